# Optimizing an MI355X kernel written in HIP

```python
import jax, jax.numpy as jnp
from jax import lax
import numpy as np

D_MODEL = 1024
BATCH = 4
SEQ = 8192
DEPTH = 4

MEM_LEN = 256
GLA_HEADS = 4
GLA_DK = 64
GLA_DV = 128
GLA_RANK = 16
GLA_TAU = 16.0
GLA_CHUNK = 64
GLA_QK = GLA_HEADS * GLA_DK
GLA_V = GLA_HEADS * GLA_DV
FOX_HEADS = 4
FOX_HD = 128
FOX_W = FOX_HEADS * FOX_HD
FOX_BLOCK = 128
MEM_HEADS = 4
MEM_HD = 128
MEM_W = MEM_HEADS * MEM_HD
N_BRANCH = 3
BRANCH_W = 512
D_FF = -(-8 * D_MODEL // (3 * 256)) * 256
EPS = 1e-6

IN_SIZES = (GLA_QK, GLA_QK, GLA_V, GLA_V, GLA_RANK,
            FOX_W, FOX_W, FOX_W, FOX_HEADS,
            MEM_W,
            N_BRANCH * D_MODEL)
IN_WIDTH = sum(IN_SIZES)
IN_OFFSETS = tuple(int(o) for o in np.cumsum(IN_SIZES)[:-1])

kernel_name = "hybrid_gla_fox_mem_parallel_trunk"


def _rmsnorm(x, g):
    xf = x.astype(jnp.float32)
    y = xf * lax.rsqrt(jnp.mean(xf * xf, axis=-1, keepdims=True) + EPS)
    return (y * g.astype(jnp.float32)).astype(x.dtype)


def _heads(t, n):
    b, s, w = t.shape
    return t.reshape(b, s, n, w // n).transpose(0, 2, 1, 3)


def _merge(t):
    b, h, s, d = t.shape
    return t.transpose(0, 2, 1, 3).reshape(b, s, h * d)


def _gla(q, k, v, log_a):
    out_dtype = v.dtype
    b, h, s, dk = q.shape
    dv = v.shape[-1]
    c = GLA_CHUNK
    n = s // c
    qc = (q.astype(jnp.float32) * (GLA_DK ** -0.5)).reshape(b, h, n, c, dk)
    kc = k.astype(jnp.float32).reshape(b, h, n, c, dk)
    vc = v.astype(jnp.float32).reshape(b, h, n, c, dv)
    cum = jnp.cumsum(log_a.astype(jnp.float32).reshape(b, h, n, c, dk), axis=-2)
    cum_last = cum[..., -1:, :]
    q_in = qc * jnp.exp(cum)
    k_in = kc * jnp.exp(-cum)
    k_out = kc * jnp.exp(cum_last - cum)
    tril = jnp.tril(jnp.ones((c, c), dtype=bool))
    attn = jnp.where(tril, jnp.einsum('bhncd,bhnsd->bhncs', q_in, k_in), 0.0)
    o_intra = jnp.einsum('bhncs,bhnsv->bhncv', attn, vc)
    chunk_state = jnp.einsum('bhncd,bhncv->bhndv', k_out, vc)
    decay = jnp.exp(cum_last[..., 0, :])

    def step(state, inp):
        d, cs = inp
        return d[..., None] * state + cs, state

    _, s_in = lax.scan(step, jnp.zeros((b, h, dk, dv), jnp.float32),
                       (jnp.moveaxis(decay, 2, 0), jnp.moveaxis(chunk_state, 2, 0)))
    s_in = jnp.moveaxis(s_in, 0, 2)
    o_inter = jnp.einsum('bhncd,bhndv->bhncv', q_in, s_in)
    return (o_intra + o_inter).reshape(b, h, s, dv).astype(out_dtype)


def _fox(q, k, v, log_f):
    b, h, s, hd = q.shape
    nb = s // FOX_BLOCK
    scale = hd ** -0.5
    cum = jnp.cumsum(log_f, axis=-1)
    qb = jnp.moveaxis(q.reshape(b, h, nb, FOX_BLOCK, hd), 2, 0)
    cb = jnp.moveaxis(cum.reshape(b, h, nb, FOX_BLOCK), 2, 0)
    starts = jnp.arange(nb, dtype=jnp.int32) * FOX_BLOCK
    kpos = jnp.arange(s, dtype=jnp.int32)

    def block(args):
        q_i, c_i, i0 = args
        logits = (jnp.einsum('bhqd,bhkd->bhqk', q_i, k).astype(jnp.float32) * scale
                  + c_i[..., None] - cum[:, :, None, :])
        qpos = i0 + jnp.arange(FOX_BLOCK, dtype=jnp.int32)
        mask = kpos[None, :] <= qpos[:, None]
        p = jax.nn.softmax(jnp.where(mask, logits, -jnp.inf), axis=-1)
        return jnp.einsum('bhqk,bhkd->bhqd', p.astype(v.dtype), v)

    out = lax.map(block, (qb, cb, starts))
    return jnp.moveaxis(out, 0, 2).reshape(b, h, s, hd)


def _cross(q, k, v):
    logits = jnp.einsum('bhqd,bhkd->bhqk', q, k).astype(jnp.float32) * (q.shape[-1] ** -0.5)
    p = jax.nn.softmax(logits, axis=-1)
    return jnp.einsum('bhqk,bhkd->bhqd', p.astype(v.dtype), v)


def setup_inputs(seed: int = 0) -> dict:
    key = jax.random.key(seed)
    ks = jax.random.split(key, 24)
    L, D = DEPTH, D_MODEL

    def nrm(k, shape, scale):
        return jax.random.normal(k, shape, jnp.float32) * scale

    def gain(k, shape):
        return 1.0 + 0.02 * jax.random.normal(k, shape, jnp.float32)

    return {
        "x": nrm(ks[0], (BATCH, SEQ, D), 1.0),
        "mem": nrm(ks[1], (BATCH, MEM_LEN, D), 1.0),
        "g_mix": gain(ks[2], (L, D)),
        "w_in": nrm(ks[3], (L, D, IN_WIDTH), D ** -0.5),
        "w_gla_a2": nrm(ks[4], (L, GLA_RANK, GLA_QK), GLA_RANK ** -0.5),
        "b_gla_a": nrm(ks[5], (L, GLA_QK), 0.1),
        "g_gla_out": gain(ks[6], (L, GLA_V)),
        "b_fox_f": nrm(ks[7], (L, FOX_HEADS), 0.1),
        "g_fox_q": gain(ks[8], (L, FOX_HD)),
        "g_fox_k": gain(ks[9], (L, FOX_HD)),
        "g_mem": gain(ks[10], (L, D)),
        "w_mem_kv": nrm(ks[11], (L, D, 2 * MEM_W), D ** -0.5),
        "g_mem_q": gain(ks[12], (L, MEM_HD)),
        "g_mem_k": gain(ks[13], (L, MEM_HD)),
        "b_gate": nrm(ks[14], (L, N_BRANCH * D), 0.1),
        "w_branch": nrm(ks[15], (L, N_BRANCH, BRANCH_W, D), BRANCH_W ** -0.5),
        "w_out": nrm(ks[16], (L, D, D), D ** -0.5),
        "g_ffn": gain(ks[17], (L, D)),
        "w_ffn_gate": nrm(ks[18], (L, D, D_FF), D ** -0.5),
        "w_ffn_up": nrm(ks[19], (L, D, D_FF), D ** -0.5),
        "w_ffn_down": nrm(ks[20], (L, D_FF, D), D_FF ** -0.5),
    }


def reference(x, mem, g_mix, w_in, w_gla_a2, b_gla_a, g_gla_out, b_fox_f, g_fox_q, g_fox_k,
              g_mem, w_mem_kv, g_mem_q, g_mem_k, b_gate, w_branch, w_out,
              g_ffn, w_ffn_gate, w_ffn_up, w_ffn_down):
    for l in range(DEPTH):
        h = _rmsnorm(x, g_mix[l])
        proj = h @ w_in[l]
        (gq, gk, gv, gg, ga1, fq, fk, fv, ff, mq, bg) = jnp.split(proj, IN_OFFSETS, axis=-1)

        log_a = jax.nn.log_sigmoid((ga1 @ w_gla_a2[l] + b_gla_a[l]).astype(jnp.float32)) / GLA_TAU
        o_gla = _gla(_heads(gq, GLA_HEADS), _heads(gk, GLA_HEADS), _heads(gv, GLA_HEADS),
                     _heads(log_a, GLA_HEADS))
        o_gla = _rmsnorm(o_gla, g_gla_out[l].reshape(GLA_HEADS, 1, GLA_DV))
        y_gla = _merge(o_gla) * jax.nn.silu(gg)

        log_f = jax.nn.log_sigmoid((ff + b_fox_f[l]).astype(jnp.float32)).transpose(0, 2, 1)
        o_fox = _fox(_rmsnorm(_heads(fq, FOX_HEADS), g_fox_q[l]),
                     _rmsnorm(_heads(fk, FOX_HEADS), g_fox_k[l]),
                     _heads(fv, FOX_HEADS), log_f)
        y_fox = _merge(o_fox)

        mkv = _rmsnorm(mem, g_mem[l]) @ w_mem_kv[l]
        mk, mv = jnp.split(mkv, 2, axis=-1)
        o_mem = _cross(_rmsnorm(_heads(mq, MEM_HEADS), g_mem_q[l]),
                       _rmsnorm(_heads(mk, MEM_HEADS), g_mem_k[l]),
                       _heads(mv, MEM_HEADS))
        y_mem = _merge(o_mem)

        gates = jax.nn.sigmoid(bg + b_gate[l])
        merged = None
        for i, y_b in enumerate((y_gla, y_fox, y_mem)):
            term = gates[..., i * D_MODEL:(i + 1) * D_MODEL] * (y_b @ w_branch[l, i])
            merged = term if merged is None else merged + term
        x = x + merged @ w_out[l]

        h2 = _rmsnorm(x, g_ffn[l])
        x = x + (jax.nn.silu(h2 @ w_ffn_gate[l]) * (h2 @ w_ffn_up[l])) @ w_ffn_down[l]
    return x
```

```cpp
#include <hip/hip_runtime.h>
#include <hip/hip_cooperative_groups.h>
#include <cstdio>
#include <cstdint>
#include <cmath>
namespace cg = cooperative_groups;
namespace pg8 {
#define PG8_LAS __attribute__((address_space(3)))
typedef unsigned short bf16_t;
typedef short bf16x8 __attribute__((ext_vector_type(8)));
typedef float f32x4 __attribute__((ext_vector_type(4)));
typedef unsigned u32x4 __attribute__((ext_vector_type(4)));
constexpr int BM = 256, BK = 64, HALF = 128, HTB = HALF * BK * 2  , STAGE_BYTES = 8 * HTB, NXCD = 8, WGM = 8;

__host__ __device__ __forceinline__ int lds_byte(int r, int c) { const int st = (r >> 4) * 2 + (c >> 5), rr = r & 15, cc = c & 31, ob = rr * 64 + cc * 2; return st * 1024 + (ob ^ (((ob >> 9) & 1) << 5)); }
__host__ __device__ __forceinline__ void stage_rc(int b, int& R, int& C) { const int st = b / 1024, sb = b % 1024, swz = sb ^ (((sb >> 9) & 1) << 5); R = (st >> 1) * 16 + swz / 64; C = (st & 1) * 32 + (swz % 64) / 2; }
__host__ __device__ __forceinline__ int perm32(int rho) { const int n = rho >> 4, i = rho & 15; return 8 * (i >> 2) + 4 * n + (i & 3); }

struct Unit { int pm, pn, aoff; };
struct Gemm { const bf16_t* A; const bf16_t* Bt; int M, N, K, lda; };

struct StaticOrder {
    int nM, nN, nwg, G, c;
    __host__ __device__ void init(int M, int N, int G_, int c_) { nM = M / BM; nN = N / BM; nwg = nM * nN; G = G_; c = c_; }
    __host__ __device__ bool next(int i, Unit& u) const {
        const long L = (long)i * G + c; if (L >= nwg) return false;
        int wgid = (int)L; { const int q = nwg / NXCD, r = nwg % NXCD, xcd = wgid % NXCD, off = wgid / NXCD; wgid = (xcd < r ? xcd * (q + 1) : r * (q + 1) + (xcd - r) * q) + off; }
        const int nig = WGM * nN, gid = wgid / nig, fm = gid * WGM, gsz = (nM - fm) < WGM ? (nM - fm) : WGM;
        u.pm = fm + ((wgid % nig) % gsz); u.pn = (wgid % nig) / gsz; u.aoff = 0; return true;
    }
    __device__ __forceinline__ void a_ready(const Unit&) const {}
    __device__ __forceinline__ void done(const Unit&) const {}
};
struct BranchOrder {
    StaticOrder S0;
    __host__ __device__ void init(int M, int G_, int c_) { S0.init(M, 1024, G_, c_); }
    __host__ __device__ bool next(int i, Unit& u) const { const int r = i / 3, b = i - 3 * r; if (!S0.next(r, u)) return false; u.pn += 4 * b; u.aoff = 1024 * (1 + 2 * b + (b >> 1)); return true; }
    __device__ __forceinline__ void a_ready(const Unit&) const {}
    __device__ __forceinline__ void done(const Unit&) const {}
};

__device__ __forceinline__ unsigned cvt_pk_bf16(float lo, float hi) { unsigned r; asm volatile("v_cvt_pk_bf16_f32 %0, %1, %2" : "=v"(r) : "v"(lo), "v"(hi)); return r; }
typedef float f32x2 __attribute__((ext_vector_type(2)));
typedef float f32x2 __attribute__((ext_vector_type(2)));
__device__ __forceinline__ float bf2f(unsigned short b) { return __uint_as_float((unsigned)b << 16); }
__device__ __forceinline__ float bflo(unsigned w) { return __uint_as_float(w << 16); }
__device__ __forceinline__ float bfhi(unsigned w) { return __uint_as_float(w & 0xffff0000u); }
__device__ __forceinline__ float sigmoidf_(float x) { return __builtin_amdgcn_rcpf(1.0f + __builtin_amdgcn_exp2f(-1.4426950408889634f * x)); }
__device__ __forceinline__ float row_rs(const float* ssq, size_t row, int fq) {
    const f32x4 q = *(const f32x4*)(ssq + row * 16 + 4 * fq); float s = (q[0] + q[1]) + (q[2] + q[3]);
    s += __shfl_xor(s, 16); s += __shfl_xor(s, 32);
    return 1.0f / sqrtf(s * (1.0f / 1024.0f) + 1e-6f);
}
struct EpiStore {
    static constexpr bool PERM = true, AFTER_DRAIN = false;
    bf16_t* O; int ldc; const float* ssq;
    __device__ __forceinline__ void operator()(const f32x4 (&acc)[2][2][4][2], const Unit& u, int wr, int wc, int fr, int fq) const {
        const int row0 = u.pm * BM + wr * 64 + fr, col0 = u.pn * BM + wc * 32 + 8 * fq;
#pragma unroll
        for (int ai = 0; ai < 2; ++ai)
#pragma unroll
            for (int m = 0; m < 4; ++m) { const size_t row = (size_t)(row0 + ai * HALF + m * 16); bf16_t* rowp = O + row * ldc + col0;
                const float rs = ssq ? row_rs(ssq, row, fq) : 1.0f;
#pragma unroll
                for (int bj = 0; bj < 2; ++bj) { const f32x4 v0 = acc[ai][bj][m][0] * rs, v1 = acc[ai][bj][m][1] * rs;
                    u32x4 w; w.x = cvt_pk_bf16(v0[0], v0[1]); w.y = cvt_pk_bf16(v0[2], v0[3]); w.z = cvt_pk_bf16(v1[0], v1[1]); w.w = cvt_pk_bf16(v1[2], v1[3]);
                    *(u32x4*)(rowp + bj * HALF) = w; } }
    }
};
struct EpiGate {
    static constexpr bool PERM = true, AFTER_DRAIN = false;
    const bf16_t* G; int ldg; const float* bias; bf16_t* O; int ldc;
    __device__ __forceinline__ void operator()(const f32x4 (&acc)[2][2][4][2], const Unit& u, int wr, int wc, int fr, int fq) const {
        const int row0 = u.pm * BM + wr * 64 + fr, gcol0 = u.pn * BM + wc * 32 + 8 * fq, col0 = (u.pn & 3) * BM + wc * 32 + 8 * fq; const bool first = u.pn < 4;
#pragma unroll
        for (int bj = 0; bj < 2; ++bj) {
            const f32x4 b0 = *(const f32x4*)(bias + gcol0 + bj * HALF), b1 = *(const f32x4*)(bias + gcol0 + bj * HALF + 4);
#pragma unroll
            for (int ai = 0; ai < 2; ++ai)
#pragma unroll
                for (int m = 0; m < 4; ++m) { const size_t r = (size_t)(row0 + ai * HALF + m * 16);
                    const u32x4 gw = *(const u32x4*)(G + r * ldg + gcol0 + bj * HALF);
                    bf16_t* op = O + r * ldc + col0 + bj * HALF;
                    u32x4 pw = (u32x4){0u, 0u, 0u, 0u}; if (!first) pw = *(const u32x4*)op;
                    const f32x4 v0 = acc[ai][bj][m][0], v1 = acc[ai][bj][m][1];
                    float r0 = bflo(pw.x) + sigmoidf_(bflo(gw.x) + b0[0]) * v0[0], r1 = bfhi(pw.x) + sigmoidf_(bfhi(gw.x) + b0[1]) * v0[1];
                    float r2 = bflo(pw.y) + sigmoidf_(bflo(gw.y) + b0[2]) * v0[2], r3 = bfhi(pw.y) + sigmoidf_(bfhi(gw.y) + b0[3]) * v0[3];
                    float r4 = bflo(pw.z) + sigmoidf_(bflo(gw.z) + b1[0]) * v1[0], r5 = bfhi(pw.z) + sigmoidf_(bfhi(gw.z) + b1[1]) * v1[1];
                    float r6 = bflo(pw.w) + sigmoidf_(bflo(gw.w) + b1[2]) * v1[2], r7 = bfhi(pw.w) + sigmoidf_(bfhi(gw.w) + b1[3]) * v1[3];
                    u32x4 w; w.x = cvt_pk_bf16(r0, r1); w.y = cvt_pk_bf16(r2, r3); w.z = cvt_pk_bf16(r4, r5); w.w = cvt_pk_bf16(r6, r7);
                    *(u32x4*)op = w; }
        }
    }
};
struct EpiResid {
    static constexpr bool PERM = true, AFTER_DRAIN = false;
    float* out; bf16_t* xb; float* ssq;
    __device__ __forceinline__ void operator()(const f32x4 (&acc)[2][2][4][2], const Unit& u, int wr, int wc, int fr, int fq) const {
        const int row0 = u.pm * BM + wr * 64 + fr, col0 = u.pn * BM + wc * 32 + 8 * fq;
#pragma unroll
        for (int ai = 0; ai < 2; ++ai)
#pragma unroll
            for (int m = 0; m < 4; ++m) { const size_t row = (size_t)(row0 + ai * HALF + m * 16), off = row * 1024 + col0; float ss = 0.f;
#pragma unroll
                for (int bj = 0; bj < 2; ++bj) {
                    const u32x4 rw = *(const u32x4*)(xb + off + bj * HALF);
                    const f32x4 a = (f32x4){bflo(rw.x), bfhi(rw.x), bflo(rw.y), bfhi(rw.y)} + acc[ai][bj][m][0], b = (f32x4){bflo(rw.z), bfhi(rw.z), bflo(rw.w), bfhi(rw.w)} + acc[ai][bj][m][1];
                    if (out) { *(f32x4*)(out + off + bj * HALF) = a; *(f32x4*)(out + off + bj * HALF + 4) = b; }
                    ss += (a[0] * a[0] + a[1] * a[1]) + (a[2] * a[2] + a[3] * a[3]) + (b[0] * b[0] + b[1] * b[1]) + (b[2] * b[2] + b[3] * b[3]);
                    u32x4 w; w.x = cvt_pk_bf16(a[0], a[1]); w.y = cvt_pk_bf16(a[2], a[3]); w.z = cvt_pk_bf16(b[0], b[1]); w.w = cvt_pk_bf16(b[2], b[3]);
                    *(u32x4*)(xb + off + bj * HALF) = w; }
                ss += __shfl_xor(ss, 16); ss += __shfl_xor(ss, 32);
                if (fq == 0) ssq[row * 16 + u.pn * 4 + wc] = ss; }
    }
};
struct EpiSwiglu {
    static constexpr bool PERM = true, AFTER_DRAIN = false;
    bf16_t* O; int ldc; const float* ssq;
    __device__ __forceinline__ void operator()(const f32x4 (&acc)[2][2][4][2], const Unit& u, int wr, int wc, int fr, int fq) const {
        const int row0 = u.pm * BM + wr * 64 + fr, col0 = u.pn * HALF + wc * 32 + 8 * fq;
#pragma unroll
        for (int ai = 0; ai < 2; ++ai)
#pragma unroll
            for (int m = 0; m < 4; ++m) { float h[8]; const float rs = row_rs(ssq, (size_t)(row0 + ai * HALF + m * 16), fq);
#pragma unroll
                for (int n = 0; n < 2; ++n)
#pragma unroll
                    for (int j = 0; j < 4; ++j) { const float gt = acc[ai][0][m][n][j] * rs, up = acc[ai][1][m][n][j] * rs; h[4 * n + j] = gt * sigmoidf_(gt) * up; }
                u32x4 w; w.x = cvt_pk_bf16(h[0], h[1]); w.y = cvt_pk_bf16(h[2], h[3]); w.z = cvt_pk_bf16(h[4], h[5]); w.w = cvt_pk_bf16(h[6], h[7]);
                *(u32x4*)(O + (size_t)(row0 + ai * HALF + m * 16) * ldc + col0) = w; }
    }
};
template <class Epi, class Sched, bool ALIGN_EPI = false, bool SP2 = false>
__device__ __forceinline__ void gemm_phase(PG8_LAS unsigned char* lds, const Gemm g, const Sched& S, const Epi& E) {
    int tid_ = threadIdx.x; asm volatile("" : "+v"(tid_)); const int tid = tid_, wid = __builtin_amdgcn_readfirstlane(tid >> 6), lane = tid & 63, wr = wid >> 2, wc = wid & 3, fr = lane & 15, fq = lane >> 4;
    const int K = g.K, nt = K / BK;
    unsigned voffA[2], voffB[2];
#pragma unroll
    for (int i = 0; i < 2; ++i) { int R, C; stage_rc(tid * 16 + i * 8192, R, C); const int Rb = Epi::PERM ? ((R & ~31) + perm32(R & 31)) : R;
        voffA[i] = (unsigned)(R * g.lda + C) * 2u; voffB[i] = (unsigned)(Rb * K + C) * 2u; }
    const size_t kstep = (size_t)(BK * 2);
    const size_t hstepA = (size_t)HALF * g.lda * 2, hstepB = (size_t)HALF * K * 2;
    const size_t tstepA = 2 * hstepA, tstepB = 2 * hstepB;
    const unsigned ldsw = (unsigned)wid * 1024u;
    const int aoff = lds_byte(wr * 64 + fr, fq * 8), boff = lds_byte(wc * 32 + fr, fq * 8);
#define PG8_SA(b, h) (((b) * 2 + (h)) * HTB)
#define PG8_SB(b, h) ((4 + (b) * 2 + (h)) * HTB)
#define PG8_STAGE(bufoff, gbase, voff) do { _Pragma("unroll") for (int _i = 0; _i < 2; ++_i) \
        __builtin_amdgcn_global_load_lds((const unsigned*)((const char*)(gbase) + (voff)[_i]), (PG8_LAS unsigned*)(lds + (bufoff) + ldsw + _i * 8192), 16, 0, 0); } while (0)
#define PG8_LDA(dst, b, h) do { _Pragma("unroll") for (int m = 0; m < 4; ++m) _Pragma("unroll") for (int k = 0; k < 2; ++k) dst[m][k] = *(const PG8_LAS bf16x8*)(lds + PG8_SA(b, h) + aoff + m * 2048 + k * 1024); } while (0)
#define PG8_LDB(dst, b, h) do { _Pragma("unroll") for (int n = 0; n < 2; ++n) _Pragma("unroll") for (int k = 0; k < 2; ++k) dst[n][k] = *(const PG8_LAS bf16x8*)(lds + PG8_SB(b, h) + boff + n * 2048 + k * 1024); } while (0)
#define PG8_MMA(ai, bj, At, Bt) do { __builtin_amdgcn_s_setprio(1); _Pragma("unroll") for (int m = 0; m < 4; ++m) _Pragma("unroll") for (int n = 0; n < 2; ++n) _Pragma("unroll") for (int k = 0; k < 2; ++k) \
        acc[ai][bj][m][n] = __builtin_amdgcn_mfma_f32_16x16x32_bf16(Bt[n][k], At[m][k], acc[ai][bj][m][n], 0, 0, 0); __builtin_amdgcn_s_setprio(0); } while (0)
#define PG8_WAIT_V(n) asm volatile("s_waitcnt vmcnt(" #n ")" ::: "memory")
#define PG8_WAIT_L(n) asm volatile("s_waitcnt lgkmcnt(" #n ")" ::: "memory")
#define PG8_BAR __builtin_amdgcn_s_barrier()
#define PG8_SCHED __builtin_amdgcn_sched_barrier(0)
    Unit cur, nxt; int ui = 0;
    if (!S.next(0, cur)) return;
    f32x4 acc[2][2][4][2];
#pragma unroll
    for (int a = 0; a < 2; ++a)
#pragma unroll
        for (int b = 0; b < 2; ++b)
#pragma unroll
            for (int m = 0; m < 4; ++m)
#pragma unroll
                for (int n = 0; n < 2; ++n) acc[a][b][m][n] = (f32x4){0.f, 0.f, 0.f, 0.f};
    bf16x8 At[4][2], B0[2][2], B1[2][2];
    const char* cA = (const char*)g.A + (size_t)cur.pm * tstepA + cur.aoff; const char* cB = (const char*)g.Bt + (size_t)cur.pn * tstepB;
    S.a_ready(cur);
    if constexpr (SP2) {
        PG8_STAGE(PG8_SB(0, 0), cB, voffB); PG8_STAGE(PG8_SB(0, 1), cB + hstepB, voffB); PG8_STAGE(PG8_SA(0, 0), cA, voffA); PG8_STAGE(PG8_SA(0, 1), cA + hstepA, voffA);
        if (wr == 1) PG8_BAR;
        PG8_WAIT_V(2); PG8_BAR;
        PG8_STAGE(PG8_SB(1, 0), cB + kstep, voffB); PG8_STAGE(PG8_SA(1, 0), cA + kstep, voffA); PG8_STAGE(PG8_SB(1, 1), cB + hstepB + kstep, voffB);
        PG8_WAIT_V(6); PG8_BAR;
    } else {
        PG8_STAGE(PG8_SB(0, 0), cB, voffB); PG8_STAGE(PG8_SA(0, 0), cA, voffA); PG8_STAGE(PG8_SB(0, 1), cB + hstepB, voffB); PG8_STAGE(PG8_SA(0, 1), cA + hstepA, voffA);
        if (wr == 1) PG8_BAR;
        PG8_WAIT_V(4); PG8_BAR;
        PG8_STAGE(PG8_SB(1, 0), cB + kstep, voffB); PG8_STAGE(PG8_SA(1, 0), cA + kstep, voffA); PG8_STAGE(PG8_SB(1, 1), cB + hstepB + kstep, voffB);
        PG8_WAIT_V(6); PG8_BAR;
    }
    for (;;) {
        const bool has_next = S.next(ui + 1, nxt);
        const char* nA = has_next ? (const char*)g.A + (size_t)nxt.pm * tstepA + nxt.aoff : cA; const char* nB = has_next ? (const char*)g.Bt + (size_t)nxt.pn * tstepB : cB;
        for (int t = 0; t < nt; t += 2) {
            const bool last = (t == nt - 2);
            const char* a1 = cA + (size_t)(t + 1) * kstep;
            const char* a2 = last ? nA : cA + (size_t)(t + 2) * kstep; const char* b2 = last ? nB : cB + (size_t)(t + 2) * kstep;
            const char* a3 = a2 + kstep; const char* b3 = b2 + kstep;
            if (last && has_next) S.a_ready(nxt);
            if constexpr (SP2) {
            PG8_LDB(B0, 0, 0); PG8_LDB(B1, 0, 1); PG8_SCHED; PG8_LDA(At, 0, 0); PG8_STAGE(PG8_SA(1, 1), a1 + hstepA, voffA);
            PG8_WAIT_V(8); PG8_WAIT_L(0); PG8_BAR; PG8_MMA(0, 0, At, B0); PG8_MMA(0, 1, At, B1); PG8_BAR; PG8_SCHED;
            PG8_LDA(At, 0, 1); PG8_STAGE(PG8_SB(0, 0), b2, voffB); PG8_STAGE(PG8_SB(0, 1), b2 + hstepB, voffB); PG8_STAGE(PG8_SA(0, 0), a2, voffA);
            PG8_WAIT_V(8); PG8_WAIT_L(0); PG8_BAR; PG8_MMA(1, 0, At, B0); PG8_MMA(1, 1, At, B1); PG8_BAR; PG8_SCHED;
            PG8_LDB(B0, 1, 0); PG8_LDB(B1, 1, 1); PG8_SCHED; PG8_LDA(At, 1, 0); PG8_STAGE(PG8_SA(0, 1), a2 + hstepA, voffA);
            PG8_WAIT_V(8); PG8_WAIT_L(0); PG8_BAR; PG8_MMA(0, 0, At, B0); PG8_MMA(0, 1, At, B1); PG8_BAR; PG8_SCHED;
            PG8_LDA(At, 1, 1); PG8_STAGE(PG8_SB(1, 0), b3, voffB); PG8_STAGE(PG8_SB(1, 1), b3 + hstepB, voffB); PG8_STAGE(PG8_SA(1, 0), a3, voffA);
            PG8_WAIT_V(8); PG8_WAIT_L(0); PG8_BAR; PG8_MMA(1, 0, At, B0); PG8_MMA(1, 1, At, B1); PG8_BAR; PG8_SCHED;
            } else {
            PG8_LDB(B0, 0, 0); PG8_SCHED; PG8_LDA(At, 0, 0); PG8_STAGE(PG8_SA(1, 1), a1 + hstepA, voffA);
            PG8_WAIT_L(8); PG8_BAR; PG8_WAIT_L(0); PG8_MMA(0, 0, At, B0); PG8_BAR; PG8_SCHED;
            PG8_LDB(B1, 0, 1); PG8_STAGE(PG8_SB(0, 0), b2, voffB);
            PG8_BAR; PG8_WAIT_L(0); PG8_MMA(0, 1, At, B1); PG8_BAR;
            PG8_LDA(At, 0, 1); PG8_STAGE(PG8_SA(0, 0), a2, voffA);
            PG8_BAR; PG8_WAIT_L(0); PG8_MMA(1, 0, At, B0); PG8_BAR; PG8_SCHED;
            PG8_STAGE(PG8_SB(0, 1), b2 + hstepB, voffB);
            PG8_WAIT_V(6); PG8_BAR; PG8_MMA(1, 1, At, B1); PG8_BAR;
            PG8_LDB(B0, 1, 0); PG8_SCHED; PG8_LDA(At, 1, 0); PG8_STAGE(PG8_SA(0, 1), a2 + hstepA, voffA);
            PG8_WAIT_L(8); PG8_BAR; PG8_WAIT_L(0); PG8_MMA(0, 0, At, B0); PG8_BAR; PG8_SCHED;
            PG8_LDB(B1, 1, 1); PG8_STAGE(PG8_SB(1, 0), b3, voffB);
            PG8_BAR; PG8_WAIT_L(0); PG8_MMA(0, 1, At, B1); PG8_BAR;
            PG8_LDA(At, 1, 1); PG8_STAGE(PG8_SA(1, 0), a3, voffA);
            PG8_BAR; PG8_WAIT_L(0); PG8_MMA(1, 0, At, B0); PG8_BAR; PG8_SCHED;
            PG8_STAGE(PG8_SB(1, 1), b3 + hstepB, voffB);
            PG8_WAIT_V(6); PG8_BAR; PG8_MMA(1, 1, At, B1); PG8_BAR;
            }
        }
        if constexpr (ALIGN_EPI) { if (wr == 0) PG8_BAR; }
        if constexpr (!Epi::AFTER_DRAIN) { E(acc, cur, wr, wc, fr, fq); S.done(cur); }
        if (!has_next) break;
#pragma unroll
        for (int a = 0; a < 2; ++a)
#pragma unroll
            for (int b = 0; b < 2; ++b)
#pragma unroll
                for (int m = 0; m < 4; ++m)
#pragma unroll
                    for (int n = 0; n < 2; ++n) acc[a][b][m][n] = (f32x4){0.f, 0.f, 0.f, 0.f};
        cur = nxt; cA = nA; cB = nB; ++ui;
        if constexpr (ALIGN_EPI) { if (wr == 1) PG8_BAR; }
    }
    PG8_WAIT_V(0);
    if constexpr (!ALIGN_EPI) { if (wr == 0) PG8_BAR; }
    PG8_BAR;
    if constexpr (Epi::AFTER_DRAIN) { E.fused(acc, cur, wr, wc, fr, fq, lds, wid, lane); S.done(cur); }
#undef PG8_SA
#undef PG8_SB
#undef PG8_STAGE
#undef PG8_LDA
#undef PG8_LDB
#undef PG8_MMA
#undef PG8_WAIT_V
#undef PG8_WAIT_L
#undef PG8_BAR
#undef PG8_SCHED
}
}

#define LAS __attribute__((address_space(3)))
typedef unsigned short bf16_t;
typedef short bf16x8 __attribute__((ext_vector_type(8)));
typedef short s16x4 __attribute__((ext_vector_type(4)));
typedef float f32x4 __attribute__((ext_vector_type(4)));
typedef float f32x16 __attribute__((ext_vector_type(16)));
typedef unsigned u32x4 __attribute__((ext_vector_type(4)));
typedef unsigned u32x2 __attribute__((ext_vector_type(2)));
using pg8::cvt_pk_bf16; using pg8::bf2f; using pg8::bflo; using pg8::bfhi; using pg8::sigmoidf_;

constexpr int SEQ = 8192, DM = 1024, NL = 4, MH = 16384, PW = 6912, DFF = 2816, INW = 6676, YW = 1536;
constexpr int C_GQ = 0, C_GK = 256, C_GV = 512, C_GG = 1024, C_FQ = 1536, C_FK = 2048, C_FV = 2560, C_MQ = 3072, C_BG = 3584, C_GA1 = 6656, C_FF = 6672;
constexpr float EPSN = 1e-6f, LOG2E = 1.4426950408889634f;
#ifndef FOX_SKIP
#define FOX_SKIP 1
#endif
constexpr size_t WS_WIN = 0, WS_WMEM = WS_WIN + (size_t)NL * PW * 1024 * 2, WS_WBR = WS_WMEM + (size_t)4096 * 1024 * 2, WS_WOUT = WS_WBR + (size_t)NL * 3 * 1024 * 512 * 2,
    WS_WGU = WS_WOUT + (size_t)NL * 1024 * 1024 * 2, WS_WDN = WS_WGU + (size_t)NL * 5632 * 1024 * 2,
    WS_MKN = WS_WDN + (size_t)NL * 1024 * DFF * 2, WS_MVT = WS_MKN + (size_t)NL * 1024 * 512 * 2, WS_CUMF = WS_MVT + (size_t)NL * 16 * 128 * 256 * 2, WS_DEC = WS_CUMF + (size_t)8 * SEQ * 4,
    WS_VTF = WS_DEC + (size_t)1024 * 64 * 4, WS_SIN = WS_VTF + (size_t)8 * 128 * SEQ * 2, WS_CS = WS_SIN + (size_t)1024 * 128 * 64 * 2, WS_XBF = WS_CS + (size_t)1024 * 128 * 64 * 4,
    WS_PROJ = WS_XBF + (size_t)2 * MH * 1024 * 2, WS_TSK = WS_PROJ + (size_t)MH * PW * 2, WS_BAR = WS_TSK + 256, WS_SSQ = WS_BAR + 16384, WS_MKV = WS_SSQ + (size_t)2 * MH * 16 * 4, WS_END = WS_MKV + (size_t)1024 * 4096 * 2;
constexpr size_t WS_MEMN = WS_PROJ;
static_assert((size_t)2 * MH * DFF * 2 <= (size_t)MH * PW * 2, "full-batch FFN hidden overlays PROJ");
static_assert(WS_END <= (size_t)536870912, "workspace map exceeds 512 MiB");
static_assert((size_t)MH * 1024 * 2 <= (size_t)1024 * 128 * 64 * 4, "MRG overlays CS");

struct Params { const float* in[21]; float* out; unsigned char* ws; };
enum { I_X = 0, I_MEM, I_GMIX, I_WIN, I_WA2, I_BA, I_GGLA, I_BFOX, I_GFQ, I_GFK, I_GMEM, I_WMKV, I_GMQ, I_GMK, I_BGATE, I_WBR, I_WOUT, I_GFFN, I_WFG, I_WFU, I_WFD };

__device__ __forceinline__ float wave_sum(float v) {
#pragma unroll
    for (int o = 1; o < 64; o <<= 1) v += __shfl_xor(v, o);
    return v;
}
__device__ __forceinline__ float log_sigmoid_(float x) { return fminf(x, 0.f) - __logf(1.0f + __expf(-fabsf(x))); }
#define LDS_WAIT() asm volatile("s_waitcnt lgkmcnt(0)" ::: "memory")

__device__ __forceinline__ int inmap(int n) { if (n < 1536) return n; if (n < 3072) return n + 16; if (n < 6656) return n + 20; if (n < 6672) return 1536 + (n - 6656); if (n < 6676) return 3088 + (n - 6672); return -1; }

__device__ __forceinline__ void transpose_item(const float* W, int K, int Ns, const float* gain, bf16_t* WT, LAS float* scr, int kb, int nb, int lane, int sc) {
    const int k0 = 64 * kb, n0 = 32 * nb, c = lane & 7;
    float v[32];
    const float* wp = W + (size_t)(k0 + (lane >> 5)) * Ns + (sc >= 0 ? sc : 0);
#pragma unroll
    for (int i = 0; i < 32; ++i) v[i] = wp[(size_t)(2 * i) * Ns];
    f32x4 g0 = (f32x4){1.f, 1.f, 1.f, 1.f}, g1 = g0;
    if (gain) { g0 = *(const f32x4*)(gain + k0 + 8 * c); g1 = *(const f32x4*)(gain + k0 + 8 * c + 4); }
    if (sc < 0) {
#pragma unroll
        for (int i = 0; i < 32; ++i) v[i] = 0.f;
    }
#pragma unroll
    for (int i = 0; i < 32; ++i) scr[(2 * i + (lane >> 5)) * 33 + (lane & 31)] = v[i];
    LDS_WAIT();
#pragma unroll
    for (int j = 0; j < 4; ++j) { const int n = (lane >> 3) + 8 * j; const LAS float* s = scr + (8 * c) * 33 + n;
        u32x4 o; o.x = cvt_pk_bf16(s[0 * 33] * g0[0], s[1 * 33] * g0[1]); o.y = cvt_pk_bf16(s[2 * 33] * g0[2], s[3 * 33] * g0[3]); o.z = cvt_pk_bf16(s[4 * 33] * g1[0], s[5 * 33] * g1[1]); o.w = cvt_pk_bf16(s[6 * 33] * g1[2], s[7 * 33] * g1[3]);
        *(u32x4*)(WT + (size_t)(n0 + n) * K + k0 + 8 * c) = o; }
    LDS_WAIT();
}
__device__ __forceinline__ void norm_rows(const float* X, bf16_t* XN, int nrows, int gw, int NGW, int lane) {
    for (int m = gw; m < nrows; m += NGW) {
        const f32x4* xr = (const f32x4*)(X + (size_t)m * DM) + lane; f32x4 v[4]; float s = 0.f;
#pragma unroll
        for (int j = 0; j < 4; ++j) { v[j] = xr[64 * j]; s += (v[j].x * v[j].x + v[j].y * v[j].y) + (v[j].z * v[j].z + v[j].w * v[j].w); }
        const float r = 1.0f / sqrtf(wave_sum(s) * (1.0f / DM) + EPSN);
        u32x2* o8 = (u32x2*)(XN + (size_t)m * DM) + lane;
#pragma unroll
        for (int j = 0; j < 4; ++j) { u32x2 w; w.x = cvt_pk_bf16(v[j].x * r, v[j].y * r); w.y = cvt_pk_bf16(v[j].z * r, v[j].w * r); o8[64 * j] = w; }
    }
}
__device__ __forceinline__ void norm128_rows64(const bf16_t* src, size_t spitch, bf16_t* dst, size_t dpitch, const float* gain, float scale, int tid) {
    const int sub = tid & 15; float g[8];
#pragma unroll
    for (int j = 0; j < 8; ++j) g[j] = gain[sub * 8 + j] * scale;
#pragma unroll
    for (int pass = 0; pass < 2; ++pass) { const int row = pass * 32 + (tid >> 4);
        const u32x4 w = *(const u32x4*)(src + (size_t)row * spitch + sub * 8);
        float v[8] = {bflo(w.x), bfhi(w.x), bflo(w.y), bfhi(w.y), bflo(w.z), bfhi(w.z), bflo(w.w), bfhi(w.w)};
        float ss = 0.f;
#pragma unroll
        for (int j = 0; j < 8; ++j) ss += v[j] * v[j];
        ss += __shfl_xor(ss, 1); ss += __shfl_xor(ss, 2); ss += __shfl_xor(ss, 4); ss += __shfl_xor(ss, 8);
        const float r = 1.0f / sqrtf(ss * (1.0f / 128.0f) + EPSN);
        u32x4 o; o.x = cvt_pk_bf16(v[0] * r * g[0], v[1] * r * g[1]); o.y = cvt_pk_bf16(v[2] * r * g[2], v[3] * r * g[3]); o.z = cvt_pk_bf16(v[4] * r * g[4], v[5] * r * g[5]); o.w = cvt_pk_bf16(v[6] * r * g[6], v[7] * r * g[7]);
        *(u32x4*)(dst + (size_t)row * dpitch + sub * 8) = o; }
}
__device__ __forceinline__ void vt_tile(const bf16_t* src, size_t spitch, bf16_t* dst, size_t dpitch, LAS bf16_t* T, int tid) {
#pragma unroll
    for (int i = 0; i < 2; ++i) { const int c = tid + 512 * i, row = c >> 4, part = c & 15; const u32x4 w = *(const u32x4*)(src + (size_t)row * spitch + part * 8); *(LAS u32x4*)(T + row * 136 + part * 8) = w; }
    __syncthreads();
    const int d = tid & 127, part = tid >> 7; unsigned v[16];
#pragma unroll
    for (int i = 0; i < 16; ++i) v[i] = T[(16 * part + i) * 136 + d];
    u32x4 w0, w1; w0.x = v[0] | (v[1] << 16); w0.y = v[2] | (v[3] << 16); w0.z = v[4] | (v[5] << 16); w0.w = v[6] | (v[7] << 16);
    w1.x = v[8] | (v[9] << 16); w1.y = v[10] | (v[11] << 16); w1.z = v[12] | (v[13] << 16); w1.w = v[14] | (v[15] << 16);
    *(u32x4*)(dst + (size_t)d * dpitch + 16 * part) = w0; *(u32x4*)(dst + (size_t)d * dpitch + 16 * part + 8) = w1;
    __syncthreads();
}
__device__ __forceinline__ void prep_batch(const bf16_t* PROJp, const float* gk, bf16_t* KCp, bf16_t* VTFp, LAS bf16_t* T, int v0, int vs, int tid) {
    const int sub = tid & 15, row = tid >> 4;
    u32x4 w[4][2], vw[4][2];
#pragma unroll
    for (int q = 0; q < 4; ++q) { const int v = v0 + q * vs; if (v < 1024) { const int r0 = (v >> 2) * 64, h = v & 3; const bf16_t* rowp = PROJp + (size_t)r0 * PW;
#pragma unroll
        for (int ps = 0; ps < 2; ++ps) w[q][ps] = *(const u32x4*)(rowp + (size_t)(ps * 32 + row) * PW + C_FK + h * 128 + sub * 8);
#pragma unroll
        for (int i = 0; i < 2; ++i) { const int c = tid + 512 * i; vw[q][i] = *(const u32x4*)(rowp + (size_t)(c >> 4) * PW + C_FV + h * 128 + (c & 15) * 8); } } }
    float g[8];
#pragma unroll
    for (int j = 0; j < 8; ++j) g[j] = gk[sub * 8 + j];
#pragma unroll
    for (int q = 0; q < 4; ++q) { const int v = v0 + q * vs; if (v < 1024) { const int r0 = (v >> 2) * 64, h = v & 3, bp = r0 / SEQ, s0 = r0 % SEQ;
        bf16_t* kdst = KCp + ((size_t)(bp * 4 + h) * SEQ + s0) * 128;
#pragma unroll
        for (int ps = 0; ps < 2; ++ps) { const u32x4 x = w[q][ps];
            float f[8] = {bflo(x.x), bfhi(x.x), bflo(x.y), bfhi(x.y), bflo(x.z), bfhi(x.z), bflo(x.w), bfhi(x.w)};
            float ss = 0.f;
#pragma unroll
            for (int j = 0; j < 8; ++j) ss += f[j] * f[j];
            ss += __shfl_xor(ss, 1); ss += __shfl_xor(ss, 2); ss += __shfl_xor(ss, 4); ss += __shfl_xor(ss, 8);
            const float r = 1.0f / sqrtf(ss * (1.0f / 128.0f) + EPSN);
            u32x4 o; o.x = cvt_pk_bf16(f[0] * r * g[0], f[1] * r * g[1]); o.y = cvt_pk_bf16(f[2] * r * g[2], f[3] * r * g[3]); o.z = cvt_pk_bf16(f[4] * r * g[4], f[5] * r * g[5]); o.w = cvt_pk_bf16(f[6] * r * g[6], f[7] * r * g[7]);
            *(u32x4*)(kdst + (ps * 32 + row) * 128 + sub * 8) = o; }
#pragma unroll
        for (int i = 0; i < 2; ++i) { const int c = tid + 512 * i; *(LAS u32x4*)(T + q * 8704 + (c >> 4) * 136 + (c & 15) * 8) = vw[q][i]; } } }
    __syncthreads();
    const int d = tid & 127, part = tid >> 7;
#pragma unroll
    for (int q = 0; q < 4; ++q) { const int v = v0 + q * vs; if (v < 1024) { const int r0 = (v >> 2) * 64, h = v & 3, bp = r0 / SEQ, s0 = r0 % SEQ;
        bf16_t* vtdst = VTFp + ((size_t)(bp * 4 + h) * 128 + (s0 >> 6)) * 8192; unsigned e[16];
#pragma unroll
        for (int i = 0; i < 16; ++i) e[i] = T[q * 8704 + (16 * part + i) * 136 + d];
        u32x4 w0, w1; w0.x = e[0] | (e[1] << 16); w0.y = e[2] | (e[3] << 16); w0.z = e[4] | (e[5] << 16); w0.w = e[6] | (e[7] << 16);
        w1.x = e[8] | (e[9] << 16); w1.y = e[10] | (e[11] << 16); w1.z = e[12] | (e[13] << 16); w1.w = e[14] | (e[15] << 16);
        *(u32x4*)(vtdst + d * 64 + 16 * part) = w0; *(u32x4*)(vtdst + d * 64 + 16 * part + 8) = w1; } }
    __syncthreads();
}
__device__ __forceinline__ void xb_rows(const float* X, bf16_t* XB, float* ssq, int nrows, int gw, int NGW, int lane) {
    for (int m = gw; m < nrows; m += NGW) {
        const f32x4* xr = (const f32x4*)(X + (size_t)m * DM) + lane; f32x4 v[4]; float s = 0.f;
#pragma unroll
        for (int j = 0; j < 4; ++j) { v[j] = xr[64 * j]; s += (v[j].x * v[j].x + v[j].y * v[j].y) + (v[j].z * v[j].z + v[j].w * v[j].w); }
        s = wave_sum(s);
        u32x2* o8 = (u32x2*)(XB + (size_t)m * DM) + lane;
#pragma unroll
        for (int j = 0; j < 4; ++j) { u32x2 w; w.x = cvt_pk_bf16(v[j].x, v[j].y); w.y = cvt_pk_bf16(v[j].z, v[j].w); o8[64 * j] = w; }
        if (lane < 16) ssq[(size_t)m * 16 + lane] = lane == 0 ? s : 0.f;
    }
}
#define MFMA32(a, b, c) __builtin_amdgcn_mfma_f32_32x32x16_bf16((a), (b), (c), 0, 0, 0)
__device__ __forceinline__ bf16x8 pack8(const f32x16& x, int s) {
    u32x4 p; p.x = cvt_pk_bf16(x[8 * s], x[8 * s + 1]); p.y = cvt_pk_bf16(x[8 * s + 2], x[8 * s + 3]); p.z = cvt_pk_bf16(x[8 * s + 4], x[8 * s + 5]); p.w = cvt_pk_bf16(x[8 * s + 6], x[8 * s + 7]);
    return __builtin_bit_cast(bf16x8, p);
}
constexpr int AT_K = 0, AT_V = 34816, AT_B = 71680, AT_Q = 73984;
template <bool FOX>
__device__ __forceinline__ void attn_tile(const LAS unsigned char* Kb, const LAS unsigned char* Vb, const LAS float* bb, const LAS unsigned char* Qw, f32x16 (&o)[4], float& mrun, float& lrun,
                                          int k0, int qw0, int qlane, int r32, int hi) {
    if (FOX && k0 > qw0 + 31) return;
    f32x16 st[2];
#pragma unroll
    for (int kb = 0; kb < 2; ++kb)
#pragma unroll
        for (int r = 0; r < 16; ++r) st[kb][r] = 0.f;
#pragma unroll
    for (int hb = 0; hb < 2; ++hb) {
        bf16x8 qf[4], ka[4][2];
#pragma unroll
        for (int k4 = 0; k4 < 4; ++k4) { const int ks = 4 * hb + k4; qf[k4] = *(const LAS bf16x8*)(Qw + (r32 * 136 + 16 * ks + 8 * hi) * 2);
            ka[k4][0] = *(const LAS bf16x8*)(Kb + (r32 * 136 + 16 * ks + 8 * hi) * 2); ka[k4][1] = *(const LAS bf16x8*)(Kb + ((32 + r32) * 136 + 16 * ks + 8 * hi) * 2); }
        __builtin_amdgcn_sched_barrier(0);
#pragma unroll
        for (int k4 = 0; k4 < 4; ++k4) { st[0] = MFMA32(ka[k4][0], qf[k4], st[0]); st[1] = MFMA32(ka[k4][1], qf[k4], st[1]); }
        __builtin_amdgcn_sched_barrier(0);
    }
    if (FOX) {
#pragma unroll
        for (int kb = 0; kb < 2; ++kb)
#pragma unroll
            for (int g = 0; g < 4; ++g) { const f32x4 bv = *(const LAS f32x4*)(bb + 32 * kb + 8 * g + 4 * hi);
#pragma unroll
                for (int i = 0; i < 4; ++i) st[kb][4 * g + i] += bv[i]; }
        if (k0 + 63 > qw0) {
#pragma unroll
            for (int kb = 0; kb < 2; ++kb)
#pragma unroll
                for (int r = 0; r < 16; ++r) { const int key = k0 + 32 * kb + (r & 3) + 8 * (r >> 2) + 4 * hi; if (key > qlane) st[kb][r] = -INFINITY; }
        }
    }
    float mx = st[0][0];
#pragma unroll
    for (int r = 1; r < 16; ++r) mx = fmaxf(mx, st[0][r]);
#pragma unroll
    for (int r = 0; r < 16; ++r) mx = fmaxf(mx, st[1][r]);
    mx = fmaxf(mx, __shfl_xor(mx, 32));
    const float mnew = fmaxf(mrun, mx), msafe = (mnew == -INFINITY) ? 0.f : mnew;
    const float alpha = (mrun == -INFINITY) ? 0.f : __builtin_amdgcn_exp2f(mrun - msafe);
    float rs = 0.f;
#pragma unroll
    for (int kb = 0; kb < 2; ++kb)
#pragma unroll
        for (int r = 0; r < 16; ++r) { const float pv = __builtin_amdgcn_exp2f(st[kb][r] - msafe); st[kb][r] = pv; rs += pv; }
    rs += __shfl_xor(rs, 32);
    lrun = lrun * alpha + rs; mrun = mnew;
#pragma unroll
    for (int i = 0; i < 4; ++i)
#pragma unroll
        for (int r = 0; r < 16; ++r) o[i][r] *= alpha;
    s16x4 vlo[2][4], vhi[2][4];
#define AT_VLD(buf, g) do { _Pragma("unroll") for (int db = 0; db < 4; ++db) { const LAS unsigned char* vp = Vb + ((32 * db + r32) * 72 + 16 * (g) + 4 * hi) * 2; \
        vlo[buf][db] = *(const LAS s16x4*)vp; vhi[buf][db] = *(const LAS s16x4*)(vp + 16); } } while (0)
    AT_VLD(0, 0);
#pragma unroll
    for (int g = 0; g < 4; ++g) {
        __builtin_amdgcn_sched_barrier(0);
        if (g < 3) AT_VLD((g + 1) & 1, g + 1);
        const bf16x8 pf = pack8(st[g >> 1], g & 1);
        __builtin_amdgcn_sched_barrier(0);
#pragma unroll
        for (int db = 0; db < 4; ++db) { const bf16x8 a = __builtin_shufflevector(vlo[g & 1][db], vhi[g & 1][db], 0, 1, 2, 3, 4, 5, 6, 7); o[db] = MFMA32(a, pf, o[db]); }
    }
#undef AT_VLD
}
template <bool FOX>
__device__ __forceinline__ void attn_unit(LAS unsigned char* lds, const float* qgain, const bf16_t* Q, size_t qpitch, const bf16_t* K, size_t kpitch, const bf16_t* VT, size_t vpitch, int vtile,
                                          const float* cum, float cref, float o1, float o2, float o3, int q0, int j0, int j1, bf16_t* O, size_t opitch, int tid, int lane, int wid) {
    const int r32 = lane & 31, hi = lane >> 5, qw0 = q0 + 32 * wid, qlane = qw0 + r32;
    const LAS unsigned char* Qw = lds + AT_Q + wid * (32 * 136 * 2);
    {
        bf16x8 qf[8];
#pragma unroll
        for (int ks = 0; ks < 8; ++ks) qf[ks] = *(const bf16x8*)(Q + (unsigned)((32 * wid + r32) * (int)qpitch + 16 * ks + 8 * hi));
        float ss = 0.f;
#pragma unroll
        for (int ks = 0; ks < 8; ++ks)
#pragma unroll
            for (int j = 0; j < 8; ++j) { const float x = bf2f((unsigned short)qf[ks][j]); ss += x * x; }
        ss += __shfl_xor(ss, 32);
        const float rq = (1.0f / sqrtf(ss * (1.0f / 128.0f) + EPSN)) * (0.08838834764831845f * LOG2E);
#pragma unroll
        for (int ks = 0; ks < 8; ++ks) { const f32x4 ga = *(const f32x4*)(qgain + 16 * ks + 8 * hi), gb = *(const f32x4*)(qgain + 16 * ks + 8 * hi + 4);
            u32x4 w; w.x = cvt_pk_bf16(bf2f((unsigned short)qf[ks][0]) * rq * ga[0], bf2f((unsigned short)qf[ks][1]) * rq * ga[1]);
            w.y = cvt_pk_bf16(bf2f((unsigned short)qf[ks][2]) * rq * ga[2], bf2f((unsigned short)qf[ks][3]) * rq * ga[3]);
            w.z = cvt_pk_bf16(bf2f((unsigned short)qf[ks][4]) * rq * gb[0], bf2f((unsigned short)qf[ks][5]) * rq * gb[1]);
            w.w = cvt_pk_bf16(bf2f((unsigned short)qf[ks][6]) * rq * gb[2], bf2f((unsigned short)qf[ks][7]) * rq * gb[3]);
            *(LAS u32x4*)(lds + AT_Q + wid * (32 * 136 * 2) + (r32 * 136 + 16 * ks + 8 * hi) * 2) = w; }
    }
    f32x16 o[4];
#pragma unroll
    for (int i = 0; i < 4; ++i)
#pragma unroll
        for (int r = 0; r < 16; ++r) o[i][r] = 0.f;
    float mrun = -INFINITY, lrun = 0.f;
    const int kkey0 = tid >> 4, kpart = tid & 15, vd0 = tid >> 3, vpart = tid & 7;
    u32x4 kA[2], vA[2], kB[2], vB[2]; float bA = 0.f, bB = 0.f;
#define AT_LOAD(kr, vr, br, j) do { _Pragma("unroll") for (int i_ = 0; i_ < 2; ++i_) { \
        kr[i_] = *(const u32x4*)(K + (unsigned)((64 * (j) + kkey0 + 32 * i_) * (int)kpitch + kpart * 8)); \
        vr[i_] = *(const u32x4*)(VT + (unsigned)((vd0 + 64 * i_) * (int)vpitch + vtile * (j) + vpart * 8)); } \
        if (FOX) { const int sj_ = (j) >> 5; br = (cref - (cum[64 * (j) + (tid & 63)] + (sj_ == 0 ? 0.f : sj_ == 1 ? o1 : sj_ == 2 ? o2 : o3))) * LOG2E; } } while (0)
#define AT_STORE(kr, vr, br, buf) do { _Pragma("unroll") for (int i_ = 0; i_ < 2; ++i_) { \
        *(LAS u32x4*)(lds + AT_K + (buf) * 17408 + ((kkey0 + 32 * i_) * 136 + kpart * 8) * 2) = kr[i_]; \
        *(LAS u32x4*)(lds + AT_V + (buf) * 18432 + ((vd0 + 64 * i_) * 72 + vpart * 8) * 2) = vr[i_]; } \
        if (FOX && tid < 64) ((LAS float*)(lds + AT_B))[(buf) * 64 + tid] = br; } while (0)
#define AT_TILE(buf, j) attn_tile<FOX>(lds + AT_K + (buf) * 17408, lds + AT_V + (buf) * 18432, (const LAS float*)(lds + AT_B) + (buf) * 64, Qw, o, mrun, lrun, 64 * (j), qw0, qlane, r32, hi)
#define AT_BAR() asm volatile("s_waitcnt lgkmcnt(0)\n\ts_barrier" ::: "memory")
    AT_LOAD(kA, vA, bA, j0);
    AT_LOAD(kB, vB, bB, (j0 + 1 <= j1 ? j0 + 1 : j1));
    AT_STORE(kA, vA, bA, 0);
    AT_BAR();
    for (int j = j0; j <= j1; j += 2) {
        AT_LOAD(kA, vA, bA, (j + 2 <= j1 ? j + 2 : j1));
        __builtin_amdgcn_sched_barrier(0);
        AT_TILE(0, j);
        if (j + 1 <= j1) AT_STORE(kB, vB, bB, 1);
        AT_BAR();
        if (j + 1 > j1) break;
        AT_LOAD(kB, vB, bB, (j + 3 <= j1 ? j + 3 : j1));
        __builtin_amdgcn_sched_barrier(0);
        AT_TILE(1, j + 1);
        if (j + 2 <= j1) AT_STORE(kA, vA, bA, 0);
        AT_BAR();
    }
#undef AT_BAR
#undef AT_LOAD
#undef AT_STORE
#undef AT_TILE
    const float rl = 1.0f / lrun;
    int lr_ = lane; asm volatile("" : "+v"(lr_));
    bf16_t* orow = O + (unsigned)((32 * wid + (lr_ & 31)) * (int)opitch);
#pragma unroll
    for (int db = 0; db < 4; ++db)
#pragma unroll
        for (int g = 0; g < 4; ++g) { u32x2 w; w.x = cvt_pk_bf16(o[db][4 * g] * rl, o[db][4 * g + 1] * rl); w.y = cvt_pk_bf16(o[db][4 * g + 2] * rl, o[db][4 * g + 3] * rl);
            *(u32x2*)(orow + 32 * db + 8 * g + 4 * (lr_ >> 5)) = w; }
}
constexpr int GL_GA1 = 0, GL_SEG = 4096, GL_SS = 6144, GL_A8 = 8192, GL_KIN = 17408, GL_VT = 26624, GL_SINT = 45056, GL_UOFF = 65536;
template <bool OUTPHASE>
__device__ __forceinline__ void gla_pair(LAS unsigned char* lds0, const Params& p, int l, int unitA, int unitB, const bf16_t* PROJ, float* CS, float* DEC, const bf16_t* SIN, bf16_t* Y, int tid, int lane, int wid) {
    const int r32 = lane & 31, hi = lane >> 5, d = tid & 63, seg = wid;
    int h[2], r0[2], unit[2];
#pragma unroll
    for (int uu = 0; uu < 2; ++uu) { unit[uu] = uu ? unitB : unitA; const int bhp = unit[uu] >> 7, n = unit[uu] & 127; h[uu] = bhp & 3; r0[uu] = (bhp >> 2) * SEQ + n * 64; }
    u32x2 ggw[2][4]; f32x4 ggn[2][4]; float wa[2][16], ba[2], kv[2][8], qv[2][8];
#pragma unroll
    for (int uu = 0; uu < 2; ++uu) { LAS unsigned char* lds = lds0 + uu * GL_UOFF;
        LAS float* GA1 = (LAS float*)(lds + GL_GA1); LAS bf16_t* VTl = (LAS bf16_t*)(lds + GL_VT); LAS bf16_t* SINT = (LAS bf16_t*)(lds + GL_SINT);
        if (tid < 128) { const int row = tid >> 1, hp = tid & 1; const u32x4 w = *(const u32x4*)(PROJ + (size_t)(r0[uu] + row) * PW + C_GA1 + 8 * hp);
            LAS float* gp = GA1 + row * 16 + 8 * hp; gp[0] = bflo(w.x); gp[1] = bfhi(w.x); gp[2] = bflo(w.y); gp[3] = bfhi(w.y); gp[4] = bflo(w.z); gp[5] = bfhi(w.z); gp[6] = bflo(w.w); gp[7] = bfhi(w.w); }
        { const int dv = tid & 127, part = tid >> 7; unsigned v[16];
#pragma unroll
          for (int i = 0; i < 16; ++i) v[i] = PROJ[(size_t)(r0[uu] + 16 * part + i) * PW + C_GV + h[uu] * 128 + dv];
          u32x4 w0, w1; w0.x = v[0] | (v[1] << 16); w0.y = v[2] | (v[3] << 16); w0.z = v[4] | (v[5] << 16); w0.w = v[6] | (v[7] << 16);
          w1.x = v[8] | (v[9] << 16); w1.y = v[10] | (v[11] << 16); w1.z = v[12] | (v[13] << 16); w1.w = v[14] | (v[15] << 16);
          *(LAS u32x4*)(VTl + dv * 72 + 16 * part) = w0; *(LAS u32x4*)(VTl + dv * 72 + 16 * part + 8) = w1; }
        if (OUTPHASE) {
#pragma unroll
            for (int i = 0; i < 2; ++i) { const int c = tid + 512 * i, dv = c >> 3, part = c & 7; *(LAS u32x4*)(SINT + dv * 72 + part * 8) = *(const u32x4*)(SIN + ((size_t)unit[uu] * 128 + dv) * 64 + part * 8); }
            const int dvb_ = wid >> 1, cb_ = wid & 1;
#pragma unroll
            for (int g = 0; g < 4; ++g) { const int d4 = 32 * dvb_ + 8 * g + 4 * hi; ggw[uu][g] = *(const u32x2*)(PROJ + (size_t)(r0[uu] + 32 * cb_ + r32) * PW + C_GG + h[uu] * 128 + d4); ggn[uu][g] = *(const f32x4*)(p.in[I_GGLA] + l * 512 + h[uu] * 128 + d4); }
        }
#pragma unroll
        for (int i = 0; i < 16; ++i) wa[uu][i] = p.in[I_WA2][(size_t)(l * 16 + i) * 256 + h[uu] * 64 + d];
        ba[uu] = p.in[I_BA][l * 256 + h[uu] * 64 + d];
#pragma unroll
        for (int i = 0; i < 8; ++i) { kv[uu][i] = bf2f(PROJ[(size_t)(r0[uu] + 8 * seg + i) * PW + C_GK + h[uu] * 64 + d]); qv[uu][i] = OUTPHASE ? bf2f(PROJ[(size_t)(r0[uu] + 8 * seg + i) * PW + C_GQ + h[uu] * 64 + d]) : 0.f; }
    }
    __syncthreads();
    float cumv[2][8];
#pragma unroll
    for (int uu = 0; uu < 2; ++uu) { LAS unsigned char* lds = lds0 + uu * GL_UOFF; LAS float* GA1 = (LAS float*)(lds + GL_GA1); LAS float* SEG = (LAS float*)(lds + GL_SEG);
        float run = 0.f;
#pragma unroll
        for (int i = 0; i < 8; ++i) { const LAS float* gp = GA1 + (8 * seg + i) * 16; float z = ba[uu];
#pragma unroll
            for (int j = 0; j < 16; ++j) z += gp[j] * wa[uu][j];
            run += log_sigmoid_(z) * (1.0f / 16.0f); cumv[uu][i] = run; }
        SEG[seg * 64 + d] = run; }
    __syncthreads();
#pragma unroll
    for (int uu = 0; uu < 2; ++uu) { LAS unsigned char* lds = lds0 + uu * GL_UOFF; LAS float* SEG = (LAS float*)(lds + GL_SEG); LAS bf16_t* A8 = (LAS bf16_t*)(lds + GL_A8); LAS bf16_t* KIN = (LAS bf16_t*)(lds + GL_KIN);
        float offs = 0.f, total = 0.f;
#pragma unroll
        for (int s = 0; s < 8; ++s) { const float t = SEG[s * 64 + d]; total += t; if (s < seg) offs += t; }
        if (!OUTPHASE) {
            float ko[8];
#pragma unroll
            for (int i = 0; i < 8; ++i) ko[i] = kv[uu][i] * __expf(total - (cumv[uu][i] + offs));
            u32x4 w; w.x = cvt_pk_bf16(ko[0], ko[1]); w.y = cvt_pk_bf16(ko[2], ko[3]); w.z = cvt_pk_bf16(ko[4], ko[5]); w.w = cvt_pk_bf16(ko[6], ko[7]);
            *(LAS u32x4*)(A8 + d * 72 + 8 * seg) = w;
            if (seg == 0) DEC[(size_t)unit[uu] * 64 + d] = __expf(total);
        } else {
#pragma unroll
            for (int i = 0; i < 8; ++i) { const float c = cumv[uu][i] + offs; const int t = 8 * seg + i;
                A8[t * 72 + d] = (bf16_t)(cvt_pk_bf16(qv[uu][i] * 0.125f * __expf(c), 0.f) & 0xffffu);
                KIN[t * 72 + d] = (bf16_t)(cvt_pk_bf16(kv[uu][i] * __expf(-c), 0.f) & 0xffffu); }
        } }
    __syncthreads();
    if (!OUTPHASE) {
        const int dvb = wid >> 1, dkb = wid & 1;
#pragma unroll
        for (int uu = 0; uu < 2; ++uu) { LAS unsigned char* lds = lds0 + uu * GL_UOFF; LAS bf16_t* A8 = (LAS bf16_t*)(lds + GL_A8); LAS bf16_t* VTl = (LAS bf16_t*)(lds + GL_VT);
            f32x16 acc;
#pragma unroll
            for (int r = 0; r < 16; ++r) acc[r] = 0.f;
#pragma unroll
            for (int ks = 0; ks < 4; ++ks) { const bf16x8 a = *(const LAS bf16x8*)(VTl + (32 * dvb + r32) * 72 + 16 * ks + 8 * hi); const bf16x8 b = *(const LAS bf16x8*)(A8 + (32 * dkb + r32) * 72 + 16 * ks + 8 * hi); acc = MFMA32(a, b, acc); }
            float* cs = CS + (size_t)unit[uu] * 8192;
#pragma unroll
            for (int r = 0; r < 16; ++r) cs[(32 * dvb + (r & 3) + 8 * (r >> 2) + 4 * hi) * 64 + 32 * dkb + r32] = acc[r]; }
        __syncthreads();
    } else {
        const int dvb = wid >> 1, cb = wid & 1;
        f32x16 o[2];
#pragma unroll
        for (int uu = 0; uu < 2; ++uu) { LAS unsigned char* lds = lds0 + uu * GL_UOFF; LAS float* SS = (LAS float*)(lds + GL_SS);
            LAS bf16_t* A8 = (LAS bf16_t*)(lds + GL_A8); LAS bf16_t* KIN = (LAS bf16_t*)(lds + GL_KIN); LAS bf16_t* VTl = (LAS bf16_t*)(lds + GL_VT); LAS bf16_t* SINT = (LAS bf16_t*)(lds + GL_SINT);
            f32x16 at[2];
#pragma unroll
            for (int r = 0; r < 16; ++r) { at[0][r] = 0.f; at[1][r] = 0.f; o[uu][r] = 0.f; }
            bf16x8 qb[4];
#pragma unroll
            for (int ks = 0; ks < 4; ++ks) qb[ks] = *(const LAS bf16x8*)(A8 + (32 * cb + r32) * 72 + 16 * ks + 8 * hi);
#pragma unroll
            for (int sb = 0; sb < 2; ++sb) if (sb <= cb) {
#pragma unroll
                for (int ks = 0; ks < 4; ++ks) { const bf16x8 a = *(const LAS bf16x8*)(KIN + (32 * sb + r32) * 72 + 16 * ks + 8 * hi); at[sb] = MFMA32(a, qb[ks], at[sb]); }
                if (sb == cb) {
#pragma unroll
                    for (int r = 0; r < 16; ++r) if ((r & 3) + 8 * (r >> 2) + 4 * hi > r32) at[sb][r] = 0.f;
                }
#pragma unroll
                for (int s = 0; s < 2; ++s) { const bf16x8 pf = pack8(at[sb], s); const LAS bf16_t* vp = VTl + (32 * dvb + r32) * 72 + 32 * sb + 16 * s + 4 * hi;
                    const s16x4 lo = *(const LAS s16x4*)vp, hh = *(const LAS s16x4*)(vp + 8); const bf16x8 a = __builtin_shufflevector(lo, hh, 0, 1, 2, 3, 4, 5, 6, 7);
                    o[uu] = MFMA32(a, pf, o[uu]); }
            }
#pragma unroll
            for (int ks = 0; ks < 4; ++ks) { const bf16x8 a = *(const LAS bf16x8*)(SINT + (32 * dvb + r32) * 72 + 16 * ks + 8 * hi); o[uu] = MFMA32(a, qb[ks], o[uu]); }
            float ss = 0.f;
#pragma unroll
            for (int r = 0; r < 16; ++r) ss += o[uu][r] * o[uu][r];
            ss += __shfl_xor(ss, 32);
            if (hi == 0) SS[dvb * 64 + 32 * cb + r32] = ss; }
        __syncthreads();
#pragma unroll
        for (int uu = 0; uu < 2; ++uu) { if (uu == 1 && unitB == unitA) break;
            LAS unsigned char* lds = lds0 + uu * GL_UOFF; LAS float* SS = (LAS float*)(lds + GL_SS);
            const int c = 32 * cb + r32;
            const float tot = SS[c] + SS[64 + c] + SS[128 + c] + SS[192 + c];
            const float rn = 1.0f / sqrtf(tot * (1.0f / 128.0f) + EPSN);
            const size_t row = (size_t)(r0[uu] + c);
#pragma unroll
            for (int g = 0; g < 4; ++g) { const int d4 = 32 * dvb + 8 * g + 4 * hi;
                const u32x2 gw = ggw[uu][g]; const f32x4 gn = ggn[uu][g];
                const float g0 = bflo(gw.x), g1 = bfhi(gw.x), g2 = bflo(gw.y), g3 = bfhi(gw.y);
                u32x2 w; w.x = cvt_pk_bf16(o[uu][4 * g] * rn * gn[0] * g0 * sigmoidf_(g0), o[uu][4 * g + 1] * rn * gn[1] * g1 * sigmoidf_(g1));
                w.y = cvt_pk_bf16(o[uu][4 * g + 2] * rn * gn[2] * g2 * sigmoidf_(g2), o[uu][4 * g + 3] * rn * gn[3] * g3 * sigmoidf_(g3));
                *(u32x2*)(Y + row * PW + C_GV + h[uu] * 128 + d4) = w; } }
        __syncthreads();
    }
}
#define XB_TMO      128
#define XB_XCNT(j)  (256  + 64 * (j))
#define XB_XSUB(j)  (1280 + 64 * (j))
#define XB_XGEN(j)  (2304 + 64 * (j))
#define XB_TOP      3328
#define XB_TOPGEN   3392
#define XCD_BAR_WORDS 3456
#define XB_SPIN_CAP (1u << 18)

__device__ __forceinline__ unsigned xb_ld(unsigned* p)              { return __hip_atomic_load(p, __ATOMIC_RELAXED, __HIP_MEMORY_SCOPE_AGENT); }
__device__ __forceinline__ unsigned xb_add(unsigned* p, unsigned v) { return __hip_atomic_fetch_add(p, v, __ATOMIC_RELAXED, __HIP_MEMORY_SCOPE_AGENT); }
__device__ __forceinline__ unsigned xb_xcc_id() { return (unsigned)__builtin_amdgcn_s_getreg((3 << 11) | 20) & 0xFu; }
#define XB_SPIN(cond, bar) do { unsigned _sp = 0; while (cond) { __builtin_amdgcn_s_sleep(1); \
    if ((++_sp & 255u) == 0u) { if (xb_ld(&(bar)[XB_TMO])) break; if (_sp > XB_SPIN_CAP) { atomicAdd(&(bar)[XB_TMO], 1u); break; } } } } while (0)

struct XcdBarrier {
    unsigned* bar; unsigned x;
    volatile LAS unsigned* st;
};

__device__ __forceinline__ XcdBarrier xcd_barrier_post(unsigned* bar, volatile LAS unsigned* st) {
    XcdBarrier b; b.bar = bar; b.x = xb_xcc_id(); b.st = st;
    if (threadIdx.x == 0) (void)xb_add(&bar[XB_XCNT(b.x)], 1u);
    return b;
}
__device__ __forceinline__ void xcd_barrier_complete(unsigned* bar, unsigned x, unsigned& nloc, unsigned& nx) {
    const unsigned G = gridDim.x * gridDim.y * gridDim.z;
    unsigned sum, cnt, mine, sp = 0u;
    for (;;) {
        sum = 0u; cnt = 0u; mine = 0u;
#pragma unroll
        for (unsigned j = 0; j < 16; ++j) { const unsigned c = xb_ld(&bar[XB_XCNT(j)]); sum += c; cnt += (c > 0u) ? 1u : 0u; mine = (j == x) ? c : mine; }
        if (sum == G) break;
        __builtin_amdgcn_s_sleep(1);
        if ((++sp & 255u) == 0u) { if (xb_ld(&bar[XB_TMO])) break; if (sp > XB_SPIN_CAP) { atomicAdd(&bar[XB_TMO], 1u); break; } }
    }
    nloc = mine > 0u ? mine : 1u; nx = cnt > 0u ? cnt : 1u;
}

__device__ __forceinline__ void xcd_barrier(const XcdBarrier& b) {
    asm volatile("s_waitcnt vmcnt(0)" ::: "memory");
    __syncthreads();
    if (threadIdx.x == 0) {
        unsigned* bar = b.bar;
        __builtin_amdgcn_s_waitcnt(0);
        unsigned nloc = b.st[0], nx = b.st[1];
        if (nloc == 0u) { xcd_barrier_complete(bar, b.x, nloc, nx); b.st[0] = nloc; b.st[1] = nx; }
        const unsigned old = xb_add(&bar[XB_XSUB(b.x)], 1u);
        const unsigned gen = old / nloc;
        if (old + 1u == (gen + 1u) * nloc) {
            __builtin_amdgcn_fence(__ATOMIC_RELEASE, "agent");
            asm volatile("s_waitcnt vmcnt(0)" ::: "memory");
            const unsigned og = xb_add(&bar[XB_TOP], 1u);
            const unsigned tg = og / nx;
            if (og + 1u == (tg + 1u) * nx) xb_add(&bar[XB_TOPGEN], 1u);
            else XB_SPIN(xb_ld(&bar[XB_TOPGEN]) == tg, bar);
            __builtin_amdgcn_fence(__ATOMIC_ACQUIRE, "agent");
            xb_add(&bar[XB_XGEN(b.x)], 1u);
            asm volatile("s_waitcnt vmcnt(0)" ::: "memory");
        } else {
            XB_SPIN(xb_ld(&bar[XB_XGEN(b.x)]) == gen, bar);
            __builtin_amdgcn_fence(__ATOMIC_ACQUIRE, "agent");
            asm volatile("s_waitcnt vmcnt(0)" ::: "memory");
        }
    }
    __syncthreads();
}
constexpr int LDS_BYTES = 147456;
#define GEMM_PHASE(EPI, g, E) do { pg8::StaticOrder S_; S_.init((g).M, (g).N, G, (int)blockIdx.x); pg8::gemm_phase<EPI, pg8::StaticOrder, true, true>(lds, (g), S_, (E)); } while (0)
__global__ void __launch_bounds__(512, 2) mega_fwd(Params p) {
    extern __shared__ __attribute__((aligned(16))) unsigned char lds_raw[];
    LAS unsigned char* lds = (LAS unsigned char*)lds_raw;
    cg::grid_group grid = cg::this_grid();
    const int G = gridDim.x, bx = blockIdx.x, NGW = G * 8;
#define PH_BEGIN int tid = threadIdx.x; asm volatile("" : "+v"(tid)); const int lane = tid & 63, wid = __builtin_amdgcn_readfirstlane(tid >> 6), gw = bx * 8 + wid; size_t wso_ = 0; asm volatile("" : "+s"(wso_)); unsigned char* ws = p.ws + wso_; (void)lane; (void)gw; (void)ws;
#define WIN ((bf16_t*)(ws + WS_WIN))
#define WMEM ((bf16_t*)(ws + WS_WMEM))
#define WBR ((bf16_t*)(ws + WS_WBR))
#define WOUT ((bf16_t*)(ws + WS_WOUT))
#define WGU ((bf16_t*)(ws + WS_WGU))
#define WDN ((bf16_t*)(ws + WS_WDN))
#define MEMN ((bf16_t*)(ws + WS_MEMN))
#define MKV ((bf16_t*)(ws + WS_MKV))
#define MKN ((bf16_t*)(ws + WS_MKN))
#define MVT ((bf16_t*)(ws + WS_MVT))
#define CUMF ((float*)(ws + WS_CUMF))
#define DEC ((float*)(ws + WS_DEC))
#define VTF ((bf16_t*)(ws + WS_VTF))
#define SIN ((bf16_t*)(ws + WS_SIN))
#define CS ((float*)(ws + WS_CS))
#define MRG ((bf16_t*)((unsigned char*)p.out + (size_t)32 * 1048576))
#define XBF ((bf16_t*)(ws + WS_XBF))
#define KC ((bf16_t*)p.out)
#define SSQ ((float*)(ws + WS_SSQ))
#define PROJ ((bf16_t*)(ws + WS_PROJ))
#define HB ((bf16_t*)(ws + WS_PROJ))

    volatile LAS unsigned* MISC = (volatile LAS unsigned*)(lds + LDS_BYTES - 64);
    if (threadIdx.x < 16) MISC[threadIdx.x] = 0u;
    __syncthreads();
    const XcdBarrier bar = xcd_barrier_post((unsigned*)(p.ws + WS_BAR), MISC);
#define GSYNC() xcd_barrier(bar)
    { PH_BEGIN
        LAS float* scr = (LAS float*)(lds + wid * 16384);
        constexpr int PER_L = 3456 + 512 + 768 + 512 + 2816 + 1408;
        for (int it = gw; it < NL * PER_L; it += NGW) {
            const int l = it / PER_L; int r = it % PER_L; const int ln = lane & 31;
            if (r < 3456) { const int kb = r / 216, nb = r % 216; transpose_item(p.in[I_WIN] + (size_t)l * 1024 * INW, 1024, INW, p.in[I_GMIX] + l * 1024, WIN + (size_t)l * PW * 1024, scr, kb, nb, lane, inmap(nb * 32 + ln)); continue; } r -= 3456;
            if (r < 512) { const int kb = r / 32, nb = r % 32; transpose_item(p.in[I_WMKV] + (size_t)l * 1024 * 1024, 1024, 1024, p.in[I_GMEM] + l * 1024, WMEM + (size_t)l * 1024 * 1024, scr, kb, nb, lane, nb * 32 + ln); continue; } r -= 512;
            if (r < 768) { const int i = r / 256, r2 = r % 256, kb = r2 / 32, nb = r2 % 32; transpose_item(p.in[I_WBR] + (size_t)(l * 3 + i) * 512 * 1024, 512, 1024, nullptr, WBR + (size_t)(l * 3 + i) * 1024 * 512, scr, kb, nb, lane, nb * 32 + ln); continue; } r -= 768;
            if (r < 512) { const int kb = r / 32, nb = r % 32; transpose_item(p.in[I_WOUT] + (size_t)l * 1024 * 1024, 1024, 1024, nullptr, WOUT + (size_t)l * 1024 * 1024, scr, kb, nb, lane, nb * 32 + ln); continue; } r -= 512;
            if (r < 2816) { const int kb = r / 176, nb = r % 176, n0 = nb * 32, t = n0 >> 8, rr = n0 & 255; const bool isup = rr >= 128;
                transpose_item((isup ? p.in[I_WFU] : p.in[I_WFG]) + (size_t)l * 1024 * DFF, 1024, DFF, p.in[I_GFFN] + l * 1024, WGU + (size_t)l * 5632 * 1024, scr, kb, nb, lane, 128 * t + (rr & 127) + ln); continue; } r -= 2816;
            { const int kb = r / 32, nb = r % 32; transpose_item(p.in[I_WFD] + (size_t)l * DFF * 1024, DFF, 1024, nullptr, WDN + (size_t)l * 1024 * DFF, scr, kb, nb, lane, nb * 32 + ln); }
        }
        norm_rows(p.in[I_MEM], MEMN, 1024, gw, NGW, lane);
        if (bx == 0 && tid < NL) {
            float am = 0.f, cm = 0.f;
            for (int i = 0; i < 128; ++i) { am = fmaxf(am, fabsf(p.in[I_GFQ][tid * 128 + i])); cm = fmaxf(cm, fabsf(p.in[I_GFK][tid * 128 + i])); }
            ((float*)(ws + WS_TSK))[tid] = 104.0f + 2.0f * 11.3137085f * am * cm * 1.01f + 1.0f;
        }
    }
    grid.sync();
    { PH_BEGIN pg8::Gemm g{MEMN, WMEM, 1024, 4096, 1024, 1024}; pg8::EpiStore E{MKV, 4096, nullptr}; GEMM_PHASE(pg8::EpiStore, g, E);
      if (G > 64) { if (bx >= 64) xb_rows(p.in[I_X], XBF, SSQ, 2 * MH, (bx - 64) * 8 + wid, (G - 64) * 8, lane); }
      else xb_rows(p.in[I_X], XBF, SSQ, 2 * MH, gw, NGW, lane); }
    GSYNC();
    { PH_BEGIN for (int u = bx; u < 256; u += G) { const int l = u >> 6, b = (u >> 4) & 3, h = (u >> 2) & 3, t = u & 3;
        const bf16_t* src = MKV + (size_t)(b * 256 + t * 64) * 4096 + l * 1024 + h * 128;
        norm128_rows64(src, 4096, MKN + ((size_t)(l * 4 + b) * 256 + t * 64) * 512 + h * 128, 512, p.in[I_GMK] + l * 128, 1.0f, tid);
        vt_tile(src + 512, 4096, MVT + ((size_t)((l * 4 + b) * 4 + h) * 128) * 256 + t * 64, 256, (LAS bf16_t*)lds, tid); } }
    for (int l = 0; l < NL; ++l) {
        for (int hf = 0; hf < 2; ++hf) {
            { PH_BEGIN pg8::Gemm g{XBF + (size_t)hf * MH * 1024, WIN + (size_t)l * PW * 1024, MH, PW, 1024, 1024}; pg8::EpiStore E{PROJ, PW, SSQ + (size_t)hf * MH * 16}; GEMM_PHASE(pg8::EpiStore, g, E); }
            GSYNC();
            { PH_BEGIN const int tid0_ = tid;
              for (int u = bx; u < 32; u += G) { int tid = tid0_; asm volatile("" : "+v"(tid)); const int lane = tid & 63;
                    const int bhp = u >> 2, sg = u & 3, bp = bhp >> 2, h = bhp & 3; const float fb = p.in[I_BFOX][l * 4 + h];
                    float loc[4]; float run = 0.f;
#pragma unroll
                    for (int i = 0; i < 4; ++i) { const float x = bf2f(PROJ[(size_t)(bp * SEQ + sg * 2048 + 4 * tid + i) * PW + C_FF + h]) + fb; run += log_sigmoid_(x); loc[i] = run; }
                    float sc = run;
#pragma unroll
                    for (int o = 1; o < 64; o <<= 1) { const float t = __shfl_up(sc, o); if (lane >= o) sc += t; }
                    LAS float* wt = (LAS float*)lds;
                    if (lane == 63) wt[wid] = sc;
                    __syncthreads();
                    float offs = sc - run;
                    for (int w = 0; w < wid; ++w) offs += wt[w];
                    *(f32x4*)(CUMF + (size_t)bhp * SEQ + sg * 2048 + 4 * tid) = (f32x4){loc[0] + offs, loc[1] + offs, loc[2] + offs, loc[3] + offs};
                    if (tid == 511) ((float*)(ws + WS_TSK))[16 + u] = loc[3] + offs;
                    __syncthreads();
              }
              for (int v0 = bx; v0 < 1024; v0 += 4 * G) { int tid = tid0_; asm volatile("" : "+v"(tid)); prep_batch(PROJ, p.in[I_GFK] + l * 128, KC, VTF, (LAS bf16_t*)lds, v0, G, tid); }
              for (int u = bx; u < 1024; u += 2 * G) { int tid = tid0_; asm volatile("" : "+v"(tid)); const int lane = tid & 63; gla_pair<false>(lds, p, l, u, (u + G < 1024 ? u + G : u), PROJ, CS, DEC, SIN, PROJ, tid, lane, wid); }
              for (int v = bx; v < 256; v += G) { int tid = tid0_; asm volatile("" : "+v"(tid)); const int lane = tid & 63;
                    const int rb = v >> 2, h = v & 3, r0 = rb * 256, bp = r0 / SEQ, b = hf * 2 + bp;
                    attn_unit<false>(lds, p.in[I_GMQ] + l * 128, PROJ + (size_t)r0 * PW + C_MQ + h * 128, PW, MKN + ((size_t)(l * 4 + b) * 256) * 512 + h * 128, 512,
                                     MVT + ((size_t)((l * 4 + b) * 4 + h) * 128) * 256, 256, 64, nullptr, 0.f, 0.f, 0.f, 0.f, 0, 0, 3, PROJ + (size_t)r0 * PW + C_MQ + h * 128, PW, tid, lane, wid);
              }
            }
            GSYNC();
            { PH_BEGIN
                for (int u = bx; u < 512; u += G) {
                    typedef float f32x2v __attribute__((ext_vector_type(2)));
                    const int e2 = u * 64 + lane, bhp = e2 >> 12, dvdk = (e2 & 4095) * 2, dk = dvdk & 63, seg = wid;
                    f32x2v c[16], d[16];
#pragma unroll
                    for (int i = 0; i < 16; ++i) { const size_t unit = (size_t)bhp * 128 + seg * 16 + i; c[i] = *(const f32x2v*)(CS + unit * 8192 + dvdk); d[i] = *(const f32x2v*)(DEC + unit * 64 + dk); }
                    f32x2v sl[16], pl[16]; f32x2v sacc = (f32x2v){0.f, 0.f}, pacc = (f32x2v){1.f, 1.f};
#pragma unroll
                    for (int i = 0; i < 16; ++i) { sl[i] = sacc; pl[i] = pacc; sacc = d[i] * sacc + c[i]; pacc = pacc * d[i]; }
                    LAS f32x4* AB = (LAS f32x4*)lds;
                    AB[seg * 64 + lane] = (f32x4){pacc.x, pacc.y, sacc.x, sacc.y};
                    __syncthreads();
                    f32x2v s0 = (f32x2v){0.f, 0.f};
                    for (int j = 0; j < seg; ++j) { const f32x4 ab = AB[j * 64 + lane]; s0 = (f32x2v){ab[0] * s0.x + ab[2], ab[1] * s0.y + ab[3]}; }
#pragma unroll
                    for (int i = 0; i < 16; ++i) { const size_t unit = (size_t)bhp * 128 + seg * 16 + i; const f32x2v v = sl[i] + pl[i] * s0;
                        *(unsigned*)(SIN + unit * 8192 + dvdk) = cvt_pk_bf16(v.x, v.y); }
                    __syncthreads();
                }
                const int nf = G, fidx = bx;
                const int tid0_ = tid; if (fidx >= 0) for (int u = fidx; u < 256; u += nf) { int tid = tid0_; asm volatile("" : "+v"(tid)); const int lane = tid & 63;
                    const int qb = 31 - (u >> 3), bhp = u & 7, bp = bhp >> 2, h = bhp & 3, q0 = qb * 256; const size_t r0 = (size_t)bp * SEQ + q0;
                    const float* cum = CUMF + (size_t)bhp * SEQ; const float* sgt = (const float*)(ws + WS_TSK) + 16 + bhp * 4;
                    const float o1 = sgt[0], o2 = o1 + sgt[1], o3 = o2 + sgt[2];
                    const int sq_ = q0 >> 11; const float cref = cum[q0] + (sq_ == 0 ? 0.f : sq_ == 1 ? o1 : sq_ == 2 ? o2 : o3);
                    int j0 = 0;
#if FOX_SKIP
                    {
                        const float T = ((const float*)(ws + WS_TSK))[l];
                        const int nt = q0 >> 6;
                        int cnt = 0;
                        if (tid < nt) { const int sk_ = tid >> 5; cnt = (cref - (cum[64 * tid + 63] + (sk_ == 0 ? 0.f : sk_ == 1 ? o1 : sk_ == 2 ? o2 : o3)) < -T) ? 1 : 0; }
                        const unsigned long long bal = __ballot(cnt);
                        LAS int* red = (LAS int*)(lds + 73728);
                        if (lane == 0 && wid < 2) red[wid] = __popcll(bal);
                        __syncthreads();
                        j0 = red[0] + red[1];
                    }
#endif
                    attn_unit<true>(lds, p.in[I_GFQ] + l * 128, PROJ + r0 * PW + C_FQ + h * 128, PW, KC + (size_t)bhp * SEQ * 128, 128, VTF + ((size_t)bhp * 128) * SEQ, 64, 8192,
                                    cum, cref, o1, o2, o3, q0, j0, (q0 >> 6) + 3, PROJ + r0 * PW + C_FQ + h * 128, PW, tid, lane, wid);
                }
            }
            GSYNC();
            { PH_BEGIN const int tid0_ = tid; for (int u = bx; u < 1024; u += 2 * G) { int tid = tid0_; asm volatile("" : "+v"(tid)); const int lane = tid & 63; gla_pair<true>(lds, p, l, u, (u + G < 1024 ? u + G : u), PROJ, CS, DEC, SIN, PROJ, tid, lane, wid); } }
            GSYNC();
            { PH_BEGIN
                pg8::Gemm g{PROJ, WBR + (size_t)l * 3 * 1024 * 512, MH, 3072, 512, PW};
                pg8::EpiGate E{PROJ + C_BG, PW, p.in[I_BGATE] + l * 3072, MRG + (size_t)hf * MH * 1024, 1024};
                pg8::BranchOrder S_; S_.init(MH, G, (int)blockIdx.x); static_assert(C_GV * 2 == 1024 && C_FQ * 2 == 3072 && C_MQ * 2 == 6144, "BranchOrder offsets"); pg8::gemm_phase<pg8::EpiGate, pg8::BranchOrder, true, true>(lds, g, S_, E);
            }
            GSYNC();
        }
        { PH_BEGIN pg8::Gemm g{MRG, WOUT + (size_t)l * 1024 * 1024, 2 * MH, 1024, 1024, 1024}; pg8::EpiResid E{nullptr, XBF, SSQ}; GEMM_PHASE(pg8::EpiResid, g, E); }
        GSYNC();
        { PH_BEGIN pg8::Gemm g{XBF, WGU + (size_t)l * 5632 * 1024, 2 * MH, 5632, 1024, 1024}; pg8::EpiSwiglu E{HB, DFF, SSQ}; GEMM_PHASE(pg8::EpiSwiglu, g, E); }
        GSYNC();
        { PH_BEGIN pg8::Gemm g{HB, WDN + (size_t)l * 1024 * DFF, 2 * MH, 1024, DFF, DFF}; pg8::EpiResid E{l == NL - 1 ? p.out : nullptr, XBF, SSQ}; GEMM_PHASE(pg8::EpiResid, g, E); }
        GSYNC();
    }
}

extern "C" void kernel_launch(void* const* d_in, const int* in_sizes, int n_in, void* d_out, int out_size, void* d_ws, size_t ws_size, hipStream_t stream) {
    static int grid = 0;
    if (grid == 0) {
        int dev = 0, cus = 0, per_cu = 0;
        hipGetDevice(&dev); hipDeviceGetAttribute(&cus, hipDeviceAttributeMultiprocessorCount, dev);
        hipFuncSetAttribute((const void*)mega_fwd, hipFuncAttributeMaxDynamicSharedMemorySize, LDS_BYTES);
        hipOccupancyMaxActiveBlocksPerMultiprocessor(&per_cu, (const void*)mega_fwd, 512, LDS_BYTES);
        if (per_cu < 1) { fprintf(stderr, "kernel_launch: occupancy query says %d blocks/CU\n", per_cu); per_cu = 1; }
        grid = cus * 1;
        if (ws_size < WS_END) { fprintf(stderr, "kernel_launch: workspace too small: %zu < %zu\n", ws_size, (size_t)WS_END); grid = -1; }
        (void)hipGetLastError();
    }
    if (grid < 0) return;
    Params p{};
    for (int i = 0; i < 21; ++i) p.in[i] = (const float*)d_in[i];
    p.out = (float*)d_out; p.ws = (unsigned char*)d_ws;
    hipMemsetAsync((unsigned char*)d_ws + WS_BAR, 0, 16384, stream);
    void* args[] = {&p};
    hipError_t e = hipLaunchCooperativeKernel((const void*)mega_fwd, dim3(grid), dim3(512), args, LDS_BYTES, stream);
    if (e != hipSuccess) fprintf(stderr, "cooperative launch failed: %s (grid %d)\n", hipGetErrorString(e), grid);
}
```

```cpp
#include <hip/hip_runtime.h>
#include <hip/hip_cooperative_groups.h>
#include <cstdio>
#include <cstdint>
#include <cmath>
namespace cg = cooperative_groups;
namespace pg8 {
#define PG8_LAS __attribute__((address_space(3)))
typedef unsigned short bf16_t;
typedef short bf16x8 __attribute__((ext_vector_type(8)));
typedef float f32x4 __attribute__((ext_vector_type(4)));
typedef unsigned u32x4 __attribute__((ext_vector_type(4)));
constexpr int BM = 256, BK = 64, HALF = 128, HTB = HALF * BK * 2  , STAGE_BYTES = 8 * HTB, NXCD = 8, WGM = 8;

__host__ __device__ __forceinline__ int lds_byte(int r, int c) { const int st = (r >> 4) * 2 + (c >> 5), rr = r & 15, cc = c & 31, ob = rr * 64 + cc * 2; return st * 1024 + (ob ^ (((ob >> 9) & 1) << 5)); }
__host__ __device__ __forceinline__ void stage_rc(int b, int& R, int& C) { const int st = b / 1024, sb = b % 1024, swz = sb ^ (((sb >> 9) & 1) << 5); R = (st >> 1) * 16 + swz / 64; C = (st & 1) * 32 + (swz % 64) / 2; }
__host__ __device__ __forceinline__ int perm32(int rho) { const int n = rho >> 4, i = rho & 15; return 8 * (i >> 2) + 4 * n + (i & 3); }

struct Unit { int pm, pn, aoff; };
struct Gemm { const bf16_t* A; const bf16_t* Bt; int M, N, K, lda; };

struct StaticOrder {
    int nM, nN, nwg, G, c;
    __host__ __device__ void init(int M, int N, int G_, int c_) { nM = M / BM; nN = N / BM; nwg = nM * nN; G = G_; c = c_; }
    __host__ __device__ bool next(int i, Unit& u) const {
        const long L = (long)i * G + c; if (L >= nwg) return false;
        int wgid = (int)L; { const int q = nwg / NXCD, r = nwg % NXCD, xcd = wgid % NXCD, off = wgid / NXCD; wgid = (xcd < r ? xcd * (q + 1) : r * (q + 1) + (xcd - r) * q) + off; }
        const int nig = WGM * nN, gid = wgid / nig, fm = gid * WGM, gsz = (nM - fm) < WGM ? (nM - fm) : WGM;
        u.pm = fm + ((wgid % nig) % gsz); u.pn = (wgid % nig) / gsz; u.aoff = 0; return true;
    }
    __device__ __forceinline__ void a_ready(const Unit&) const {}
    __device__ __forceinline__ void done(const Unit&) const {}
};
struct BranchOrder {
    StaticOrder S0;
    __host__ __device__ void init(int M, int G_, int c_) { S0.init(M, 1024, G_, c_); }
    __host__ __device__ bool next(int i, Unit& u) const { const int r = i / 3, b = i - 3 * r; if (!S0.next(r, u)) return false; u.pn += 4 * b; u.aoff = 1024 * (1 + 2 * b + (b >> 1)); return true; }
    __device__ __forceinline__ void a_ready(const Unit&) const {}
    __device__ __forceinline__ void done(const Unit&) const {}
};

__device__ __forceinline__ unsigned cvt_pk_bf16(float lo, float hi) { unsigned r; asm volatile("v_cvt_pk_bf16_f32 %0, %1, %2" : "=v"(r) : "v"(lo), "v"(hi)); return r; }
typedef float f32x2 __attribute__((ext_vector_type(2)));
typedef float f32x2 __attribute__((ext_vector_type(2)));
__device__ __forceinline__ float bf2f(unsigned short b) { return __uint_as_float((unsigned)b << 16); }
__device__ __forceinline__ float bflo(unsigned w) { return __uint_as_float(w << 16); }
__device__ __forceinline__ float bfhi(unsigned w) { return __uint_as_float(w & 0xffff0000u); }
__device__ __forceinline__ float sigmoidf_(float x) { return __builtin_amdgcn_rcpf(1.0f + __builtin_amdgcn_exp2f(-1.4426950408889634f * x)); }
__device__ __forceinline__ float row_rs(const float* ssq, size_t row, int fq) {
    const f32x4 q = *(const f32x4*)(ssq + row * 16 + 4 * fq); float s = (q[0] + q[1]) + (q[2] + q[3]);
    s += __shfl_xor(s, 16); s += __shfl_xor(s, 32);
    return __builtin_amdgcn_rsqf(s * (1.0f / 1024.0f) + 1e-6f);
}
struct EpiStore {
    static constexpr bool PERM = true, AFTER_DRAIN = false;
    bf16_t* O; int ldc; const float* ssq;
    __device__ __forceinline__ void operator()(const f32x4 (&acc)[2][2][4][2], const Unit& u, int wr, int wc, int fr, int fq) const {
        const int row0 = u.pm * BM + wr * 64 + fr, col0 = u.pn * BM + wc * 32 + 8 * fq;
#pragma unroll
        for (int ai = 0; ai < 2; ++ai)
#pragma unroll
            for (int m = 0; m < 4; ++m) { const size_t row = (size_t)(row0 + ai * HALF + m * 16); bf16_t* rowp = O + row * ldc + col0;
                const float rs = ssq ? row_rs(ssq, row, fq) : 1.0f;
#pragma unroll
                for (int bj = 0; bj < 2; ++bj) { const f32x4 v0 = acc[ai][bj][m][0] * rs, v1 = acc[ai][bj][m][1] * rs;
                    u32x4 w; w.x = cvt_pk_bf16(v0[0], v0[1]); w.y = cvt_pk_bf16(v0[2], v0[3]); w.z = cvt_pk_bf16(v1[0], v1[1]); w.w = cvt_pk_bf16(v1[2], v1[3]);
                    *(u32x4*)(rowp + bj * HALF) = w; } }
    }
};
struct EpiGate {
    static constexpr bool PERM = true, AFTER_DRAIN = false;
    const bf16_t* G; int ldg; const float* bias; bf16_t* O; int ldc;
    __device__ __forceinline__ void operator()(const f32x4 (&acc)[2][2][4][2], const Unit& u, int wr, int wc, int fr, int fq) const {
        const int row0 = u.pm * BM + wr * 64 + fr, gcol0 = u.pn * BM + wc * 32 + 8 * fq, col0 = (u.pn & 3) * BM + wc * 32 + 8 * fq; const bool first = u.pn < 4;
#pragma unroll
        for (int bj = 0; bj < 2; ++bj) {
            const f32x4 b0 = *(const f32x4*)(bias + gcol0 + bj * HALF), b1 = *(const f32x4*)(bias + gcol0 + bj * HALF + 4);
#pragma unroll
            for (int ai = 0; ai < 2; ++ai)
#pragma unroll
                for (int m = 0; m < 4; ++m) { const size_t r = (size_t)(row0 + ai * HALF + m * 16);
                    const u32x4 gw = *(const u32x4*)(G + r * ldg + gcol0 + bj * HALF);
                    bf16_t* op = O + r * ldc + col0 + bj * HALF;
                    u32x4 pw = (u32x4){0u, 0u, 0u, 0u}; if (!first) pw = *(const u32x4*)op;
                    const f32x4 v0 = acc[ai][bj][m][0], v1 = acc[ai][bj][m][1];
                    float r0 = bflo(pw.x) + sigmoidf_(bflo(gw.x) + b0[0]) * v0[0], r1 = bfhi(pw.x) + sigmoidf_(bfhi(gw.x) + b0[1]) * v0[1];
                    float r2 = bflo(pw.y) + sigmoidf_(bflo(gw.y) + b0[2]) * v0[2], r3 = bfhi(pw.y) + sigmoidf_(bfhi(gw.y) + b0[3]) * v0[3];
                    float r4 = bflo(pw.z) + sigmoidf_(bflo(gw.z) + b1[0]) * v1[0], r5 = bfhi(pw.z) + sigmoidf_(bfhi(gw.z) + b1[1]) * v1[1];
                    float r6 = bflo(pw.w) + sigmoidf_(bflo(gw.w) + b1[2]) * v1[2], r7 = bfhi(pw.w) + sigmoidf_(bfhi(gw.w) + b1[3]) * v1[3];
                    u32x4 w; w.x = cvt_pk_bf16(r0, r1); w.y = cvt_pk_bf16(r2, r3); w.z = cvt_pk_bf16(r4, r5); w.w = cvt_pk_bf16(r6, r7);
                    *(u32x4*)op = w; }
        }
    }
};
struct EpiResid {
    static constexpr bool PERM = true, AFTER_DRAIN = false;
    float* out; bf16_t* xb; float* ssq;
    __device__ __forceinline__ void operator()(const f32x4 (&acc)[2][2][4][2], const Unit& u, int wr, int wc, int fr, int fq) const {
        const int row0 = u.pm * BM + wr * 64 + fr, col0 = u.pn * BM + wc * 32 + 8 * fq;
#pragma unroll
        for (int ai = 0; ai < 2; ++ai)
#pragma unroll
            for (int m = 0; m < 4; ++m) { const size_t row = (size_t)(row0 + ai * HALF + m * 16), off = row * 1024 + col0; float ss = 0.f;
#pragma unroll
                for (int bj = 0; bj < 2; ++bj) {
                    const u32x4 rw = *(const u32x4*)(xb + off + bj * HALF);
                    const f32x4 a = (f32x4){bflo(rw.x), bfhi(rw.x), bflo(rw.y), bfhi(rw.y)} + acc[ai][bj][m][0], b = (f32x4){bflo(rw.z), bfhi(rw.z), bflo(rw.w), bfhi(rw.w)} + acc[ai][bj][m][1];
                    if (out) { *(f32x4*)(out + off + bj * HALF) = a; *(f32x4*)(out + off + bj * HALF + 4) = b; }
                    ss += (a[0] * a[0] + a[1] * a[1]) + (a[2] * a[2] + a[3] * a[3]) + (b[0] * b[0] + b[1] * b[1]) + (b[2] * b[2] + b[3] * b[3]);
                    u32x4 w; w.x = cvt_pk_bf16(a[0], a[1]); w.y = cvt_pk_bf16(a[2], a[3]); w.z = cvt_pk_bf16(b[0], b[1]); w.w = cvt_pk_bf16(b[2], b[3]);
                    *(u32x4*)(xb + off + bj * HALF) = w; }
                ss += __shfl_xor(ss, 16); ss += __shfl_xor(ss, 32);
                if (fq == 0) ssq[row * 16 + u.pn * 4 + wc] = ss; }
    }
};
struct EpiSwiglu {
    static constexpr bool PERM = true, AFTER_DRAIN = false;
    bf16_t* O; int ldc; const float* ssq;
    __device__ __forceinline__ void operator()(const f32x4 (&acc)[2][2][4][2], const Unit& u, int wr, int wc, int fr, int fq) const {
        const int row0 = u.pm * BM + wr * 64 + fr, col0 = u.pn * HALF + wc * 32 + 8 * fq;
#pragma unroll
        for (int ai = 0; ai < 2; ++ai)
#pragma unroll
            for (int m = 0; m < 4; ++m) { float h[8]; const float rs = row_rs(ssq, (size_t)(row0 + ai * HALF + m * 16), fq);
#pragma unroll
                for (int n = 0; n < 2; ++n)
#pragma unroll
                    for (int j = 0; j < 4; ++j) { const float gt = acc[ai][0][m][n][j] * rs, up = acc[ai][1][m][n][j] * rs; h[4 * n + j] = gt * sigmoidf_(gt) * up; }
                u32x4 w; w.x = cvt_pk_bf16(h[0], h[1]); w.y = cvt_pk_bf16(h[2], h[3]); w.z = cvt_pk_bf16(h[4], h[5]); w.w = cvt_pk_bf16(h[6], h[7]);
                *(u32x4*)(O + (size_t)(row0 + ai * HALF + m * 16) * ldc + col0) = w; }
    }
};
template <class Epi, class Sched, bool ALIGN_EPI = false, bool SP2 = false>
__device__ __forceinline__ void gemm_phase(PG8_LAS unsigned char* lds, const Gemm g, const Sched& S, const Epi& E) {
    int tid_ = threadIdx.x; asm volatile("" : "+v"(tid_)); const int tid = tid_, wid = __builtin_amdgcn_readfirstlane(tid >> 6), lane = tid & 63, wr = wid >> 2, wc = wid & 3, fr = lane & 15, fq = lane >> 4;
    const int K = g.K, nt = K / BK;
    unsigned voffA[2], voffB[2];
#pragma unroll
    for (int i = 0; i < 2; ++i) { int R, C; stage_rc(tid * 16 + i * 8192, R, C); const int Rb = Epi::PERM ? ((R & ~31) + perm32(R & 31)) : R;
        voffA[i] = (unsigned)(R * g.lda + C) * 2u; voffB[i] = (unsigned)(Rb * K + C) * 2u; }
    const size_t kstep = (size_t)(BK * 2);
    const size_t hstepA = (size_t)HALF * g.lda * 2, hstepB = (size_t)HALF * K * 2;
    const size_t tstepA = 2 * hstepA, tstepB = 2 * hstepB;
    const unsigned ldsw = (unsigned)wid * 1024u;
    const int aoff = lds_byte(wr * 64 + fr, fq * 8), boff = lds_byte(wc * 32 + fr, fq * 8);
#define PG8_SA(b, h) (((b) * 2 + (h)) * HTB)
#define PG8_SB(b, h) ((4 + (b) * 2 + (h)) * HTB)
#define PG8_STAGE(bufoff, gbase, voff) do { _Pragma("unroll") for (int _i = 0; _i < 2; ++_i) \
        __builtin_amdgcn_global_load_lds((const unsigned*)((const char*)(gbase) + (voff)[_i]), (PG8_LAS unsigned*)(lds + (bufoff) + ldsw + _i * 8192), 16, 0, 0); } while (0)
#define PG8_LDA(dst, b, h) do { _Pragma("unroll") for (int m = 0; m < 4; ++m) _Pragma("unroll") for (int k = 0; k < 2; ++k) dst[m][k] = *(const PG8_LAS bf16x8*)(lds + PG8_SA(b, h) + aoff + m * 2048 + k * 1024); } while (0)
#define PG8_LDB(dst, b, h) do { _Pragma("unroll") for (int n = 0; n < 2; ++n) _Pragma("unroll") for (int k = 0; k < 2; ++k) dst[n][k] = *(const PG8_LAS bf16x8*)(lds + PG8_SB(b, h) + boff + n * 2048 + k * 1024); } while (0)
#define PG8_MMA(ai, bj, At, Bt) do { __builtin_amdgcn_s_setprio(1); _Pragma("unroll") for (int m = 0; m < 4; ++m) _Pragma("unroll") for (int n = 0; n < 2; ++n) _Pragma("unroll") for (int k = 0; k < 2; ++k) \
        acc[ai][bj][m][n] = __builtin_amdgcn_mfma_f32_16x16x32_bf16(Bt[n][k], At[m][k], acc[ai][bj][m][n], 0, 0, 0); __builtin_amdgcn_s_setprio(0); } while (0)
#define PG8_WAIT_V(n) asm volatile("s_waitcnt vmcnt(" #n ")" ::: "memory")
#define PG8_WAIT_L(n) asm volatile("s_waitcnt lgkmcnt(" #n ")" ::: "memory")
#define PG8_BAR __builtin_amdgcn_s_barrier()
#define PG8_SCHED __builtin_amdgcn_sched_barrier(0)
    Unit cur, nxt; int ui = 0;
    if (!S.next(0, cur)) return;
    f32x4 acc[2][2][4][2];
#pragma unroll
    for (int a = 0; a < 2; ++a)
#pragma unroll
        for (int b = 0; b < 2; ++b)
#pragma unroll
            for (int m = 0; m < 4; ++m)
#pragma unroll
                for (int n = 0; n < 2; ++n) acc[a][b][m][n] = (f32x4){0.f, 0.f, 0.f, 0.f};
    bf16x8 At[4][2], B0[2][2], B1[2][2];
    const char* cA = (const char*)g.A + (size_t)cur.pm * tstepA + cur.aoff; const char* cB = (const char*)g.Bt + (size_t)cur.pn * tstepB;
    S.a_ready(cur);
    if constexpr (SP2) {
        PG8_STAGE(PG8_SB(0, 0), cB, voffB); PG8_STAGE(PG8_SB(0, 1), cB + hstepB, voffB); PG8_STAGE(PG8_SA(0, 0), cA, voffA); PG8_STAGE(PG8_SA(0, 1), cA + hstepA, voffA);
        if (wr == 1) PG8_BAR;
        PG8_WAIT_V(2); PG8_BAR;
        PG8_STAGE(PG8_SB(1, 0), cB + kstep, voffB); PG8_STAGE(PG8_SA(1, 0), cA + kstep, voffA); PG8_STAGE(PG8_SB(1, 1), cB + hstepB + kstep, voffB);
        PG8_WAIT_V(6); PG8_BAR;
    } else {
        PG8_STAGE(PG8_SB(0, 0), cB, voffB); PG8_STAGE(PG8_SA(0, 0), cA, voffA); PG8_STAGE(PG8_SB(0, 1), cB + hstepB, voffB); PG8_STAGE(PG8_SA(0, 1), cA + hstepA, voffA);
        if (wr == 1) PG8_BAR;
        PG8_WAIT_V(4); PG8_BAR;
        PG8_STAGE(PG8_SB(1, 0), cB + kstep, voffB); PG8_STAGE(PG8_SA(1, 0), cA + kstep, voffA); PG8_STAGE(PG8_SB(1, 1), cB + hstepB + kstep, voffB);
        PG8_WAIT_V(6); PG8_BAR;
    }
    for (;;) {
        const bool has_next = S.next(ui + 1, nxt);
        const char* nA = has_next ? (const char*)g.A + (size_t)nxt.pm * tstepA + nxt.aoff : cA; const char* nB = has_next ? (const char*)g.Bt + (size_t)nxt.pn * tstepB : cB;
        for (int t = 0; t < nt; t += 2) {
            const bool last = (t == nt - 2);
            const char* a1 = cA + (size_t)(t + 1) * kstep;
            const char* a2 = last ? nA : cA + (size_t)(t + 2) * kstep; const char* b2 = last ? nB : cB + (size_t)(t + 2) * kstep;
            const char* a3 = a2 + kstep; const char* b3 = b2 + kstep;
            if (last && has_next) S.a_ready(nxt);
            if constexpr (SP2) {
            PG8_LDB(B0, 0, 0); PG8_LDB(B1, 0, 1); PG8_SCHED; PG8_LDA(At, 0, 0); PG8_STAGE(PG8_SA(1, 1), a1 + hstepA, voffA);
            PG8_WAIT_V(8); PG8_WAIT_L(0); PG8_BAR; PG8_MMA(0, 0, At, B0); PG8_MMA(0, 1, At, B1); PG8_BAR; PG8_SCHED;
            PG8_LDA(At, 0, 1); PG8_STAGE(PG8_SB(0, 0), b2, voffB); PG8_STAGE(PG8_SB(0, 1), b2 + hstepB, voffB); PG8_STAGE(PG8_SA(0, 0), a2, voffA);
            PG8_WAIT_V(8); PG8_WAIT_L(0); PG8_BAR; PG8_MMA(1, 0, At, B0); PG8_MMA(1, 1, At, B1); PG8_BAR; PG8_SCHED;
            PG8_LDB(B0, 1, 0); PG8_LDB(B1, 1, 1); PG8_SCHED; PG8_LDA(At, 1, 0); PG8_STAGE(PG8_SA(0, 1), a2 + hstepA, voffA);
            PG8_WAIT_V(8); PG8_WAIT_L(0); PG8_BAR; PG8_MMA(0, 0, At, B0); PG8_MMA(0, 1, At, B1); PG8_BAR; PG8_SCHED;
            PG8_LDA(At, 1, 1); PG8_STAGE(PG8_SB(1, 0), b3, voffB); PG8_STAGE(PG8_SB(1, 1), b3 + hstepB, voffB); PG8_STAGE(PG8_SA(1, 0), a3, voffA);
            PG8_WAIT_V(8); PG8_WAIT_L(0); PG8_BAR; PG8_MMA(1, 0, At, B0); PG8_MMA(1, 1, At, B1); PG8_BAR; PG8_SCHED;
            } else {
            PG8_LDB(B0, 0, 0); PG8_SCHED; PG8_LDA(At, 0, 0); PG8_STAGE(PG8_SA(1, 1), a1 + hstepA, voffA);
            PG8_WAIT_L(8); PG8_BAR; PG8_WAIT_L(0); PG8_MMA(0, 0, At, B0); PG8_BAR; PG8_SCHED;
            PG8_LDB(B1, 0, 1); PG8_STAGE(PG8_SB(0, 0), b2, voffB);
            PG8_BAR; PG8_WAIT_L(0); PG8_MMA(0, 1, At, B1); PG8_BAR;
            PG8_LDA(At, 0, 1); PG8_STAGE(PG8_SA(0, 0), a2, voffA);
            PG8_BAR; PG8_WAIT_L(0); PG8_MMA(1, 0, At, B0); PG8_BAR; PG8_SCHED;
            PG8_STAGE(PG8_SB(0, 1), b2 + hstepB, voffB);
            PG8_WAIT_V(6); PG8_BAR; PG8_MMA(1, 1, At, B1); PG8_BAR;
            PG8_LDB(B0, 1, 0); PG8_SCHED; PG8_LDA(At, 1, 0); PG8_STAGE(PG8_SA(0, 1), a2 + hstepA, voffA);
            PG8_WAIT_L(8); PG8_BAR; PG8_WAIT_L(0); PG8_MMA(0, 0, At, B0); PG8_BAR; PG8_SCHED;
            PG8_LDB(B1, 1, 1); PG8_STAGE(PG8_SB(1, 0), b3, voffB);
            PG8_BAR; PG8_WAIT_L(0); PG8_MMA(0, 1, At, B1); PG8_BAR;
            PG8_LDA(At, 1, 1); PG8_STAGE(PG8_SA(1, 0), a3, voffA);
            PG8_BAR; PG8_WAIT_L(0); PG8_MMA(1, 0, At, B0); PG8_BAR; PG8_SCHED;
            PG8_STAGE(PG8_SB(1, 1), b3 + hstepB, voffB);
            PG8_WAIT_V(6); PG8_BAR; PG8_MMA(1, 1, At, B1); PG8_BAR;
            }
        }
        if constexpr (ALIGN_EPI) { if (wr == 0) PG8_BAR; }
        if constexpr (!Epi::AFTER_DRAIN) { E(acc, cur, wr, wc, fr, fq); S.done(cur); }
        if (!has_next) break;
#pragma unroll
        for (int a = 0; a < 2; ++a)
#pragma unroll
            for (int b = 0; b < 2; ++b)
#pragma unroll
                for (int m = 0; m < 4; ++m)
#pragma unroll
                    for (int n = 0; n < 2; ++n) acc[a][b][m][n] = (f32x4){0.f, 0.f, 0.f, 0.f};
        cur = nxt; cA = nA; cB = nB; ++ui;
        if constexpr (ALIGN_EPI) { if (wr == 1) PG8_BAR; }
    }
    PG8_WAIT_V(0);
    if constexpr (!ALIGN_EPI) { if (wr == 0) PG8_BAR; }
    PG8_BAR;
    if constexpr (Epi::AFTER_DRAIN) { E.fused(acc, cur, wr, wc, fr, fq, lds, wid, lane); S.done(cur); }
#undef PG8_SA
#undef PG8_SB
#undef PG8_STAGE
#undef PG8_LDA
#undef PG8_LDB
#undef PG8_MMA
#undef PG8_WAIT_V
#undef PG8_WAIT_L
#undef PG8_BAR
#undef PG8_SCHED
}
}

#define LAS __attribute__((address_space(3)))
typedef unsigned short bf16_t;
typedef short bf16x8 __attribute__((ext_vector_type(8)));
typedef short s16x4 __attribute__((ext_vector_type(4)));
typedef float f32x4 __attribute__((ext_vector_type(4)));
typedef float f32x16 __attribute__((ext_vector_type(16)));
typedef unsigned u32x4 __attribute__((ext_vector_type(4)));
typedef unsigned u32x2 __attribute__((ext_vector_type(2)));
using pg8::cvt_pk_bf16; using pg8::bf2f; using pg8::bflo; using pg8::bfhi; using pg8::sigmoidf_;

constexpr int SEQ = 8192, DM = 1024, NL = 4, MH = 16384, PW = 6912, DFF = 2816, INW = 6676, YW = 1536;
constexpr int C_GQ = 0, C_GK = 256, C_GV = 512, C_GG = 1024, C_FQ = 1536, C_FK = 2048, C_FV = 2560, C_MQ = 3072, C_BG = 3584, C_GA1 = 6656, C_FF = 6672;
constexpr float EPSN = 1e-6f, LOG2E = 1.4426950408889634f;
#ifndef FOX_SKIP
#define FOX_SKIP 1
#endif
constexpr size_t WS_WIN = 0, WS_WMEM = WS_WIN + (size_t)NL * PW * 1024 * 2, WS_WBR = WS_WMEM + (size_t)4096 * 1024 * 2, WS_WOUT = WS_WBR + (size_t)NL * 3 * 1024 * 512 * 2,
    WS_WGU = WS_WOUT + (size_t)NL * 1024 * 1024 * 2, WS_WDN = WS_WGU + (size_t)NL * 5632 * 1024 * 2,
    WS_MKN = WS_WDN + (size_t)NL * 1024 * DFF * 2, WS_MVT = WS_MKN + (size_t)NL * 1024 * 512 * 2, WS_CUMF = WS_MVT + (size_t)NL * 16 * 128 * 256 * 2, WS_DEC = WS_CUMF + (size_t)8 * SEQ * 4,
    WS_VTF = WS_DEC + (size_t)1024 * 64 * 4, WS_SIN = WS_VTF + (size_t)8 * 128 * SEQ * 2, WS_CS = WS_SIN + (size_t)1024 * 128 * 64 * 2, WS_XBF = WS_CS + (size_t)1024 * 128 * 64 * 4,
    WS_PROJ = WS_XBF + (size_t)2 * MH * 1024 * 2, WS_TSK = WS_PROJ + (size_t)MH * PW * 2, WS_BAR = WS_TSK + 256, WS_SSQ = WS_BAR + 16384, WS_MKV = WS_SSQ + (size_t)2 * MH * 16 * 4, WS_END = WS_MKV + (size_t)1024 * 4096 * 2;
constexpr size_t WS_MEMN = WS_PROJ;
static_assert((size_t)2 * MH * DFF * 2 <= (size_t)MH * PW * 2, "full-batch FFN hidden overlays PROJ");
static_assert(WS_END <= (size_t)536870912, "workspace map exceeds 512 MiB");
static_assert((size_t)MH * 1024 * 2 <= (size_t)1024 * 128 * 64 * 4, "MRG overlays CS");

struct Params { const float* in[21]; float* out; unsigned char* ws; };
enum { I_X = 0, I_MEM, I_GMIX, I_WIN, I_WA2, I_BA, I_GGLA, I_BFOX, I_GFQ, I_GFK, I_GMEM, I_WMKV, I_GMQ, I_GMK, I_BGATE, I_WBR, I_WOUT, I_GFFN, I_WFG, I_WFU, I_WFD };

__device__ __forceinline__ float wave_sum(float v) {
#pragma unroll
    for (int o = 1; o < 64; o <<= 1) v += __shfl_xor(v, o);
    return v;
}
__device__ __forceinline__ float log_sigmoid_(float x) { return fminf(x, 0.f) - __logf(1.0f + __expf(-fabsf(x))); }
#define LDS_WAIT() asm volatile("s_waitcnt lgkmcnt(0)" ::: "memory")

__device__ __forceinline__ int inmap(int n) { if (n < 1536) return n; if (n < 3072) return n + 16; if (n < 6656) return n + 20; if (n < 6672) return 1536 + (n - 6656); if (n < 6676) return 3088 + (n - 6672); return -1; }

__device__ __forceinline__ void transpose_item(const float* W, int K, int Ns, const float* gain, bf16_t* WT, LAS float* scr, int kb, int nb, int lane, int sc) {
    const int k0 = 64 * kb, n0 = 32 * nb, c = lane & 7;
    float v[32];
    const float* wp = W + (size_t)(k0 + (lane >> 5)) * Ns + (sc >= 0 ? sc : 0);
#pragma unroll
    for (int i = 0; i < 32; ++i) v[i] = wp[(size_t)(2 * i) * Ns];
    f32x4 g0 = (f32x4){1.f, 1.f, 1.f, 1.f}, g1 = g0;
    if (gain) { g0 = *(const f32x4*)(gain + k0 + 8 * c); g1 = *(const f32x4*)(gain + k0 + 8 * c + 4); }
    if (sc < 0) {
#pragma unroll
        for (int i = 0; i < 32; ++i) v[i] = 0.f;
    }
#pragma unroll
    for (int i = 0; i < 32; ++i) scr[(2 * i + (lane >> 5)) * 33 + (lane & 31)] = v[i];
    LDS_WAIT();
#pragma unroll
    for (int j = 0; j < 4; ++j) { const int n = (lane >> 3) + 8 * j; const LAS float* s = scr + (8 * c) * 33 + n;
        u32x4 o; o.x = cvt_pk_bf16(s[0 * 33] * g0[0], s[1 * 33] * g0[1]); o.y = cvt_pk_bf16(s[2 * 33] * g0[2], s[3 * 33] * g0[3]); o.z = cvt_pk_bf16(s[4 * 33] * g1[0], s[5 * 33] * g1[1]); o.w = cvt_pk_bf16(s[6 * 33] * g1[2], s[7 * 33] * g1[3]);
        *(u32x4*)(WT + (size_t)(n0 + n) * K + k0 + 8 * c) = o; }
    LDS_WAIT();
}
__device__ __forceinline__ void norm_rows(const float* X, bf16_t* XN, int nrows, int gw, int NGW, int lane) {
    for (int m = gw; m < nrows; m += NGW) {
        const f32x4* xr = (const f32x4*)(X + (size_t)m * DM) + lane; f32x4 v[4]; float s = 0.f;
#pragma unroll
        for (int j = 0; j < 4; ++j) { v[j] = xr[64 * j]; s += (v[j].x * v[j].x + v[j].y * v[j].y) + (v[j].z * v[j].z + v[j].w * v[j].w); }
        const float r = __builtin_amdgcn_rsqf(wave_sum(s) * (1.0f / DM) + EPSN);
        u32x2* o8 = (u32x2*)(XN + (size_t)m * DM) + lane;
#pragma unroll
        for (int j = 0; j < 4; ++j) { u32x2 w; w.x = cvt_pk_bf16(v[j].x * r, v[j].y * r); w.y = cvt_pk_bf16(v[j].z * r, v[j].w * r); o8[64 * j] = w; }
    }
}
__device__ __forceinline__ void norm128_rows64(const bf16_t* src, size_t spitch, bf16_t* dst, size_t dpitch, const float* gain, float scale, int tid) {
    const int sub = tid & 15; float g[8];
#pragma unroll
    for (int j = 0; j < 8; ++j) g[j] = gain[sub * 8 + j] * scale;
#pragma unroll
    for (int pass = 0; pass < 2; ++pass) { const int row = pass * 32 + (tid >> 4);
        const u32x4 w = *(const u32x4*)(src + (size_t)row * spitch + sub * 8);
        float v[8] = {bflo(w.x), bfhi(w.x), bflo(w.y), bfhi(w.y), bflo(w.z), bfhi(w.z), bflo(w.w), bfhi(w.w)};
        float ss = 0.f;
#pragma unroll
        for (int j = 0; j < 8; ++j) ss += v[j] * v[j];
        ss += __shfl_xor(ss, 1); ss += __shfl_xor(ss, 2); ss += __shfl_xor(ss, 4); ss += __shfl_xor(ss, 8);
        const float r = __builtin_amdgcn_rsqf(ss * (1.0f / 128.0f) + EPSN);
        u32x4 o; o.x = cvt_pk_bf16(v[0] * r * g[0], v[1] * r * g[1]); o.y = cvt_pk_bf16(v[2] * r * g[2], v[3] * r * g[3]); o.z = cvt_pk_bf16(v[4] * r * g[4], v[5] * r * g[5]); o.w = cvt_pk_bf16(v[6] * r * g[6], v[7] * r * g[7]);
        *(u32x4*)(dst + (size_t)row * dpitch + sub * 8) = o; }
}
__device__ __forceinline__ void vt_tile(const bf16_t* src, size_t spitch, bf16_t* dst, size_t dpitch, LAS bf16_t* T, int tid) {
#pragma unroll
    for (int i = 0; i < 2; ++i) { const int c = tid + 512 * i, row = c >> 4, part = c & 15; const u32x4 w = *(const u32x4*)(src + (size_t)row * spitch + part * 8); *(LAS u32x4*)(T + row * 136 + part * 8) = w; }
    __syncthreads();
    const int d = tid & 127, part = tid >> 7; unsigned v[16];
#pragma unroll
    for (int i = 0; i < 16; ++i) v[i] = T[(16 * part + i) * 136 + d];
    u32x4 w0, w1; w0.x = v[0] | (v[1] << 16); w0.y = v[2] | (v[3] << 16); w0.z = v[4] | (v[5] << 16); w0.w = v[6] | (v[7] << 16);
    w1.x = v[8] | (v[9] << 16); w1.y = v[10] | (v[11] << 16); w1.z = v[12] | (v[13] << 16); w1.w = v[14] | (v[15] << 16);
    *(u32x4*)(dst + (size_t)d * dpitch + 16 * part) = w0; *(u32x4*)(dst + (size_t)d * dpitch + 16 * part + 8) = w1;
    __syncthreads();
}
__device__ __forceinline__ void prep_batch(const bf16_t* PROJp, const float* gk, bf16_t* KCp, bf16_t* VTFp, LAS bf16_t* T, int v0, int vs, int tid) {
    const int sub = tid & 15, row = tid >> 4;
    u32x4 w[4][2], vw[4][2];
#pragma unroll
    for (int q = 0; q < 4; ++q) { const int v = v0 + q * vs; if (v < 1024) { const int r0 = (v >> 2) * 64, h = v & 3; const bf16_t* rowp = PROJp + (size_t)r0 * PW;
#pragma unroll
        for (int ps = 0; ps < 2; ++ps) w[q][ps] = *(const u32x4*)(rowp + (size_t)(ps * 32 + row) * PW + C_FK + h * 128 + sub * 8);
#pragma unroll
        for (int i = 0; i < 2; ++i) { const int c = tid + 512 * i; vw[q][i] = *(const u32x4*)(rowp + (size_t)(c >> 4) * PW + C_FV + h * 128 + (c & 15) * 8); } } }
    float g[8];
#pragma unroll
    for (int j = 0; j < 8; ++j) g[j] = gk[sub * 8 + j];
#pragma unroll
    for (int q = 0; q < 4; ++q) { const int v = v0 + q * vs; if (v < 1024) { const int r0 = (v >> 2) * 64, h = v & 3, bp = r0 / SEQ, s0 = r0 % SEQ;
        bf16_t* kdst = KCp + ((size_t)(bp * 4 + h) * SEQ + s0) * 128;
#pragma unroll
        for (int ps = 0; ps < 2; ++ps) { const u32x4 x = w[q][ps];
            float f[8] = {bflo(x.x), bfhi(x.x), bflo(x.y), bfhi(x.y), bflo(x.z), bfhi(x.z), bflo(x.w), bfhi(x.w)};
            float ss = 0.f;
#pragma unroll
            for (int j = 0; j < 8; ++j) ss += f[j] * f[j];
            ss += __shfl_xor(ss, 1); ss += __shfl_xor(ss, 2); ss += __shfl_xor(ss, 4); ss += __shfl_xor(ss, 8);
            const float r = __builtin_amdgcn_rsqf(ss * (1.0f / 128.0f) + EPSN);
            u32x4 o; o.x = cvt_pk_bf16(f[0] * r * g[0], f[1] * r * g[1]); o.y = cvt_pk_bf16(f[2] * r * g[2], f[3] * r * g[3]); o.z = cvt_pk_bf16(f[4] * r * g[4], f[5] * r * g[5]); o.w = cvt_pk_bf16(f[6] * r * g[6], f[7] * r * g[7]);
            *(u32x4*)(kdst + (ps * 32 + row) * 128 + sub * 8) = o; }
#pragma unroll
        for (int i = 0; i < 2; ++i) { const int c = tid + 512 * i; *(LAS u32x4*)(T + q * 8704 + (c >> 4) * 136 + (c & 15) * 8) = vw[q][i]; } } }
    __syncthreads();
    const int d = tid & 127, part = tid >> 7;
#pragma unroll
    for (int q = 0; q < 4; ++q) { const int v = v0 + q * vs; if (v < 1024) { const int r0 = (v >> 2) * 64, h = v & 3, bp = r0 / SEQ, s0 = r0 % SEQ;
        bf16_t* vtdst = VTFp + ((size_t)(bp * 4 + h) * 128 + (s0 >> 6)) * 8192; unsigned e[16];
#pragma unroll
        for (int i = 0; i < 16; ++i) e[i] = T[q * 8704 + (16 * part + i) * 136 + d];
        u32x4 w0, w1; w0.x = e[0] | (e[1] << 16); w0.y = e[2] | (e[3] << 16); w0.z = e[4] | (e[5] << 16); w0.w = e[6] | (e[7] << 16);
        w1.x = e[8] | (e[9] << 16); w1.y = e[10] | (e[11] << 16); w1.z = e[12] | (e[13] << 16); w1.w = e[14] | (e[15] << 16);
        *(u32x4*)(vtdst + d * 64 + 16 * part) = w0; *(u32x4*)(vtdst + d * 64 + 16 * part + 8) = w1; } }
    __syncthreads();
}
__device__ __forceinline__ void xb_rows(const float* X, bf16_t* XB, float* ssq, int nrows, int gw, int NGW, int lane) {
    for (int m = gw; m < nrows; m += NGW) {
        const f32x4* xr = (const f32x4*)(X + (size_t)m * DM) + lane; f32x4 v[4]; float s = 0.f;
#pragma unroll
        for (int j = 0; j < 4; ++j) { v[j] = xr[64 * j]; s += (v[j].x * v[j].x + v[j].y * v[j].y) + (v[j].z * v[j].z + v[j].w * v[j].w); }
        s = wave_sum(s);
        u32x2* o8 = (u32x2*)(XB + (size_t)m * DM) + lane;
#pragma unroll
        for (int j = 0; j < 4; ++j) { u32x2 w; w.x = cvt_pk_bf16(v[j].x, v[j].y); w.y = cvt_pk_bf16(v[j].z, v[j].w); o8[64 * j] = w; }
        if (lane < 16) ssq[(size_t)m * 16 + lane] = lane == 0 ? s : 0.f;
    }
}
#define MFMA32(a, b, c) __builtin_amdgcn_mfma_f32_32x32x16_bf16((a), (b), (c), 0, 0, 0)
__device__ __forceinline__ bf16x8 pack8(const f32x16& x, int s) {
    u32x4 p; p.x = cvt_pk_bf16(x[8 * s], x[8 * s + 1]); p.y = cvt_pk_bf16(x[8 * s + 2], x[8 * s + 3]); p.z = cvt_pk_bf16(x[8 * s + 4], x[8 * s + 5]); p.w = cvt_pk_bf16(x[8 * s + 6], x[8 * s + 7]);
    return __builtin_bit_cast(bf16x8, p);
}
constexpr int AT_K = 0, AT_V = 34816, AT_B = 71680, AT_Q = 73984;
template <bool FOX>
__device__ __forceinline__ void attn_tile(const LAS unsigned char* Kb, const LAS unsigned char* Vb, const LAS float* bb, const LAS unsigned char* Qw, f32x16 (&o)[4], float& mrun, float& lrun,
                                          int k0, int qw0, int qlane, int r32, int hi) {
    if (FOX && k0 > qw0 + 31) return;
    f32x16 st[2];
#pragma unroll
    for (int kb = 0; kb < 2; ++kb)
#pragma unroll
        for (int r = 0; r < 16; ++r) st[kb][r] = 0.f;
#pragma unroll
    for (int hb = 0; hb < 2; ++hb) {
        bf16x8 qf[4], ka[4][2];
#pragma unroll
        for (int k4 = 0; k4 < 4; ++k4) { const int ks = 4 * hb + k4; qf[k4] = *(const LAS bf16x8*)(Qw + (r32 * 136 + 16 * ks + 8 * hi) * 2);
            ka[k4][0] = *(const LAS bf16x8*)(Kb + (r32 * 136 + 16 * ks + 8 * hi) * 2); ka[k4][1] = *(const LAS bf16x8*)(Kb + ((32 + r32) * 136 + 16 * ks + 8 * hi) * 2); }
        __builtin_amdgcn_sched_barrier(0);
#pragma unroll
        for (int k4 = 0; k4 < 4; ++k4) { st[0] = MFMA32(ka[k4][0], qf[k4], st[0]); st[1] = MFMA32(ka[k4][1], qf[k4], st[1]); }
        __builtin_amdgcn_sched_barrier(0);
    }
    if (FOX) {
#pragma unroll
        for (int kb = 0; kb < 2; ++kb)
#pragma unroll
            for (int g = 0; g < 4; ++g) { const f32x4 bv = *(const LAS f32x4*)(bb + 32 * kb + 8 * g + 4 * hi);
#pragma unroll
                for (int i = 0; i < 4; ++i) st[kb][4 * g + i] += bv[i]; }
        if (k0 + 63 > qw0) {
#pragma unroll
            for (int kb = 0; kb < 2; ++kb)
#pragma unroll
                for (int r = 0; r < 16; ++r) { const int key = k0 + 32 * kb + (r & 3) + 8 * (r >> 2) + 4 * hi; if (key > qlane) st[kb][r] = -INFINITY; }
        }
    }
    float mx = st[0][0];
#pragma unroll
    for (int r = 1; r < 16; ++r) mx = fmaxf(mx, st[0][r]);
#pragma unroll
    for (int r = 0; r < 16; ++r) mx = fmaxf(mx, st[1][r]);
    mx = fmaxf(mx, __shfl_xor(mx, 32));
    const float mnew = fmaxf(mrun, mx), msafe = (mnew == -INFINITY) ? 0.f : mnew;
    const float alpha = (mrun == -INFINITY) ? 0.f : __builtin_amdgcn_exp2f(mrun - msafe);
    float rs = 0.f;
#pragma unroll
    for (int kb = 0; kb < 2; ++kb)
#pragma unroll
        for (int r = 0; r < 16; ++r) { const float pv = __builtin_amdgcn_exp2f(st[kb][r] - msafe); st[kb][r] = pv; rs += pv; }
    rs += __shfl_xor(rs, 32);
    lrun = lrun * alpha + rs; mrun = mnew;
#pragma unroll
    for (int i = 0; i < 4; ++i)
#pragma unroll
        for (int r = 0; r < 16; ++r) o[i][r] *= alpha;
    s16x4 vlo[2][4], vhi[2][4];
#define AT_VLD(buf, g) do { _Pragma("unroll") for (int db = 0; db < 4; ++db) { const LAS unsigned char* vp = Vb + ((32 * db + r32) * 72 + 16 * (g) + 4 * hi) * 2; \
        vlo[buf][db] = *(const LAS s16x4*)vp; vhi[buf][db] = *(const LAS s16x4*)(vp + 16); } } while (0)
    AT_VLD(0, 0);
#pragma unroll
    for (int g = 0; g < 4; ++g) {
        __builtin_amdgcn_sched_barrier(0);
        if (g < 3) AT_VLD((g + 1) & 1, g + 1);
        const bf16x8 pf = pack8(st[g >> 1], g & 1);
        __builtin_amdgcn_sched_barrier(0);
#pragma unroll
        for (int db = 0; db < 4; ++db) { const bf16x8 a = __builtin_shufflevector(vlo[g & 1][db], vhi[g & 1][db], 0, 1, 2, 3, 4, 5, 6, 7); o[db] = MFMA32(a, pf, o[db]); }
    }
#undef AT_VLD
}
template <bool FOX>
__device__ __forceinline__ void attn_unit(LAS unsigned char* lds, const float* qgain, const bf16_t* Q, size_t qpitch, const bf16_t* K, size_t kpitch, const bf16_t* VT, size_t vpitch, int vtile,
                                          const float* cum, float cref, float o1, float o2, float o3, int q0, int j0, int j1, bf16_t* O, size_t opitch, int tid, int lane, int wid) {
    const int r32 = lane & 31, hi = lane >> 5, qw0 = q0 + 32 * wid, qlane = qw0 + r32;
    const LAS unsigned char* Qw = lds + AT_Q + wid * (32 * 136 * 2);
    {
        bf16x8 qf[8];
#pragma unroll
        for (int ks = 0; ks < 8; ++ks) qf[ks] = *(const bf16x8*)(Q + (unsigned)((32 * wid + r32) * (int)qpitch + 16 * ks + 8 * hi));
        float ss = 0.f;
#pragma unroll
        for (int ks = 0; ks < 8; ++ks)
#pragma unroll
            for (int j = 0; j < 8; ++j) { const float x = bf2f((unsigned short)qf[ks][j]); ss += x * x; }
        ss += __shfl_xor(ss, 32);
        const float rq = (__builtin_amdgcn_rsqf(ss * (1.0f / 128.0f) + EPSN)) * (0.08838834764831845f * LOG2E);
#pragma unroll
        for (int ks = 0; ks < 8; ++ks) { const f32x4 ga = *(const f32x4*)(qgain + 16 * ks + 8 * hi), gb = *(const f32x4*)(qgain + 16 * ks + 8 * hi + 4);
            u32x4 w; w.x = cvt_pk_bf16(bf2f((unsigned short)qf[ks][0]) * rq * ga[0], bf2f((unsigned short)qf[ks][1]) * rq * ga[1]);
            w.y = cvt_pk_bf16(bf2f((unsigned short)qf[ks][2]) * rq * ga[2], bf2f((unsigned short)qf[ks][3]) * rq * ga[3]);
            w.z = cvt_pk_bf16(bf2f((unsigned short)qf[ks][4]) * rq * gb[0], bf2f((unsigned short)qf[ks][5]) * rq * gb[1]);
            w.w = cvt_pk_bf16(bf2f((unsigned short)qf[ks][6]) * rq * gb[2], bf2f((unsigned short)qf[ks][7]) * rq * gb[3]);
            *(LAS u32x4*)(lds + AT_Q + wid * (32 * 136 * 2) + (r32 * 136 + 16 * ks + 8 * hi) * 2) = w; }
    }
    f32x16 o[4];
#pragma unroll
    for (int i = 0; i < 4; ++i)
#pragma unroll
        for (int r = 0; r < 16; ++r) o[i][r] = 0.f;
    float mrun = -INFINITY, lrun = 0.f;
    const int kkey0 = tid >> 4, kpart = tid & 15, vd0 = tid >> 3, vpart = tid & 7;
    u32x4 kA[2], vA[2], kB[2], vB[2]; float bA = 0.f, bB = 0.f;
#define AT_LOAD(kr, vr, br, j) do { _Pragma("unroll") for (int i_ = 0; i_ < 2; ++i_) { \
        kr[i_] = *(const u32x4*)(K + (unsigned)((64 * (j) + kkey0 + 32 * i_) * (int)kpitch + kpart * 8)); \
        vr[i_] = *(const u32x4*)(VT + (unsigned)((vd0 + 64 * i_) * (int)vpitch + vtile * (j) + vpart * 8)); } \
        if (FOX) { const int sj_ = (j) >> 5; br = (cref - (cum[64 * (j) + (tid & 63)] + (sj_ == 0 ? 0.f : sj_ == 1 ? o1 : sj_ == 2 ? o2 : o3))) * LOG2E; } } while (0)
#define AT_STORE(kr, vr, br, buf) do { _Pragma("unroll") for (int i_ = 0; i_ < 2; ++i_) { \
        *(LAS u32x4*)(lds + AT_K + (buf) * 17408 + ((kkey0 + 32 * i_) * 136 + kpart * 8) * 2) = kr[i_]; \
        *(LAS u32x4*)(lds + AT_V + (buf) * 18432 + ((vd0 + 64 * i_) * 72 + vpart * 8) * 2) = vr[i_]; } \
        if (FOX && tid < 64) ((LAS float*)(lds + AT_B))[(buf) * 64 + tid] = br; } while (0)
#define AT_TILE(buf, j) attn_tile<FOX>(lds + AT_K + (buf) * 17408, lds + AT_V + (buf) * 18432, (const LAS float*)(lds + AT_B) + (buf) * 64, Qw, o, mrun, lrun, 64 * (j), qw0, qlane, r32, hi)
#define AT_BAR() asm volatile("s_waitcnt lgkmcnt(0)\n\ts_barrier" ::: "memory")
    AT_LOAD(kA, vA, bA, j0);
    AT_LOAD(kB, vB, bB, (j0 + 1 <= j1 ? j0 + 1 : j1));
    AT_STORE(kA, vA, bA, 0);
    AT_BAR();
    for (int j = j0; j <= j1; j += 2) {
        AT_LOAD(kA, vA, bA, (j + 2 <= j1 ? j + 2 : j1));
        __builtin_amdgcn_sched_barrier(0);
        AT_TILE(0, j);
        if (j + 1 <= j1) AT_STORE(kB, vB, bB, 1);
        AT_BAR();
        if (j + 1 > j1) break;
        AT_LOAD(kB, vB, bB, (j + 3 <= j1 ? j + 3 : j1));
        __builtin_amdgcn_sched_barrier(0);
        AT_TILE(1, j + 1);
        if (j + 2 <= j1) AT_STORE(kA, vA, bA, 0);
        AT_BAR();
    }
#undef AT_BAR
#undef AT_LOAD
#undef AT_STORE
#undef AT_TILE
    const float rl = __builtin_amdgcn_rcpf(lrun);
    int lr_ = lane; asm volatile("" : "+v"(lr_));
    bf16_t* orow = O + (unsigned)((32 * wid + (lr_ & 31)) * (int)opitch);
#pragma unroll
    for (int db = 0; db < 4; ++db)
#pragma unroll
        for (int g = 0; g < 4; ++g) { u32x2 w; w.x = cvt_pk_bf16(o[db][4 * g] * rl, o[db][4 * g + 1] * rl); w.y = cvt_pk_bf16(o[db][4 * g + 2] * rl, o[db][4 * g + 3] * rl);
            *(u32x2*)(orow + 32 * db + 8 * g + 4 * (lr_ >> 5)) = w; }
}
constexpr int GL_GA1 = 0, GL_SEG = 4096, GL_SS = 6144, GL_A8 = 8192, GL_KIN = 17408, GL_VT = 26624, GL_SINT = 45056, GL_UOFF = 65536;
template <bool OUTPHASE>
__device__ __forceinline__ void gla_pair(LAS unsigned char* lds0, const Params& p, int l, int unitA, int unitB, const bf16_t* PROJ, float* CS, float* DEC, const bf16_t* SIN, bf16_t* Y, int tid, int lane, int wid) {
    const int r32 = lane & 31, hi = lane >> 5, d = tid & 63, seg = wid;
    int h[2], r0[2], unit[2];
#pragma unroll
    for (int uu = 0; uu < 2; ++uu) { unit[uu] = uu ? unitB : unitA; const int bhp = unit[uu] >> 7, n = unit[uu] & 127; h[uu] = bhp & 3; r0[uu] = (bhp >> 2) * SEQ + n * 64; }
    u32x2 ggw[2][4]; f32x4 ggn[2][4]; float wa[2][16], ba[2], kv[2][8], qv[2][8];
#pragma unroll
    for (int uu = 0; uu < 2; ++uu) { LAS unsigned char* lds = lds0 + uu * GL_UOFF;
        LAS float* GA1 = (LAS float*)(lds + GL_GA1); LAS bf16_t* VTl = (LAS bf16_t*)(lds + GL_VT); LAS bf16_t* SINT = (LAS bf16_t*)(lds + GL_SINT);
        if (tid < 128) { const int row = tid >> 1, hp = tid & 1; const u32x4 w = *(const u32x4*)(PROJ + (size_t)(r0[uu] + row) * PW + C_GA1 + 8 * hp);
            LAS float* gp = GA1 + row * 16 + 8 * hp; gp[0] = bflo(w.x); gp[1] = bfhi(w.x); gp[2] = bflo(w.y); gp[3] = bfhi(w.y); gp[4] = bflo(w.z); gp[5] = bfhi(w.z); gp[6] = bflo(w.w); gp[7] = bfhi(w.w); }
        { const int dv = tid & 127, part = tid >> 7; unsigned v[16];
#pragma unroll
          for (int i = 0; i < 16; ++i) v[i] = PROJ[(size_t)(r0[uu] + 16 * part + i) * PW + C_GV + h[uu] * 128 + dv];
          u32x4 w0, w1; w0.x = v[0] | (v[1] << 16); w0.y = v[2] | (v[3] << 16); w0.z = v[4] | (v[5] << 16); w0.w = v[6] | (v[7] << 16);
          w1.x = v[8] | (v[9] << 16); w1.y = v[10] | (v[11] << 16); w1.z = v[12] | (v[13] << 16); w1.w = v[14] | (v[15] << 16);
          *(LAS u32x4*)(VTl + dv * 72 + 16 * part) = w0; *(LAS u32x4*)(VTl + dv * 72 + 16 * part + 8) = w1; }
        if (OUTPHASE) {
#pragma unroll
            for (int i = 0; i < 2; ++i) { const int c = tid + 512 * i, dv = c >> 3, part = c & 7; *(LAS u32x4*)(SINT + dv * 72 + part * 8) = *(const u32x4*)(SIN + ((size_t)unit[uu] * 128 + dv) * 64 + part * 8); }
            const int dvb_ = wid >> 1, cb_ = wid & 1;
#pragma unroll
            for (int g = 0; g < 4; ++g) { const int d4 = 32 * dvb_ + 8 * g + 4 * hi; ggw[uu][g] = *(const u32x2*)(PROJ + (size_t)(r0[uu] + 32 * cb_ + r32) * PW + C_GG + h[uu] * 128 + d4); ggn[uu][g] = *(const f32x4*)(p.in[I_GGLA] + l * 512 + h[uu] * 128 + d4); }
        }
#pragma unroll
        for (int i = 0; i < 16; ++i) wa[uu][i] = p.in[I_WA2][(size_t)(l * 16 + i) * 256 + h[uu] * 64 + d];
        ba[uu] = p.in[I_BA][l * 256 + h[uu] * 64 + d];
#pragma unroll
        for (int i = 0; i < 8; ++i) { kv[uu][i] = bf2f(PROJ[(size_t)(r0[uu] + 8 * seg + i) * PW + C_GK + h[uu] * 64 + d]); qv[uu][i] = OUTPHASE ? bf2f(PROJ[(size_t)(r0[uu] + 8 * seg + i) * PW + C_GQ + h[uu] * 64 + d]) : 0.f; }
    }
    __syncthreads();
    float cumv[2][8];
#pragma unroll
    for (int uu = 0; uu < 2; ++uu) { LAS unsigned char* lds = lds0 + uu * GL_UOFF; LAS float* GA1 = (LAS float*)(lds + GL_GA1); LAS float* SEG = (LAS float*)(lds + GL_SEG);
        float run = 0.f;
#pragma unroll
        for (int i = 0; i < 8; ++i) { const LAS float* gp = GA1 + (8 * seg + i) * 16; float z = ba[uu];
#pragma unroll
            for (int j = 0; j < 16; ++j) z += gp[j] * wa[uu][j];
            run += log_sigmoid_(z) * (1.0f / 16.0f); cumv[uu][i] = run; }
        SEG[seg * 64 + d] = run; }
    __syncthreads();
#pragma unroll
    for (int uu = 0; uu < 2; ++uu) { LAS unsigned char* lds = lds0 + uu * GL_UOFF; LAS float* SEG = (LAS float*)(lds + GL_SEG); LAS bf16_t* A8 = (LAS bf16_t*)(lds + GL_A8); LAS bf16_t* KIN = (LAS bf16_t*)(lds + GL_KIN);
        float offs = 0.f, total = 0.f;
#pragma unroll
        for (int s = 0; s < 8; ++s) { const float t = SEG[s * 64 + d]; total += t; if (s < seg) offs += t; }
        if (!OUTPHASE) {
            float ko[8];
#pragma unroll
            for (int i = 0; i < 8; ++i) ko[i] = kv[uu][i] * __expf(total - (cumv[uu][i] + offs));
            u32x4 w; w.x = cvt_pk_bf16(ko[0], ko[1]); w.y = cvt_pk_bf16(ko[2], ko[3]); w.z = cvt_pk_bf16(ko[4], ko[5]); w.w = cvt_pk_bf16(ko[6], ko[7]);
            *(LAS u32x4*)(A8 + d * 72 + 8 * seg) = w;
            if (seg == 0) DEC[(size_t)unit[uu] * 64 + d] = __expf(total);
        } else {
#pragma unroll
            for (int i = 0; i < 8; ++i) { const float c = cumv[uu][i] + offs; const int t = 8 * seg + i;
                A8[t * 72 + d] = (bf16_t)(cvt_pk_bf16(qv[uu][i] * 0.125f * __expf(c), 0.f) & 0xffffu);
                KIN[t * 72 + d] = (bf16_t)(cvt_pk_bf16(kv[uu][i] * __expf(-c), 0.f) & 0xffffu); }
        } }
    __syncthreads();
    if (!OUTPHASE) {
        const int dvb = wid >> 1, dkb = wid & 1;
#pragma unroll
        for (int uu = 0; uu < 2; ++uu) { LAS unsigned char* lds = lds0 + uu * GL_UOFF; LAS bf16_t* A8 = (LAS bf16_t*)(lds + GL_A8); LAS bf16_t* VTl = (LAS bf16_t*)(lds + GL_VT);
            f32x16 acc;
#pragma unroll
            for (int r = 0; r < 16; ++r) acc[r] = 0.f;
#pragma unroll
            for (int ks = 0; ks < 4; ++ks) { const bf16x8 a = *(const LAS bf16x8*)(VTl + (32 * dvb + r32) * 72 + 16 * ks + 8 * hi); const bf16x8 b = *(const LAS bf16x8*)(A8 + (32 * dkb + r32) * 72 + 16 * ks + 8 * hi); acc = MFMA32(a, b, acc); }
            float* cs = CS + (size_t)unit[uu] * 8192;
#pragma unroll
            for (int r = 0; r < 16; ++r) cs[(32 * dvb + (r & 3) + 8 * (r >> 2) + 4 * hi) * 64 + 32 * dkb + r32] = acc[r]; }
        __syncthreads();
    } else {
        const int dvb = wid >> 1, cb = wid & 1;
        f32x16 o[2];
#pragma unroll
        for (int uu = 0; uu < 2; ++uu) { LAS unsigned char* lds = lds0 + uu * GL_UOFF; LAS float* SS = (LAS float*)(lds + GL_SS);
            LAS bf16_t* A8 = (LAS bf16_t*)(lds + GL_A8); LAS bf16_t* KIN = (LAS bf16_t*)(lds + GL_KIN); LAS bf16_t* VTl = (LAS bf16_t*)(lds + GL_VT); LAS bf16_t* SINT = (LAS bf16_t*)(lds + GL_SINT);
            f32x16 at[2];
#pragma unroll
            for (int r = 0; r < 16; ++r) { at[0][r] = 0.f; at[1][r] = 0.f; o[uu][r] = 0.f; }
            bf16x8 qb[4];
#pragma unroll
            for (int ks = 0; ks < 4; ++ks) qb[ks] = *(const LAS bf16x8*)(A8 + (32 * cb + r32) * 72 + 16 * ks + 8 * hi);
#pragma unroll
            for (int sb = 0; sb < 2; ++sb) if (sb <= cb) {
#pragma unroll
                for (int ks = 0; ks < 4; ++ks) { const bf16x8 a = *(const LAS bf16x8*)(KIN + (32 * sb + r32) * 72 + 16 * ks + 8 * hi); at[sb] = MFMA32(a, qb[ks], at[sb]); }
                if (sb == cb) {
#pragma unroll
                    for (int r = 0; r < 16; ++r) if ((r & 3) + 8 * (r >> 2) + 4 * hi > r32) at[sb][r] = 0.f;
                }
#pragma unroll
                for (int s = 0; s < 2; ++s) { const bf16x8 pf = pack8(at[sb], s); const LAS bf16_t* vp = VTl + (32 * dvb + r32) * 72 + 32 * sb + 16 * s + 4 * hi;
                    const s16x4 lo = *(const LAS s16x4*)vp, hh = *(const LAS s16x4*)(vp + 8); const bf16x8 a = __builtin_shufflevector(lo, hh, 0, 1, 2, 3, 4, 5, 6, 7);
                    o[uu] = MFMA32(a, pf, o[uu]); }
            }
#pragma unroll
            for (int ks = 0; ks < 4; ++ks) { const bf16x8 a = *(const LAS bf16x8*)(SINT + (32 * dvb + r32) * 72 + 16 * ks + 8 * hi); o[uu] = MFMA32(a, qb[ks], o[uu]); }
            float ss = 0.f;
#pragma unroll
            for (int r = 0; r < 16; ++r) ss += o[uu][r] * o[uu][r];
            ss += __shfl_xor(ss, 32);
            if (hi == 0) SS[dvb * 64 + 32 * cb + r32] = ss; }
        __syncthreads();
#pragma unroll
        for (int uu = 0; uu < 2; ++uu) { if (uu == 1 && unitB == unitA) break;
            LAS unsigned char* lds = lds0 + uu * GL_UOFF; LAS float* SS = (LAS float*)(lds + GL_SS);
            const int c = 32 * cb + r32;
            const float tot = SS[c] + SS[64 + c] + SS[128 + c] + SS[192 + c];
            const float rn = __builtin_amdgcn_rsqf(tot * (1.0f / 128.0f) + EPSN);
            const size_t row = (size_t)(r0[uu] + c);
#pragma unroll
            for (int g = 0; g < 4; ++g) { const int d4 = 32 * dvb + 8 * g + 4 * hi;
                const u32x2 gw = ggw[uu][g]; const f32x4 gn = ggn[uu][g];
                const float g0 = bflo(gw.x), g1 = bfhi(gw.x), g2 = bflo(gw.y), g3 = bfhi(gw.y);
                u32x2 w; w.x = cvt_pk_bf16(o[uu][4 * g] * rn * gn[0] * g0 * sigmoidf_(g0), o[uu][4 * g + 1] * rn * gn[1] * g1 * sigmoidf_(g1));
                w.y = cvt_pk_bf16(o[uu][4 * g + 2] * rn * gn[2] * g2 * sigmoidf_(g2), o[uu][4 * g + 3] * rn * gn[3] * g3 * sigmoidf_(g3));
                *(u32x2*)(Y + row * PW + C_GV + h[uu] * 128 + d4) = w; } }
        __syncthreads();
    }
}
#define XB_TMO      128
#define XB_XCNT(j)  (256  + 64 * (j))
#define XB_XSUB(j)  (1280 + 64 * (j))
#define XB_XGEN(j)  (2304 + 64 * (j))
#define XB_TOP      3328
#define XB_TOPGEN   3392
#define XCD_BAR_WORDS 3456
#define XB_SPIN_CAP (1u << 18)

__device__ __forceinline__ unsigned xb_ld(unsigned* p)              { return __hip_atomic_load(p, __ATOMIC_RELAXED, __HIP_MEMORY_SCOPE_AGENT); }
__device__ __forceinline__ unsigned xb_add(unsigned* p, unsigned v) { return __hip_atomic_fetch_add(p, v, __ATOMIC_RELAXED, __HIP_MEMORY_SCOPE_AGENT); }
__device__ __forceinline__ unsigned xb_xcc_id() { return (unsigned)__builtin_amdgcn_s_getreg((3 << 11) | 20) & 0xFu; }
#define XB_SPIN(cond, bar) do { unsigned _sp = 0; while (cond) { __builtin_amdgcn_s_sleep(1); \
    if ((++_sp & 255u) == 0u) { if (xb_ld(&(bar)[XB_TMO])) break; if (_sp > XB_SPIN_CAP) { atomicAdd(&(bar)[XB_TMO], 1u); break; } } } } while (0)

struct XcdBarrier {
    unsigned* bar; unsigned x;
    volatile LAS unsigned* st;
};

__device__ __forceinline__ XcdBarrier xcd_barrier_post(unsigned* bar, volatile LAS unsigned* st) {
    XcdBarrier b; b.bar = bar; b.x = xb_xcc_id(); b.st = st;
    if (threadIdx.x == 0) (void)xb_add(&bar[XB_XCNT(b.x)], 1u);
    return b;
}
__device__ __forceinline__ void xcd_barrier_complete(unsigned* bar, unsigned x, unsigned& nloc, unsigned& nx) {
    const unsigned G = gridDim.x * gridDim.y * gridDim.z;
    unsigned sum, cnt, mine, sp = 0u;
    for (;;) {
        sum = 0u; cnt = 0u; mine = 0u;
#pragma unroll
        for (unsigned j = 0; j < 16; ++j) { const unsigned c = xb_ld(&bar[XB_XCNT(j)]); sum += c; cnt += (c > 0u) ? 1u : 0u; mine = (j == x) ? c : mine; }
        if (sum == G) break;
        __builtin_amdgcn_s_sleep(1);
        if ((++sp & 255u) == 0u) { if (xb_ld(&bar[XB_TMO])) break; if (sp > XB_SPIN_CAP) { atomicAdd(&bar[XB_TMO], 1u); break; } }
    }
    nloc = mine > 0u ? mine : 1u; nx = cnt > 0u ? cnt : 1u;
}

__device__ __forceinline__ void xcd_barrier(const XcdBarrier& b) {
    asm volatile("s_waitcnt vmcnt(0)" ::: "memory");
    __syncthreads();
    if (threadIdx.x == 0) {
        unsigned* bar = b.bar;
        __builtin_amdgcn_s_waitcnt(0);
        unsigned nloc = b.st[0], nx = b.st[1];
        if (nloc == 0u) { xcd_barrier_complete(bar, b.x, nloc, nx); b.st[0] = nloc; b.st[1] = nx; }
        const unsigned old = xb_add(&bar[XB_XSUB(b.x)], 1u);
        const unsigned gen = old / nloc;
        if (old + 1u == (gen + 1u) * nloc) {
            __builtin_amdgcn_fence(__ATOMIC_RELEASE, "agent");
            asm volatile("s_waitcnt vmcnt(0)" ::: "memory");
            const unsigned og = xb_add(&bar[XB_TOP], 1u);
            const unsigned tg = og / nx;
            if (og + 1u == (tg + 1u) * nx) xb_add(&bar[XB_TOPGEN], 1u);
            else XB_SPIN(xb_ld(&bar[XB_TOPGEN]) == tg, bar);
            __builtin_amdgcn_fence(__ATOMIC_ACQUIRE, "agent");
            xb_add(&bar[XB_XGEN(b.x)], 1u);
            asm volatile("s_waitcnt vmcnt(0)" ::: "memory");
        } else {
            XB_SPIN(xb_ld(&bar[XB_XGEN(b.x)]) == gen, bar);
            __builtin_amdgcn_fence(__ATOMIC_ACQUIRE, "agent");
            asm volatile("s_waitcnt vmcnt(0)" ::: "memory");
        }
    }
    __syncthreads();
}
constexpr int LDS_BYTES = 147456;
#define GEMM_PHASE(EPI, g, E) do { pg8::StaticOrder S_; S_.init((g).M, (g).N, G, (int)blockIdx.x); pg8::gemm_phase<EPI, pg8::StaticOrder, true, true>(lds, (g), S_, (E)); } while (0)
__global__ void __launch_bounds__(512, 2) mega_fwd(Params p) {
    extern __shared__ __attribute__((aligned(16))) unsigned char lds_raw[];
    LAS unsigned char* lds = (LAS unsigned char*)lds_raw;
    cg::grid_group grid = cg::this_grid();
    const int G = gridDim.x, bx = blockIdx.x, NGW = G * 8;
#define PH_BEGIN int tid = threadIdx.x; asm volatile("" : "+v"(tid)); const int lane = tid & 63, wid = __builtin_amdgcn_readfirstlane(tid >> 6), gw = bx * 8 + wid; size_t wso_ = 0; asm volatile("" : "+s"(wso_)); unsigned char* ws = p.ws + wso_; (void)lane; (void)gw; (void)ws;
#define WIN ((bf16_t*)(ws + WS_WIN))
#define WMEM ((bf16_t*)(ws + WS_WMEM))
#define WBR ((bf16_t*)(ws + WS_WBR))
#define WOUT ((bf16_t*)(ws + WS_WOUT))
#define WGU ((bf16_t*)(ws + WS_WGU))
#define WDN ((bf16_t*)(ws + WS_WDN))
#define MEMN ((bf16_t*)(ws + WS_MEMN))
#define MKV ((bf16_t*)(ws + WS_MKV))
#define MKN ((bf16_t*)(ws + WS_MKN))
#define MVT ((bf16_t*)(ws + WS_MVT))
#define CUMF ((float*)(ws + WS_CUMF))
#define DEC ((float*)(ws + WS_DEC))
#define VTF ((bf16_t*)(ws + WS_VTF))
#define SIN ((bf16_t*)(ws + WS_SIN))
#define CS ((float*)(ws + WS_CS))
#define MRG ((bf16_t*)((unsigned char*)p.out + (size_t)32 * 1048576))
#define XBF ((bf16_t*)(ws + WS_XBF))
#define KC ((bf16_t*)p.out)
#define SSQ ((float*)(ws + WS_SSQ))
#define PROJ ((bf16_t*)(ws + WS_PROJ))
#define HB ((bf16_t*)(ws + WS_PROJ))

    volatile LAS unsigned* MISC = (volatile LAS unsigned*)(lds + LDS_BYTES - 64);
    if (threadIdx.x < 16) MISC[threadIdx.x] = 0u;
    __syncthreads();
    const XcdBarrier bar = xcd_barrier_post((unsigned*)(p.ws + WS_BAR), MISC);
#define GSYNC() xcd_barrier(bar)
    { PH_BEGIN
        LAS float* scr = (LAS float*)(lds + wid * 16384);
        constexpr int PER_L = 3456 + 512 + 768 + 512 + 2816 + 1408;
        for (int it = gw; it < NL * PER_L; it += NGW) {
            const int l = it / PER_L; int r = it % PER_L; const int ln = lane & 31;
            if (r < 3456) { const int kb = r / 216, nb = r % 216; transpose_item(p.in[I_WIN] + (size_t)l * 1024 * INW, 1024, INW, p.in[I_GMIX] + l * 1024, WIN + (size_t)l * PW * 1024, scr, kb, nb, lane, inmap(nb * 32 + ln)); continue; } r -= 3456;
            if (r < 512) { const int kb = r / 32, nb = r % 32; transpose_item(p.in[I_WMKV] + (size_t)l * 1024 * 1024, 1024, 1024, p.in[I_GMEM] + l * 1024, WMEM + (size_t)l * 1024 * 1024, scr, kb, nb, lane, nb * 32 + ln); continue; } r -= 512;
            if (r < 768) { const int i = r / 256, r2 = r % 256, kb = r2 / 32, nb = r2 % 32; transpose_item(p.in[I_WBR] + (size_t)(l * 3 + i) * 512 * 1024, 512, 1024, nullptr, WBR + (size_t)(l * 3 + i) * 1024 * 512, scr, kb, nb, lane, nb * 32 + ln); continue; } r -= 768;
            if (r < 512) { const int kb = r / 32, nb = r % 32; transpose_item(p.in[I_WOUT] + (size_t)l * 1024 * 1024, 1024, 1024, nullptr, WOUT + (size_t)l * 1024 * 1024, scr, kb, nb, lane, nb * 32 + ln); continue; } r -= 512;
            if (r < 2816) { const int kb = r / 176, nb = r % 176, n0 = nb * 32, t = n0 >> 8, rr = n0 & 255; const bool isup = rr >= 128;
                transpose_item((isup ? p.in[I_WFU] : p.in[I_WFG]) + (size_t)l * 1024 * DFF, 1024, DFF, p.in[I_GFFN] + l * 1024, WGU + (size_t)l * 5632 * 1024, scr, kb, nb, lane, 128 * t + (rr & 127) + ln); continue; } r -= 2816;
            { const int kb = r / 32, nb = r % 32; transpose_item(p.in[I_WFD] + (size_t)l * DFF * 1024, DFF, 1024, nullptr, WDN + (size_t)l * 1024 * DFF, scr, kb, nb, lane, nb * 32 + ln); }
        }
        norm_rows(p.in[I_MEM], MEMN, 1024, gw, NGW, lane);
        if (bx == 0 && tid < NL) {
            float am = 0.f, cm = 0.f;
            for (int i = 0; i < 128; ++i) { am = fmaxf(am, fabsf(p.in[I_GFQ][tid * 128 + i])); cm = fmaxf(cm, fabsf(p.in[I_GFK][tid * 128 + i])); }
            ((float*)(ws + WS_TSK))[tid] = 104.0f + 2.0f * 11.3137085f * am * cm * 1.01f + 1.0f;
        }
    }
    grid.sync();
    { PH_BEGIN pg8::Gemm g{MEMN, WMEM, 1024, 4096, 1024, 1024}; pg8::EpiStore E{MKV, 4096, nullptr}; GEMM_PHASE(pg8::EpiStore, g, E);
      if (G > 64) { if (bx >= 64) xb_rows(p.in[I_X], XBF, SSQ, 2 * MH, (bx - 64) * 8 + wid, (G - 64) * 8, lane); }
      else xb_rows(p.in[I_X], XBF, SSQ, 2 * MH, gw, NGW, lane); }
    GSYNC();
    { PH_BEGIN for (int u = bx; u < 256; u += G) { const int l = u >> 6, b = (u >> 4) & 3, h = (u >> 2) & 3, t = u & 3;
        const bf16_t* src = MKV + (size_t)(b * 256 + t * 64) * 4096 + l * 1024 + h * 128;
        norm128_rows64(src, 4096, MKN + ((size_t)(l * 4 + b) * 256 + t * 64) * 512 + h * 128, 512, p.in[I_GMK] + l * 128, 1.0f, tid);
        vt_tile(src + 512, 4096, MVT + ((size_t)((l * 4 + b) * 4 + h) * 128) * 256 + t * 64, 256, (LAS bf16_t*)lds, tid); } }
    for (int l = 0; l < NL; ++l) {
        for (int hf = 0; hf < 2; ++hf) {
            { PH_BEGIN pg8::Gemm g{XBF + (size_t)hf * MH * 1024, WIN + (size_t)l * PW * 1024, MH, PW, 1024, 1024}; pg8::EpiStore E{PROJ, PW, SSQ + (size_t)hf * MH * 16}; GEMM_PHASE(pg8::EpiStore, g, E); }
            GSYNC();
            { PH_BEGIN const int tid0_ = tid;
              for (int u = bx; u < 32; u += G) { int tid = tid0_; asm volatile("" : "+v"(tid)); const int lane = tid & 63;
                    const int bhp = u >> 2, sg = u & 3, bp = bhp >> 2, h = bhp & 3; const float fb = p.in[I_BFOX][l * 4 + h];
                    float loc[4]; float run = 0.f;
#pragma unroll
                    for (int i = 0; i < 4; ++i) { const float x = bf2f(PROJ[(size_t)(bp * SEQ + sg * 2048 + 4 * tid + i) * PW + C_FF + h]) + fb; run += log_sigmoid_(x); loc[i] = run; }
                    float sc = run;
#pragma unroll
                    for (int o = 1; o < 64; o <<= 1) { const float t = __shfl_up(sc, o); if (lane >= o) sc += t; }
                    LAS float* wt = (LAS float*)lds;
                    if (lane == 63) wt[wid] = sc;
                    __syncthreads();
                    float offs = sc - run;
                    for (int w = 0; w < wid; ++w) offs += wt[w];
                    *(f32x4*)(CUMF + (size_t)bhp * SEQ + sg * 2048 + 4 * tid) = (f32x4){loc[0] + offs, loc[1] + offs, loc[2] + offs, loc[3] + offs};
                    if (tid == 511) ((float*)(ws + WS_TSK))[16 + u] = loc[3] + offs;
                    __syncthreads();
              }
              for (int v0 = bx; v0 < 1024; v0 += 4 * G) { int tid = tid0_; asm volatile("" : "+v"(tid)); prep_batch(PROJ, p.in[I_GFK] + l * 128, KC, VTF, (LAS bf16_t*)lds, v0, G, tid); }
              for (int u = bx; u < 1024; u += 2 * G) { int tid = tid0_; asm volatile("" : "+v"(tid)); const int lane = tid & 63; gla_pair<false>(lds, p, l, u, (u + G < 1024 ? u + G : u), PROJ, CS, DEC, SIN, PROJ, tid, lane, wid); }
              for (int v = bx; v < 256; v += G) { int tid = tid0_; asm volatile("" : "+v"(tid)); const int lane = tid & 63;
                    const int rb = v >> 2, h = v & 3, r0 = rb * 256, bp = r0 / SEQ, b = hf * 2 + bp;
                    attn_unit<false>(lds, p.in[I_GMQ] + l * 128, PROJ + (size_t)r0 * PW + C_MQ + h * 128, PW, MKN + ((size_t)(l * 4 + b) * 256) * 512 + h * 128, 512,
                                     MVT + ((size_t)((l * 4 + b) * 4 + h) * 128) * 256, 256, 64, nullptr, 0.f, 0.f, 0.f, 0.f, 0, 0, 3, PROJ + (size_t)r0 * PW + C_MQ + h * 128, PW, tid, lane, wid);
              }
            }
            GSYNC();
            { PH_BEGIN
                for (int u = bx; u < 512; u += G) {
                    typedef float f32x2v __attribute__((ext_vector_type(2)));
                    const int e2 = u * 64 + lane, bhp = e2 >> 12, dvdk = (e2 & 4095) * 2, dk = dvdk & 63, seg = wid;
                    f32x2v c[16], d[16];
#pragma unroll
                    for (int i = 0; i < 16; ++i) { const size_t unit = (size_t)bhp * 128 + seg * 16 + i; c[i] = *(const f32x2v*)(CS + unit * 8192 + dvdk); d[i] = *(const f32x2v*)(DEC + unit * 64 + dk); }
                    f32x2v sl[16], pl[16]; f32x2v sacc = (f32x2v){0.f, 0.f}, pacc = (f32x2v){1.f, 1.f};
#pragma unroll
                    for (int i = 0; i < 16; ++i) { sl[i] = sacc; pl[i] = pacc; sacc = d[i] * sacc + c[i]; pacc = pacc * d[i]; }
                    LAS f32x4* AB = (LAS f32x4*)lds;
                    AB[seg * 64 + lane] = (f32x4){pacc.x, pacc.y, sacc.x, sacc.y};
                    __syncthreads();
                    f32x2v s0 = (f32x2v){0.f, 0.f};
                    for (int j = 0; j < seg; ++j) { const f32x4 ab = AB[j * 64 + lane]; s0 = (f32x2v){ab[0] * s0.x + ab[2], ab[1] * s0.y + ab[3]}; }
#pragma unroll
                    for (int i = 0; i < 16; ++i) { const size_t unit = (size_t)bhp * 128 + seg * 16 + i; const f32x2v v = sl[i] + pl[i] * s0;
                        *(unsigned*)(SIN + unit * 8192 + dvdk) = cvt_pk_bf16(v.x, v.y); }
                    __syncthreads();
                }
                const int nf = G, fidx = bx;
                const int tid0_ = tid; if (fidx >= 0) for (int u = fidx; u < 256; u += nf) { int tid = tid0_; asm volatile("" : "+v"(tid)); const int lane = tid & 63;
                    const int qb = 31 - (u >> 3), bhp = u & 7, bp = bhp >> 2, h = bhp & 3, q0 = qb * 256; const size_t r0 = (size_t)bp * SEQ + q0;
                    const float* cum = CUMF + (size_t)bhp * SEQ; const float* sgt = (const float*)(ws + WS_TSK) + 16 + bhp * 4;
                    const float o1 = sgt[0], o2 = o1 + sgt[1], o3 = o2 + sgt[2];
                    const int sq_ = q0 >> 11; const float cref = cum[q0] + (sq_ == 0 ? 0.f : sq_ == 1 ? o1 : sq_ == 2 ? o2 : o3);
                    int j0 = 0;
#if FOX_SKIP
                    {
                        const float T = ((const float*)(ws + WS_TSK))[l];
                        const int nt = q0 >> 6;
                        int cnt = 0;
                        if (tid < nt) { const int sk_ = tid >> 5; cnt = (cref - (cum[64 * tid + 63] + (sk_ == 0 ? 0.f : sk_ == 1 ? o1 : sk_ == 2 ? o2 : o3)) < -T) ? 1 : 0; }
                        const unsigned long long bal = __ballot(cnt);
                        LAS int* red = (LAS int*)(lds + 73728);
                        if (lane == 0 && wid < 2) red[wid] = __popcll(bal);
                        __syncthreads();
                        j0 = red[0] + red[1];
                    }
#endif
                    attn_unit<true>(lds, p.in[I_GFQ] + l * 128, PROJ + r0 * PW + C_FQ + h * 128, PW, KC + (size_t)bhp * SEQ * 128, 128, VTF + ((size_t)bhp * 128) * SEQ, 64, 8192,
                                    cum, cref, o1, o2, o3, q0, j0, (q0 >> 6) + 3, PROJ + r0 * PW + C_FQ + h * 128, PW, tid, lane, wid);
                }
            }
            GSYNC();
            { PH_BEGIN const int tid0_ = tid; for (int u = bx; u < 1024; u += 2 * G) { int tid = tid0_; asm volatile("" : "+v"(tid)); const int lane = tid & 63; gla_pair<true>(lds, p, l, u, (u + G < 1024 ? u + G : u), PROJ, CS, DEC, SIN, PROJ, tid, lane, wid); } }
            GSYNC();
            { PH_BEGIN
                pg8::Gemm g{PROJ, WBR + (size_t)l * 3 * 1024 * 512, MH, 3072, 512, PW};
                pg8::EpiGate E{PROJ + C_BG, PW, p.in[I_BGATE] + l * 3072, MRG + (size_t)hf * MH * 1024, 1024};
                pg8::BranchOrder S_; S_.init(MH, G, (int)blockIdx.x); static_assert(C_GV * 2 == 1024 && C_FQ * 2 == 3072 && C_MQ * 2 == 6144, "BranchOrder offsets"); pg8::gemm_phase<pg8::EpiGate, pg8::BranchOrder, true, true>(lds, g, S_, E);
            }
            GSYNC();
        }
        { PH_BEGIN pg8::Gemm g{MRG, WOUT + (size_t)l * 1024 * 1024, 2 * MH, 1024, 1024, 1024}; pg8::EpiResid E{nullptr, XBF, SSQ}; GEMM_PHASE(pg8::EpiResid, g, E); }
        GSYNC();
        { PH_BEGIN pg8::Gemm g{XBF, WGU + (size_t)l * 5632 * 1024, 2 * MH, 5632, 1024, 1024}; pg8::EpiSwiglu E{HB, DFF, SSQ}; GEMM_PHASE(pg8::EpiSwiglu, g, E); }
        GSYNC();
        { PH_BEGIN pg8::Gemm g{HB, WDN + (size_t)l * 1024 * DFF, 2 * MH, 1024, DFF, DFF}; pg8::EpiResid E{l == NL - 1 ? p.out : nullptr, XBF, SSQ}; GEMM_PHASE(pg8::EpiResid, g, E); }
        GSYNC();
    }
}

extern "C" void kernel_launch(void* const* d_in, const int* in_sizes, int n_in, void* d_out, int out_size, void* d_ws, size_t ws_size, hipStream_t stream) {
    static int grid = 0;
    if (grid == 0) {
        int dev = 0, cus = 0, per_cu = 0;
        hipGetDevice(&dev); hipDeviceGetAttribute(&cus, hipDeviceAttributeMultiprocessorCount, dev);
        hipFuncSetAttribute((const void*)mega_fwd, hipFuncAttributeMaxDynamicSharedMemorySize, LDS_BYTES);
        hipOccupancyMaxActiveBlocksPerMultiprocessor(&per_cu, (const void*)mega_fwd, 512, LDS_BYTES);
        if (per_cu < 1) { fprintf(stderr, "kernel_launch: occupancy query says %d blocks/CU\n", per_cu); per_cu = 1; }
        grid = cus * 1;
        if (ws_size < WS_END) { fprintf(stderr, "kernel_launch: workspace too small: %zu < %zu\n", ws_size, (size_t)WS_END); grid = -1; }
        (void)hipGetLastError();
    }
    if (grid < 0) return;
    Params p{};
    for (int i = 0; i < 21; ++i) p.in[i] = (const float*)d_in[i];
    p.out = (float*)d_out; p.ws = (unsigned char*)d_ws;
    hipMemsetAsync((unsigned char*)d_ws + WS_BAR, 0, 16384, stream);
    void* args[] = {&p};
    hipError_t e = hipLaunchCooperativeKernel((const void*)mega_fwd, dim3(grid), dim3(512), args, LDS_BYTES, stream);
    if (e != hipSuccess) fprintf(stderr, "cooperative launch failed: %s (grid %d)\n", hipGetErrorString(e), grid);
}
```

```cpp
#include <hip/hip_runtime.h>
#include <hip/hip_cooperative_groups.h>
#include <cstdio>
#include <cstdint>
#include <cmath>
namespace cg = cooperative_groups;
namespace pg8 {
#define PG8_LAS __attribute__((address_space(3)))
typedef unsigned short bf16_t;
typedef short bf16x8 __attribute__((ext_vector_type(8)));
typedef float f32x4 __attribute__((ext_vector_type(4)));
typedef unsigned u32x4 __attribute__((ext_vector_type(4)));
constexpr int BM = 256, BK = 64, HALF = 128, HTB = HALF * BK * 2  , STAGE_BYTES = 8 * HTB, NXCD = 8, WGM = 8;

__host__ __device__ __forceinline__ int lds_byte(int r, int c) { const int st = (r >> 4) * 2 + (c >> 5), rr = r & 15, cc = c & 31, ob = rr * 64 + cc * 2; return st * 1024 + (ob ^ (((ob >> 9) & 1) << 5)); }
__host__ __device__ __forceinline__ void stage_rc(int b, int& R, int& C) { const int st = b / 1024, sb = b % 1024, swz = sb ^ (((sb >> 9) & 1) << 5); R = (st >> 1) * 16 + swz / 64; C = (st & 1) * 32 + (swz % 64) / 2; }
__host__ __device__ __forceinline__ int perm32(int rho) { const int n = rho >> 4, i = rho & 15; return 8 * (i >> 2) + 4 * n + (i & 3); }

struct Unit { int pm, pn, aoff; };
struct Gemm { const bf16_t* A; const bf16_t* Bt; int M, N, K, lda; };

struct StaticOrder {
    int nM, nN, nwg, G, c;
    __host__ __device__ void init(int M, int N, int G_, int c_) { nM = M / BM; nN = N / BM; nwg = nM * nN; G = G_; c = c_; }
    __host__ __device__ bool next(int i, Unit& u) const {
        const long L = (long)i * G + c; if (L >= nwg) return false;
        int wgid = (int)L; { const int q = nwg / NXCD, r = nwg % NXCD, xcd = wgid % NXCD, off = wgid / NXCD; wgid = (xcd < r ? xcd * (q + 1) : r * (q + 1) + (xcd - r) * q) + off; }
        const int nig = WGM * nN, gid = wgid / nig, fm = gid * WGM, gsz = (nM - fm) < WGM ? (nM - fm) : WGM;
        u.pm = fm + ((wgid % nig) % gsz); u.pn = (wgid % nig) / gsz; u.aoff = 0; return true;
    }
    __device__ __forceinline__ void a_ready(const Unit&) const {}
    __device__ __forceinline__ void done(const Unit&) const {}
};
struct BranchOrder {
    StaticOrder S0;
    __host__ __device__ void init(int M, int G_, int c_) { S0.init(M, 1024, G_, c_); }
    __host__ __device__ bool next(int i, Unit& u) const { const int r = i / 3, b = i - 3 * r; if (!S0.next(r, u)) return false; u.pn += 4 * b; u.aoff = 1024 * (1 + 2 * b + (b >> 1)); return true; }
    __device__ __forceinline__ void a_ready(const Unit&) const {}
    __device__ __forceinline__ void done(const Unit&) const {}
};

__device__ __forceinline__ unsigned cvt_pk_bf16(float lo, float hi) { unsigned r; asm volatile("v_cvt_pk_bf16_f32 %0, %1, %2" : "=v"(r) : "v"(lo), "v"(hi)); return r; }
typedef float f32x2 __attribute__((ext_vector_type(2)));
typedef float f32x2 __attribute__((ext_vector_type(2)));
__device__ __forceinline__ float bf2f(unsigned short b) { return __uint_as_float((unsigned)b << 16); }
__device__ __forceinline__ float bflo(unsigned w) { return __uint_as_float(w << 16); }
__device__ __forceinline__ float bfhi(unsigned w) { return __uint_as_float(w & 0xffff0000u); }
__device__ __forceinline__ float xsum32(float s) { const auto r = __builtin_amdgcn_permlane32_swap(__float_as_uint(s), __float_as_uint(s), false, false); return __uint_as_float(r[0]) + __uint_as_float(r[1]); }
__device__ __forceinline__ float xmax32(float s) { const auto r = __builtin_amdgcn_permlane32_swap(__float_as_uint(s), __float_as_uint(s), false, false); return fmaxf(__uint_as_float(r[0]), __uint_as_float(r[1])); }
__device__ __forceinline__ float xsum16(float s) { const auto r = __builtin_amdgcn_permlane16_swap(__float_as_uint(s), __float_as_uint(s), false, false); return __uint_as_float(r[0]) + __uint_as_float(r[1]); }
__device__ __forceinline__ float sigmoidf_(float x) { return __builtin_amdgcn_rcpf(1.0f + __builtin_amdgcn_exp2f(-1.4426950408889634f * x)); }
__device__ __forceinline__ float row_rs(const float* ssq, size_t row, int fq) {
    const f32x4 q = *(const f32x4*)(ssq + row * 16 + 4 * fq); float s = (q[0] + q[1]) + (q[2] + q[3]);
    s = xsum16(s); s = xsum32(s);
    return __builtin_amdgcn_rsqf(s * (1.0f / 1024.0f) + 1e-6f);
}
struct EpiStore {
    static constexpr bool PERM = true, AFTER_DRAIN = false;
    bf16_t* O; int ldc; const float* ssq;
    __device__ __forceinline__ void operator()(const f32x4 (&acc)[2][2][4][2], const Unit& u, int wr, int wc, int fr, int fq) const {
        const int row0 = u.pm * BM + wr * 64 + fr, col0 = u.pn * BM + wc * 32 + 8 * fq;
#pragma unroll
        for (int ai = 0; ai < 2; ++ai)
#pragma unroll
            for (int m = 0; m < 4; ++m) { const size_t row = (size_t)(row0 + ai * HALF + m * 16); bf16_t* rowp = O + row * ldc + col0;
                const float rs = ssq ? row_rs(ssq, row, fq) : 1.0f;
#pragma unroll
                for (int bj = 0; bj < 2; ++bj) { const f32x4 v0 = acc[ai][bj][m][0] * rs, v1 = acc[ai][bj][m][1] * rs;
                    u32x4 w; w.x = cvt_pk_bf16(v0[0], v0[1]); w.y = cvt_pk_bf16(v0[2], v0[3]); w.z = cvt_pk_bf16(v1[0], v1[1]); w.w = cvt_pk_bf16(v1[2], v1[3]);
                    *(u32x4*)(rowp + bj * HALF) = w; } }
    }
};
struct EpiGate {
    static constexpr bool PERM = true, AFTER_DRAIN = false;
    const bf16_t* G; int ldg; const float* bias; bf16_t* O; int ldc;
    __device__ __forceinline__ void operator()(const f32x4 (&acc)[2][2][4][2], const Unit& u, int wr, int wc, int fr, int fq) const {
        const int row0 = u.pm * BM + wr * 64 + fr, gcol0 = u.pn * BM + wc * 32 + 8 * fq, col0 = (u.pn & 3) * BM + wc * 32 + 8 * fq; const bool first = u.pn < 4;
#pragma unroll
        for (int bj = 0; bj < 2; ++bj) {
            const f32x4 b0 = *(const f32x4*)(bias + gcol0 + bj * HALF), b1 = *(const f32x4*)(bias + gcol0 + bj * HALF + 4);
#pragma unroll
            for (int ai = 0; ai < 2; ++ai)
#pragma unroll
                for (int m = 0; m < 4; ++m) { const size_t r = (size_t)(row0 + ai * HALF + m * 16);
                    const u32x4 gw = *(const u32x4*)(G + r * ldg + gcol0 + bj * HALF);
                    bf16_t* op = O + r * ldc + col0 + bj * HALF;
                    u32x4 pw = (u32x4){0u, 0u, 0u, 0u}; if (!first) pw = *(const u32x4*)op;
                    const f32x4 v0 = acc[ai][bj][m][0], v1 = acc[ai][bj][m][1];
                    float r0 = bflo(pw.x) + sigmoidf_(bflo(gw.x) + b0[0]) * v0[0], r1 = bfhi(pw.x) + sigmoidf_(bfhi(gw.x) + b0[1]) * v0[1];
                    float r2 = bflo(pw.y) + sigmoidf_(bflo(gw.y) + b0[2]) * v0[2], r3 = bfhi(pw.y) + sigmoidf_(bfhi(gw.y) + b0[3]) * v0[3];
                    float r4 = bflo(pw.z) + sigmoidf_(bflo(gw.z) + b1[0]) * v1[0], r5 = bfhi(pw.z) + sigmoidf_(bfhi(gw.z) + b1[1]) * v1[1];
                    float r6 = bflo(pw.w) + sigmoidf_(bflo(gw.w) + b1[2]) * v1[2], r7 = bfhi(pw.w) + sigmoidf_(bfhi(gw.w) + b1[3]) * v1[3];
                    u32x4 w; w.x = cvt_pk_bf16(r0, r1); w.y = cvt_pk_bf16(r2, r3); w.z = cvt_pk_bf16(r4, r5); w.w = cvt_pk_bf16(r6, r7);
                    *(u32x4*)op = w; }
        }
    }
};
struct EpiResid {
    static constexpr bool PERM = true, AFTER_DRAIN = false;
    float* out; bf16_t* xb; float* ssq;
    __device__ __forceinline__ void operator()(const f32x4 (&acc)[2][2][4][2], const Unit& u, int wr, int wc, int fr, int fq) const {
        const int row0 = u.pm * BM + wr * 64 + fr, col0 = u.pn * BM + wc * 32 + 8 * fq;
#pragma unroll
        for (int ai = 0; ai < 2; ++ai)
#pragma unroll
            for (int m = 0; m < 4; ++m) { const size_t row = (size_t)(row0 + ai * HALF + m * 16), off = row * 1024 + col0; float ss = 0.f;
#pragma unroll
                for (int bj = 0; bj < 2; ++bj) {
                    const u32x4 rw = *(const u32x4*)(xb + off + bj * HALF);
                    const f32x4 a = (f32x4){bflo(rw.x), bfhi(rw.x), bflo(rw.y), bfhi(rw.y)} + acc[ai][bj][m][0], b = (f32x4){bflo(rw.z), bfhi(rw.z), bflo(rw.w), bfhi(rw.w)} + acc[ai][bj][m][1];
                    if (out) { *(f32x4*)(out + off + bj * HALF) = a; *(f32x4*)(out + off + bj * HALF + 4) = b; }
                    ss += (a[0] * a[0] + a[1] * a[1]) + (a[2] * a[2] + a[3] * a[3]) + (b[0] * b[0] + b[1] * b[1]) + (b[2] * b[2] + b[3] * b[3]);
                    u32x4 w; w.x = cvt_pk_bf16(a[0], a[1]); w.y = cvt_pk_bf16(a[2], a[3]); w.z = cvt_pk_bf16(b[0], b[1]); w.w = cvt_pk_bf16(b[2], b[3]);
                    *(u32x4*)(xb + off + bj * HALF) = w; }
                ss = xsum16(ss); ss = xsum32(ss);
                if (fq == 0) ssq[row * 16 + u.pn * 4 + wc] = ss; }
    }
};
struct EpiSwiglu {
    static constexpr bool PERM = true, AFTER_DRAIN = false;
    bf16_t* O; int ldc; const float* ssq;
    __device__ __forceinline__ void operator()(const f32x4 (&acc)[2][2][4][2], const Unit& u, int wr, int wc, int fr, int fq) const {
        const int row0 = u.pm * BM + wr * 64 + fr, col0 = u.pn * HALF + wc * 32 + 8 * fq;
#pragma unroll
        for (int ai = 0; ai < 2; ++ai)
#pragma unroll
            for (int m = 0; m < 4; ++m) { float h[8]; const float rs = row_rs(ssq, (size_t)(row0 + ai * HALF + m * 16), fq);
#pragma unroll
                for (int n = 0; n < 2; ++n)
#pragma unroll
                    for (int j = 0; j < 4; ++j) { const float gt = acc[ai][0][m][n][j] * rs, up = acc[ai][1][m][n][j] * rs; h[4 * n + j] = gt * sigmoidf_(gt) * up; }
                u32x4 w; w.x = cvt_pk_bf16(h[0], h[1]); w.y = cvt_pk_bf16(h[2], h[3]); w.z = cvt_pk_bf16(h[4], h[5]); w.w = cvt_pk_bf16(h[6], h[7]);
                *(u32x4*)(O + (size_t)(row0 + ai * HALF + m * 16) * ldc + col0) = w; }
    }
};
template <class Epi, class Sched, bool ALIGN_EPI = false, bool SP2 = false>
__device__ __forceinline__ void gemm_phase(PG8_LAS unsigned char* lds, const Gemm g, const Sched& S, const Epi& E) {
    int tid_ = threadIdx.x; asm volatile("" : "+v"(tid_)); const int tid = tid_, wid = __builtin_amdgcn_readfirstlane(tid >> 6), lane = tid & 63, wr = wid >> 2, wc = wid & 3, fr = lane & 15, fq = lane >> 4;
    const int K = g.K, nt = K / BK;
    unsigned voffA[2], voffB[2];
#pragma unroll
    for (int i = 0; i < 2; ++i) { int R, C; stage_rc(tid * 16 + i * 8192, R, C); const int Rb = Epi::PERM ? ((R & ~31) + perm32(R & 31)) : R;
        voffA[i] = (unsigned)(R * g.lda + C) * 2u; voffB[i] = (unsigned)(Rb * K + C) * 2u; }
    const size_t kstep = (size_t)(BK * 2);
    const size_t hstepA = (size_t)HALF * g.lda * 2, hstepB = (size_t)HALF * K * 2;
    const size_t tstepA = 2 * hstepA, tstepB = 2 * hstepB;
    const unsigned ldsw = (unsigned)wid * 1024u;
    const int aoff = lds_byte(wr * 64 + fr, fq * 8), boff = lds_byte(wc * 32 + fr, fq * 8);
#define PG8_SA(b, h) (((b) * 2 + (h)) * HTB)
#define PG8_SB(b, h) ((4 + (b) * 2 + (h)) * HTB)
#define PG8_STAGE(bufoff, gbase, voff) do { _Pragma("unroll") for (int _i = 0; _i < 2; ++_i) \
        __builtin_amdgcn_global_load_lds((const unsigned*)((const char*)(gbase) + (voff)[_i]), (PG8_LAS unsigned*)(lds + (bufoff) + ldsw + _i * 8192), 16, 0, 0); } while (0)
#define PG8_LDA(dst, b, h) do { _Pragma("unroll") for (int m = 0; m < 4; ++m) _Pragma("unroll") for (int k = 0; k < 2; ++k) dst[m][k] = *(const PG8_LAS bf16x8*)(lds + PG8_SA(b, h) + aoff + m * 2048 + k * 1024); } while (0)
#define PG8_LDB(dst, b, h) do { _Pragma("unroll") for (int n = 0; n < 2; ++n) _Pragma("unroll") for (int k = 0; k < 2; ++k) dst[n][k] = *(const PG8_LAS bf16x8*)(lds + PG8_SB(b, h) + boff + n * 2048 + k * 1024); } while (0)
#define PG8_MMA(ai, bj, At, Bt) do { __builtin_amdgcn_s_setprio(1); _Pragma("unroll") for (int m = 0; m < 4; ++m) _Pragma("unroll") for (int n = 0; n < 2; ++n) _Pragma("unroll") for (int k = 0; k < 2; ++k) \
        acc[ai][bj][m][n] = __builtin_amdgcn_mfma_f32_16x16x32_bf16(Bt[n][k], At[m][k], acc[ai][bj][m][n], 0, 0, 0); __builtin_amdgcn_s_setprio(0); } while (0)
#define PG8_WAIT_V(n) asm volatile("s_waitcnt vmcnt(" #n ")" ::: "memory")
#define PG8_WAIT_L(n) asm volatile("s_waitcnt lgkmcnt(" #n ")" ::: "memory")
#define PG8_BAR __builtin_amdgcn_s_barrier()
#define PG8_SCHED __builtin_amdgcn_sched_barrier(0)
    Unit cur, nxt; int ui = 0;
    if (!S.next(0, cur)) return;
    f32x4 acc[2][2][4][2];
#pragma unroll
    for (int a = 0; a < 2; ++a)
#pragma unroll
        for (int b = 0; b < 2; ++b)
#pragma unroll
            for (int m = 0; m < 4; ++m)
#pragma unroll
                for (int n = 0; n < 2; ++n) acc[a][b][m][n] = (f32x4){0.f, 0.f, 0.f, 0.f};
    bf16x8 At[4][2], B0[2][2], B1[2][2];
    const char* cA = (const char*)g.A + (size_t)cur.pm * tstepA + cur.aoff; const char* cB = (const char*)g.Bt + (size_t)cur.pn * tstepB;
    S.a_ready(cur);
    if constexpr (SP2) {
        PG8_STAGE(PG8_SB(0, 0), cB, voffB); PG8_STAGE(PG8_SB(0, 1), cB + hstepB, voffB); PG8_STAGE(PG8_SA(0, 0), cA, voffA); PG8_STAGE(PG8_SA(0, 1), cA + hstepA, voffA);
        if (wr == 1) PG8_BAR;
        PG8_WAIT_V(2); PG8_BAR;
        PG8_STAGE(PG8_SB(1, 0), cB + kstep, voffB); PG8_STAGE(PG8_SA(1, 0), cA + kstep, voffA); PG8_STAGE(PG8_SB(1, 1), cB + hstepB + kstep, voffB);
        PG8_WAIT_V(6); PG8_BAR;
    } else {
        PG8_STAGE(PG8_SB(0, 0), cB, voffB); PG8_STAGE(PG8_SA(0, 0), cA, voffA); PG8_STAGE(PG8_SB(0, 1), cB + hstepB, voffB); PG8_STAGE(PG8_SA(0, 1), cA + hstepA, voffA);
        if (wr == 1) PG8_BAR;
        PG8_WAIT_V(4); PG8_BAR;
        PG8_STAGE(PG8_SB(1, 0), cB + kstep, voffB); PG8_STAGE(PG8_SA(1, 0), cA + kstep, voffA); PG8_STAGE(PG8_SB(1, 1), cB + hstepB + kstep, voffB);
        PG8_WAIT_V(6); PG8_BAR;
    }
    for (;;) {
        const bool has_next = S.next(ui + 1, nxt);
        const char* nA = has_next ? (const char*)g.A + (size_t)nxt.pm * tstepA + nxt.aoff : cA; const char* nB = has_next ? (const char*)g.Bt + (size_t)nxt.pn * tstepB : cB;
        for (int t = 0; t < nt; t += 2) {
            const bool last = (t == nt - 2);
            const char* a1 = cA + (size_t)(t + 1) * kstep;
            const char* a2 = last ? nA : cA + (size_t)(t + 2) * kstep; const char* b2 = last ? nB : cB + (size_t)(t + 2) * kstep;
            const char* a3 = a2 + kstep; const char* b3 = b2 + kstep;
            if (last && has_next) S.a_ready(nxt);
            if constexpr (SP2) {
            PG8_LDB(B0, 0, 0); PG8_LDB(B1, 0, 1); PG8_SCHED; PG8_LDA(At, 0, 0); PG8_STAGE(PG8_SA(1, 1), a1 + hstepA, voffA);
            PG8_WAIT_V(8); PG8_WAIT_L(0); PG8_BAR; PG8_MMA(0, 0, At, B0); PG8_MMA(0, 1, At, B1); PG8_BAR; PG8_SCHED;
            PG8_LDA(At, 0, 1); PG8_STAGE(PG8_SB(0, 0), b2, voffB); PG8_STAGE(PG8_SB(0, 1), b2 + hstepB, voffB); PG8_STAGE(PG8_SA(0, 0), a2, voffA);
            PG8_WAIT_V(8); PG8_WAIT_L(0); PG8_BAR; PG8_MMA(1, 0, At, B0); PG8_MMA(1, 1, At, B1); PG8_BAR; PG8_SCHED;
            PG8_LDB(B0, 1, 0); PG8_LDB(B1, 1, 1); PG8_SCHED; PG8_LDA(At, 1, 0); PG8_STAGE(PG8_SA(0, 1), a2 + hstepA, voffA);
            PG8_WAIT_V(8); PG8_WAIT_L(0); PG8_BAR; PG8_MMA(0, 0, At, B0); PG8_MMA(0, 1, At, B1); PG8_BAR; PG8_SCHED;
            PG8_LDA(At, 1, 1); PG8_STAGE(PG8_SB(1, 0), b3, voffB); PG8_STAGE(PG8_SB(1, 1), b3 + hstepB, voffB); PG8_STAGE(PG8_SA(1, 0), a3, voffA);
            PG8_WAIT_V(8); PG8_WAIT_L(0); PG8_BAR; PG8_MMA(1, 0, At, B0); PG8_MMA(1, 1, At, B1); PG8_BAR; PG8_SCHED;
            } else {
            PG8_LDB(B0, 0, 0); PG8_SCHED; PG8_LDA(At, 0, 0); PG8_STAGE(PG8_SA(1, 1), a1 + hstepA, voffA);
            PG8_WAIT_L(8); PG8_BAR; PG8_WAIT_L(0); PG8_MMA(0, 0, At, B0); PG8_BAR; PG8_SCHED;
            PG8_LDB(B1, 0, 1); PG8_STAGE(PG8_SB(0, 0), b2, voffB);
            PG8_BAR; PG8_WAIT_L(0); PG8_MMA(0, 1, At, B1); PG8_BAR;
            PG8_LDA(At, 0, 1); PG8_STAGE(PG8_SA(0, 0), a2, voffA);
            PG8_BAR; PG8_WAIT_L(0); PG8_MMA(1, 0, At, B0); PG8_BAR; PG8_SCHED;
            PG8_STAGE(PG8_SB(0, 1), b2 + hstepB, voffB);
            PG8_WAIT_V(6); PG8_BAR; PG8_MMA(1, 1, At, B1); PG8_BAR;
            PG8_LDB(B0, 1, 0); PG8_SCHED; PG8_LDA(At, 1, 0); PG8_STAGE(PG8_SA(0, 1), a2 + hstepA, voffA);
            PG8_WAIT_L(8); PG8_BAR; PG8_WAIT_L(0); PG8_MMA(0, 0, At, B0); PG8_BAR; PG8_SCHED;
            PG8_LDB(B1, 1, 1); PG8_STAGE(PG8_SB(1, 0), b3, voffB);
            PG8_BAR; PG8_WAIT_L(0); PG8_MMA(0, 1, At, B1); PG8_BAR;
            PG8_LDA(At, 1, 1); PG8_STAGE(PG8_SA(1, 0), a3, voffA);
            PG8_BAR; PG8_WAIT_L(0); PG8_MMA(1, 0, At, B0); PG8_BAR; PG8_SCHED;
            PG8_STAGE(PG8_SB(1, 1), b3 + hstepB, voffB);
            PG8_WAIT_V(6); PG8_BAR; PG8_MMA(1, 1, At, B1); PG8_BAR;
            }
        }
        if constexpr (ALIGN_EPI) { if (wr == 0) PG8_BAR; }
        if constexpr (!Epi::AFTER_DRAIN) { E(acc, cur, wr, wc, fr, fq); S.done(cur); }
        if (!has_next) break;
#pragma unroll
        for (int a = 0; a < 2; ++a)
#pragma unroll
            for (int b = 0; b < 2; ++b)
#pragma unroll
                for (int m = 0; m < 4; ++m)
#pragma unroll
                    for (int n = 0; n < 2; ++n) acc[a][b][m][n] = (f32x4){0.f, 0.f, 0.f, 0.f};
        cur = nxt; cA = nA; cB = nB; ++ui;
        if constexpr (ALIGN_EPI) { if (wr == 1) PG8_BAR; }
    }
    PG8_WAIT_V(0);
    if constexpr (!ALIGN_EPI) { if (wr == 0) PG8_BAR; }
    PG8_BAR;
    if constexpr (Epi::AFTER_DRAIN) { E.fused(acc, cur, wr, wc, fr, fq, lds, wid, lane); S.done(cur); }
#undef PG8_SA
#undef PG8_SB
#undef PG8_STAGE
#undef PG8_LDA
#undef PG8_LDB
#undef PG8_MMA
#undef PG8_WAIT_V
#undef PG8_WAIT_L
#undef PG8_BAR
#undef PG8_SCHED
}
}

#define LAS __attribute__((address_space(3)))
typedef unsigned short bf16_t;
typedef short bf16x8 __attribute__((ext_vector_type(8)));
typedef short s16x4 __attribute__((ext_vector_type(4)));
typedef float f32x4 __attribute__((ext_vector_type(4)));
typedef float f32x16 __attribute__((ext_vector_type(16)));
typedef unsigned u32x4 __attribute__((ext_vector_type(4)));
typedef unsigned u32x2 __attribute__((ext_vector_type(2)));
using pg8::cvt_pk_bf16; using pg8::bf2f; using pg8::bflo; using pg8::bfhi; using pg8::sigmoidf_;

constexpr int SEQ = 8192, DM = 1024, NL = 4, MH = 16384, PW = 6912, DFF = 2816, INW = 6676, YW = 1536;
constexpr int C_GQ = 0, C_GK = 256, C_GV = 512, C_GG = 1024, C_FQ = 1536, C_FK = 2048, C_FV = 2560, C_MQ = 3072, C_BG = 3584, C_GA1 = 6656, C_FF = 6672;
constexpr float EPSN = 1e-6f, LOG2E = 1.4426950408889634f;
#ifndef FOX_SKIP
#define FOX_SKIP 1
#endif
constexpr size_t WS_WIN = 0, WS_WMEM = WS_WIN + (size_t)NL * PW * 1024 * 2, WS_WBR = WS_WMEM + (size_t)4096 * 1024 * 2, WS_WOUT = WS_WBR + (size_t)NL * 3 * 1024 * 512 * 2,
    WS_WGU = WS_WOUT + (size_t)NL * 1024 * 1024 * 2, WS_WDN = WS_WGU + (size_t)NL * 5632 * 1024 * 2,
    WS_MKN = WS_WDN + (size_t)NL * 1024 * DFF * 2, WS_MVT = WS_MKN + (size_t)NL * 1024 * 512 * 2, WS_CUMF = WS_MVT + (size_t)NL * 16 * 128 * 256 * 2, WS_DEC = WS_CUMF + (size_t)8 * SEQ * 4,
    WS_VTF = WS_DEC + (size_t)1024 * 64 * 4, WS_SIN = WS_VTF + (size_t)8 * 128 * SEQ * 2, WS_CS = WS_SIN + (size_t)1024 * 128 * 64 * 2, WS_XBF = WS_CS + (size_t)1024 * 128 * 64 * 4,
    WS_PROJ = WS_XBF + (size_t)2 * MH * 1024 * 2, WS_TSK = WS_PROJ + (size_t)MH * PW * 2, WS_BAR = WS_TSK + 256, WS_SSQ = WS_BAR + 16384, WS_MKV = WS_SSQ + (size_t)2 * MH * 16 * 4, WS_END = WS_MKV + (size_t)1024 * 4096 * 2;
constexpr size_t WS_MEMN = WS_PROJ;
static_assert((size_t)2 * MH * DFF * 2 <= (size_t)MH * PW * 2, "full-batch FFN hidden overlays PROJ");
static_assert(WS_END <= (size_t)536870912, "workspace map exceeds 512 MiB");
static_assert((size_t)MH * 1024 * 2 <= (size_t)1024 * 128 * 64 * 4, "MRG overlays CS");

struct Params { const float* in[21]; float* out; unsigned char* ws; };
enum { I_X = 0, I_MEM, I_GMIX, I_WIN, I_WA2, I_BA, I_GGLA, I_BFOX, I_GFQ, I_GFK, I_GMEM, I_WMKV, I_GMQ, I_GMK, I_BGATE, I_WBR, I_WOUT, I_GFFN, I_WFG, I_WFU, I_WFD };

__device__ __forceinline__ float wave_sum(float v) {
#pragma unroll
    for (int o = 1; o < 64; o <<= 1) v += __shfl_xor(v, o);
    return v;
}
__device__ __forceinline__ float log_sigmoid_(float x) { return fminf(x, 0.f) - __logf(1.0f + __expf(-fabsf(x))); }
#define LDS_WAIT() asm volatile("s_waitcnt lgkmcnt(0)" ::: "memory")

__device__ __forceinline__ int inmap(int n) { if (n < 1536) return n; if (n < 3072) return n + 16; if (n < 6656) return n + 20; if (n < 6672) return 1536 + (n - 6656); if (n < 6676) return 3088 + (n - 6672); return -1; }

__device__ __forceinline__ void transpose_item(const float* W, int K, int Ns, const float* gain, bf16_t* WT, LAS float* scr, int kb, int nb, int lane, int sc) {
    const int k0 = 64 * kb, n0 = 32 * nb, c = lane & 7;
    float v[32];
    const float* wp = W + (size_t)(k0 + (lane >> 5)) * Ns + (sc >= 0 ? sc : 0);
#pragma unroll
    for (int i = 0; i < 32; ++i) v[i] = wp[(size_t)(2 * i) * Ns];
    f32x4 g0 = (f32x4){1.f, 1.f, 1.f, 1.f}, g1 = g0;
    if (gain) { g0 = *(const f32x4*)(gain + k0 + 8 * c); g1 = *(const f32x4*)(gain + k0 + 8 * c + 4); }
    if (sc < 0) {
#pragma unroll
        for (int i = 0; i < 32; ++i) v[i] = 0.f;
    }
#pragma unroll
    for (int i = 0; i < 32; ++i) scr[(2 * i + (lane >> 5)) * 33 + (lane & 31)] = v[i];
    LDS_WAIT();
#pragma unroll
    for (int j = 0; j < 4; ++j) { const int n = (lane >> 3) + 8 * j; const LAS float* s = scr + (8 * c) * 33 + n;
        u32x4 o; o.x = cvt_pk_bf16(s[0 * 33] * g0[0], s[1 * 33] * g0[1]); o.y = cvt_pk_bf16(s[2 * 33] * g0[2], s[3 * 33] * g0[3]); o.z = cvt_pk_bf16(s[4 * 33] * g1[0], s[5 * 33] * g1[1]); o.w = cvt_pk_bf16(s[6 * 33] * g1[2], s[7 * 33] * g1[3]);
        *(u32x4*)(WT + (size_t)(n0 + n) * K + k0 + 8 * c) = o; }
    LDS_WAIT();
}
__device__ __forceinline__ void norm_rows(const float* X, bf16_t* XN, int nrows, int gw, int NGW, int lane) {
    for (int m = gw; m < nrows; m += NGW) {
        const f32x4* xr = (const f32x4*)(X + (size_t)m * DM) + lane; f32x4 v[4]; float s = 0.f;
#pragma unroll
        for (int j = 0; j < 4; ++j) { v[j] = xr[64 * j]; s += (v[j].x * v[j].x + v[j].y * v[j].y) + (v[j].z * v[j].z + v[j].w * v[j].w); }
        const float r = __builtin_amdgcn_rsqf(wave_sum(s) * (1.0f / DM) + EPSN);
        u32x2* o8 = (u32x2*)(XN + (size_t)m * DM) + lane;
#pragma unroll
        for (int j = 0; j < 4; ++j) { u32x2 w; w.x = cvt_pk_bf16(v[j].x * r, v[j].y * r); w.y = cvt_pk_bf16(v[j].z * r, v[j].w * r); o8[64 * j] = w; }
    }
}
__device__ __forceinline__ void norm128_rows64(const bf16_t* src, size_t spitch, bf16_t* dst, size_t dpitch, const float* gain, float scale, int tid) {
    const int sub = tid & 15; float g[8];
#pragma unroll
    for (int j = 0; j < 8; ++j) g[j] = gain[sub * 8 + j] * scale;
#pragma unroll
    for (int pass = 0; pass < 2; ++pass) { const int row = pass * 32 + (tid >> 4);
        const u32x4 w = *(const u32x4*)(src + (size_t)row * spitch + sub * 8);
        float v[8] = {bflo(w.x), bfhi(w.x), bflo(w.y), bfhi(w.y), bflo(w.z), bfhi(w.z), bflo(w.w), bfhi(w.w)};
        float ss = 0.f;
#pragma unroll
        for (int j = 0; j < 8; ++j) ss += v[j] * v[j];
        ss += __shfl_xor(ss, 1); ss += __shfl_xor(ss, 2); ss += __shfl_xor(ss, 4); ss += __shfl_xor(ss, 8);
        const float r = __builtin_amdgcn_rsqf(ss * (1.0f / 128.0f) + EPSN);
        u32x4 o; o.x = cvt_pk_bf16(v[0] * r * g[0], v[1] * r * g[1]); o.y = cvt_pk_bf16(v[2] * r * g[2], v[3] * r * g[3]); o.z = cvt_pk_bf16(v[4] * r * g[4], v[5] * r * g[5]); o.w = cvt_pk_bf16(v[6] * r * g[6], v[7] * r * g[7]);
        *(u32x4*)(dst + (size_t)row * dpitch + sub * 8) = o; }
}
__device__ __forceinline__ void vt_tile(const bf16_t* src, size_t spitch, bf16_t* dst, size_t dpitch, LAS bf16_t* T, int tid) {
#pragma unroll
    for (int i = 0; i < 2; ++i) { const int c = tid + 512 * i, row = c >> 4, part = c & 15; const u32x4 w = *(const u32x4*)(src + (size_t)row * spitch + part * 8); *(LAS u32x4*)(T + row * 136 + part * 8) = w; }
    __syncthreads();
    const int d = tid & 127, part = tid >> 7; unsigned v[16];
#pragma unroll
    for (int i = 0; i < 16; ++i) v[i] = T[(16 * part + i) * 136 + d];
    u32x4 w0, w1; w0.x = v[0] | (v[1] << 16); w0.y = v[2] | (v[3] << 16); w0.z = v[4] | (v[5] << 16); w0.w = v[6] | (v[7] << 16);
    w1.x = v[8] | (v[9] << 16); w1.y = v[10] | (v[11] << 16); w1.z = v[12] | (v[13] << 16); w1.w = v[14] | (v[15] << 16);
    *(u32x4*)(dst + (size_t)d * dpitch + 16 * part) = w0; *(u32x4*)(dst + (size_t)d * dpitch + 16 * part + 8) = w1;
    __syncthreads();
}
__device__ __forceinline__ void prep_batch(const bf16_t* PROJp, const float* gk, bf16_t* KCp, bf16_t* VTFp, LAS bf16_t* T, int v0, int vs, int tid) {
    const int sub = tid & 15, row = tid >> 4;
    u32x4 w[4][2], vw[4][2];
#pragma unroll
    for (int q = 0; q < 4; ++q) { const int v = v0 + q * vs; if (v < 1024) { const int r0 = (v >> 2) * 64, h = v & 3; const bf16_t* rowp = PROJp + (size_t)r0 * PW;
#pragma unroll
        for (int ps = 0; ps < 2; ++ps) w[q][ps] = *(const u32x4*)(rowp + (size_t)(ps * 32 + row) * PW + C_FK + h * 128 + sub * 8);
#pragma unroll
        for (int i = 0; i < 2; ++i) { const int c = tid + 512 * i; vw[q][i] = *(const u32x4*)(rowp + (size_t)(c >> 4) * PW + C_FV + h * 128 + (c & 15) * 8); } } }
    float g[8];
#pragma unroll
    for (int j = 0; j < 8; ++j) g[j] = gk[sub * 8 + j];
#pragma unroll
    for (int q = 0; q < 4; ++q) { const int v = v0 + q * vs; if (v < 1024) { const int r0 = (v >> 2) * 64, h = v & 3, bp = r0 / SEQ, s0 = r0 % SEQ;
        bf16_t* kdst = KCp + ((size_t)(bp * 4 + h) * SEQ + s0) * 128;
#pragma unroll
        for (int ps = 0; ps < 2; ++ps) { const u32x4 x = w[q][ps];
            float f[8] = {bflo(x.x), bfhi(x.x), bflo(x.y), bfhi(x.y), bflo(x.z), bfhi(x.z), bflo(x.w), bfhi(x.w)};
            float ss = 0.f;
#pragma unroll
            for (int j = 0; j < 8; ++j) ss += f[j] * f[j];
            ss += __shfl_xor(ss, 1); ss += __shfl_xor(ss, 2); ss += __shfl_xor(ss, 4); ss += __shfl_xor(ss, 8);
            const float r = __builtin_amdgcn_rsqf(ss * (1.0f / 128.0f) + EPSN);
            u32x4 o; o.x = cvt_pk_bf16(f[0] * r * g[0], f[1] * r * g[1]); o.y = cvt_pk_bf16(f[2] * r * g[2], f[3] * r * g[3]); o.z = cvt_pk_bf16(f[4] * r * g[4], f[5] * r * g[5]); o.w = cvt_pk_bf16(f[6] * r * g[6], f[7] * r * g[7]);
            *(u32x4*)(kdst + (ps * 32 + row) * 128 + sub * 8) = o; }
#pragma unroll
        for (int i = 0; i < 2; ++i) { const int c = tid + 512 * i; *(LAS u32x4*)(T + q * 8704 + (c >> 4) * 136 + (c & 15) * 8) = vw[q][i]; } } }
    __syncthreads();
    const int d = tid & 127, part = tid >> 7;
#pragma unroll
    for (int q = 0; q < 4; ++q) { const int v = v0 + q * vs; if (v < 1024) { const int r0 = (v >> 2) * 64, h = v & 3, bp = r0 / SEQ, s0 = r0 % SEQ;
        bf16_t* vtdst = VTFp + ((size_t)(bp * 4 + h) * 128 + (s0 >> 6)) * 8192; unsigned e[16];
#pragma unroll
        for (int i = 0; i < 16; ++i) e[i] = T[q * 8704 + (16 * part + i) * 136 + d];
        u32x4 w0, w1; w0.x = e[0] | (e[1] << 16); w0.y = e[2] | (e[3] << 16); w0.z = e[4] | (e[5] << 16); w0.w = e[6] | (e[7] << 16);
        w1.x = e[8] | (e[9] << 16); w1.y = e[10] | (e[11] << 16); w1.z = e[12] | (e[13] << 16); w1.w = e[14] | (e[15] << 16);
        *(u32x4*)(vtdst + d * 64 + 16 * part) = w0; *(u32x4*)(vtdst + d * 64 + 16 * part + 8) = w1; } }
    __syncthreads();
}
__device__ __forceinline__ void xb_rows(const float* X, bf16_t* XB, float* ssq, int nrows, int gw, int NGW, int lane) {
    for (int m = gw; m < nrows; m += NGW) {
        const f32x4* xr = (const f32x4*)(X + (size_t)m * DM) + lane; f32x4 v[4]; float s = 0.f;
#pragma unroll
        for (int j = 0; j < 4; ++j) { v[j] = xr[64 * j]; s += (v[j].x * v[j].x + v[j].y * v[j].y) + (v[j].z * v[j].z + v[j].w * v[j].w); }
        s = wave_sum(s);
        u32x2* o8 = (u32x2*)(XB + (size_t)m * DM) + lane;
#pragma unroll
        for (int j = 0; j < 4; ++j) { u32x2 w; w.x = cvt_pk_bf16(v[j].x, v[j].y); w.y = cvt_pk_bf16(v[j].z, v[j].w); o8[64 * j] = w; }
        if (lane < 16) ssq[(size_t)m * 16 + lane] = lane == 0 ? s : 0.f;
    }
}
#define MFMA32(a, b, c) __builtin_amdgcn_mfma_f32_32x32x16_bf16((a), (b), (c), 0, 0, 0)
__device__ __forceinline__ bf16x8 pack8(const f32x16& x, int s) {
    u32x4 p; p.x = cvt_pk_bf16(x[8 * s], x[8 * s + 1]); p.y = cvt_pk_bf16(x[8 * s + 2], x[8 * s + 3]); p.z = cvt_pk_bf16(x[8 * s + 4], x[8 * s + 5]); p.w = cvt_pk_bf16(x[8 * s + 6], x[8 * s + 7]);
    return __builtin_bit_cast(bf16x8, p);
}
constexpr int AT_K = 0, AT_V = 34816, AT_B = 71680, AT_Q = 73984;
template <bool FOX>
__device__ __forceinline__ void attn_tile(const LAS unsigned char* Kb, const LAS unsigned char* Vb, const LAS float* bb, const LAS unsigned char* Qw, f32x16 (&o)[4], float& mrun, float& lrun,
                                          int k0, int qw0, int qlane, int r32, int hi) {
    if (FOX && k0 > qw0 + 31) return;
    f32x16 st[2];
#pragma unroll
    for (int kb = 0; kb < 2; ++kb)
#pragma unroll
        for (int r = 0; r < 16; ++r) st[kb][r] = 0.f;
#pragma unroll
    for (int hb = 0; hb < 2; ++hb) {
        bf16x8 qf[4], ka[4][2];
#pragma unroll
        for (int k4 = 0; k4 < 4; ++k4) { const int ks = 4 * hb + k4; qf[k4] = *(const LAS bf16x8*)(Qw + (r32 * 136 + 16 * ks + 8 * hi) * 2);
            ka[k4][0] = *(const LAS bf16x8*)(Kb + (r32 * 136 + 16 * ks + 8 * hi) * 2); ka[k4][1] = *(const LAS bf16x8*)(Kb + ((32 + r32) * 136 + 16 * ks + 8 * hi) * 2); }
        __builtin_amdgcn_sched_barrier(0);
#pragma unroll
        for (int k4 = 0; k4 < 4; ++k4) { st[0] = MFMA32(ka[k4][0], qf[k4], st[0]); st[1] = MFMA32(ka[k4][1], qf[k4], st[1]); }
        __builtin_amdgcn_sched_barrier(0);
    }
    if (FOX) {
#pragma unroll
        for (int kb = 0; kb < 2; ++kb)
#pragma unroll
            for (int g = 0; g < 4; ++g) { const f32x4 bv = *(const LAS f32x4*)(bb + 32 * kb + 8 * g + 4 * hi);
#pragma unroll
                for (int i = 0; i < 4; ++i) st[kb][4 * g + i] += bv[i]; }
        if (k0 + 63 > qw0) {
#pragma unroll
            for (int kb = 0; kb < 2; ++kb)
#pragma unroll
                for (int r = 0; r < 16; ++r) { const int key = k0 + 32 * kb + (r & 3) + 8 * (r >> 2) + 4 * hi; if (key > qlane) st[kb][r] = -INFINITY; }
        }
    }
    float mx = st[0][0];
#pragma unroll
    for (int r = 1; r < 16; ++r) mx = fmaxf(mx, st[0][r]);
#pragma unroll
    for (int r = 0; r < 16; ++r) mx = fmaxf(mx, st[1][r]);
    mx = pg8::xmax32(mx);
    const float mnew = fmaxf(mrun, mx), msafe = (mnew == -INFINITY) ? 0.f : mnew;
    const float alpha = (mrun == -INFINITY) ? 0.f : __builtin_amdgcn_exp2f(mrun - msafe);
    float rs = 0.f;
#pragma unroll
    for (int kb = 0; kb < 2; ++kb)
#pragma unroll
        for (int r = 0; r < 16; ++r) { const float pv = __builtin_amdgcn_exp2f(st[kb][r] - msafe); st[kb][r] = pv; rs += pv; }
    rs = pg8::xsum32(rs);
    lrun = lrun * alpha + rs; mrun = mnew;
#pragma unroll
    for (int i = 0; i < 4; ++i)
#pragma unroll
        for (int r = 0; r < 16; ++r) o[i][r] *= alpha;
    s16x4 vlo[2][4], vhi[2][4];
#define AT_VLD(buf, g) do { _Pragma("unroll") for (int db = 0; db < 4; ++db) { const LAS unsigned char* vp = Vb + ((32 * db + r32) * 72 + 16 * (g) + 4 * hi) * 2; \
        vlo[buf][db] = *(const LAS s16x4*)vp; vhi[buf][db] = *(const LAS s16x4*)(vp + 16); } } while (0)
    AT_VLD(0, 0);
#pragma unroll
    for (int g = 0; g < 4; ++g) {
        __builtin_amdgcn_sched_barrier(0);
        if (g < 3) AT_VLD((g + 1) & 1, g + 1);
        const bf16x8 pf = pack8(st[g >> 1], g & 1);
        __builtin_amdgcn_sched_barrier(0);
#pragma unroll
        for (int db = 0; db < 4; ++db) { const bf16x8 a = __builtin_shufflevector(vlo[g & 1][db], vhi[g & 1][db], 0, 1, 2, 3, 4, 5, 6, 7); o[db] = MFMA32(a, pf, o[db]); }
    }
#undef AT_VLD
}
template <bool FOX>
__device__ __forceinline__ void attn_unit(LAS unsigned char* lds, const float* qgain, const bf16_t* Q, size_t qpitch, const bf16_t* K, size_t kpitch, const bf16_t* VT, size_t vpitch, int vtile,
                                          const float* cum, float cref, float o1, float o2, float o3, int q0, int j0, int j1, bf16_t* O, size_t opitch, int tid, int lane, int wid) {
    const int r32 = lane & 31, hi = lane >> 5, qw0 = q0 + 32 * wid, qlane = qw0 + r32;
    const LAS unsigned char* Qw = lds + AT_Q + wid * (32 * 136 * 2);
    {
        bf16x8 qf[8];
#pragma unroll
        for (int ks = 0; ks < 8; ++ks) qf[ks] = *(const bf16x8*)(Q + (unsigned)((32 * wid + r32) * (int)qpitch + 16 * ks + 8 * hi));
        float ss = 0.f;
#pragma unroll
        for (int ks = 0; ks < 8; ++ks)
#pragma unroll
            for (int j = 0; j < 8; ++j) { const float x = bf2f((unsigned short)qf[ks][j]); ss += x * x; }
        ss = pg8::xsum32(ss);
        const float rq = (__builtin_amdgcn_rsqf(ss * (1.0f / 128.0f) + EPSN)) * (0.08838834764831845f * LOG2E);
#pragma unroll
        for (int ks = 0; ks < 8; ++ks) { const f32x4 ga = *(const f32x4*)(qgain + 16 * ks + 8 * hi), gb = *(const f32x4*)(qgain + 16 * ks + 8 * hi + 4);
            u32x4 w; w.x = cvt_pk_bf16(bf2f((unsigned short)qf[ks][0]) * rq * ga[0], bf2f((unsigned short)qf[ks][1]) * rq * ga[1]);
            w.y = cvt_pk_bf16(bf2f((unsigned short)qf[ks][2]) * rq * ga[2], bf2f((unsigned short)qf[ks][3]) * rq * ga[3]);
            w.z = cvt_pk_bf16(bf2f((unsigned short)qf[ks][4]) * rq * gb[0], bf2f((unsigned short)qf[ks][5]) * rq * gb[1]);
            w.w = cvt_pk_bf16(bf2f((unsigned short)qf[ks][6]) * rq * gb[2], bf2f((unsigned short)qf[ks][7]) * rq * gb[3]);
            *(LAS u32x4*)(lds + AT_Q + wid * (32 * 136 * 2) + (r32 * 136 + 16 * ks + 8 * hi) * 2) = w; }
    }
    f32x16 o[4];
#pragma unroll
    for (int i = 0; i < 4; ++i)
#pragma unroll
        for (int r = 0; r < 16; ++r) o[i][r] = 0.f;
    float mrun = -INFINITY, lrun = 0.f;
    const int kkey0 = tid >> 4, kpart = tid & 15, vd0 = tid >> 3, vpart = tid & 7;
    u32x4 kA[2], vA[2], kB[2], vB[2]; float bA = 0.f, bB = 0.f;
#define AT_LOAD(kr, vr, br, j) do { _Pragma("unroll") for (int i_ = 0; i_ < 2; ++i_) { \
        kr[i_] = *(const u32x4*)(K + (unsigned)((64 * (j) + kkey0 + 32 * i_) * (int)kpitch + kpart * 8)); \
        vr[i_] = *(const u32x4*)(VT + (unsigned)((vd0 + 64 * i_) * (int)vpitch + vtile * (j) + vpart * 8)); } \
        if (FOX) { const int sj_ = (j) >> 5; br = (cref - (cum[64 * (j) + (tid & 63)] + (sj_ == 0 ? 0.f : sj_ == 1 ? o1 : sj_ == 2 ? o2 : o3))) * LOG2E; } } while (0)
#define AT_STORE(kr, vr, br, buf) do { _Pragma("unroll") for (int i_ = 0; i_ < 2; ++i_) { \
        *(LAS u32x4*)(lds + AT_K + (buf) * 17408 + ((kkey0 + 32 * i_) * 136 + kpart * 8) * 2) = kr[i_]; \
        *(LAS u32x4*)(lds + AT_V + (buf) * 18432 + ((vd0 + 64 * i_) * 72 + vpart * 8) * 2) = vr[i_]; } \
        if (FOX && tid < 64) ((LAS float*)(lds + AT_B))[(buf) * 64 + tid] = br; } while (0)
#define AT_TILE(buf, j) attn_tile<FOX>(lds + AT_K + (buf) * 17408, lds + AT_V + (buf) * 18432, (const LAS float*)(lds + AT_B) + (buf) * 64, Qw, o, mrun, lrun, 64 * (j), qw0, qlane, r32, hi)
#define AT_BAR() asm volatile("s_waitcnt lgkmcnt(0)\n\ts_barrier" ::: "memory")
    AT_LOAD(kA, vA, bA, j0);
    AT_LOAD(kB, vB, bB, (j0 + 1 <= j1 ? j0 + 1 : j1));
    AT_STORE(kA, vA, bA, 0);
    AT_BAR();
    for (int j = j0; j <= j1; j += 2) {
        AT_LOAD(kA, vA, bA, (j + 2 <= j1 ? j + 2 : j1));
        __builtin_amdgcn_sched_barrier(0);
        AT_TILE(0, j);
        if (j + 1 <= j1) AT_STORE(kB, vB, bB, 1);
        AT_BAR();
        if (j + 1 > j1) break;
        AT_LOAD(kB, vB, bB, (j + 3 <= j1 ? j + 3 : j1));
        __builtin_amdgcn_sched_barrier(0);
        AT_TILE(1, j + 1);
        if (j + 2 <= j1) AT_STORE(kA, vA, bA, 0);
        AT_BAR();
    }
#undef AT_BAR
#undef AT_LOAD
#undef AT_STORE
#undef AT_TILE
    const float rl = __builtin_amdgcn_rcpf(lrun);
    int lr_ = lane; asm volatile("" : "+v"(lr_));
    bf16_t* orow = O + (unsigned)((32 * wid + (lr_ & 31)) * (int)opitch);
#pragma unroll
    for (int db = 0; db < 4; ++db)
#pragma unroll
        for (int g = 0; g < 4; ++g) { u32x2 w; w.x = cvt_pk_bf16(o[db][4 * g] * rl, o[db][4 * g + 1] * rl); w.y = cvt_pk_bf16(o[db][4 * g + 2] * rl, o[db][4 * g + 3] * rl);
            *(u32x2*)(orow + 32 * db + 8 * g + 4 * (lr_ >> 5)) = w; }
}
constexpr int GL_GA1 = 0, GL_SEG = 4096, GL_SS = 6144, GL_A8 = 8192, GL_KIN = 17408, GL_VT = 26624, GL_SINT = 45056, GL_UOFF = 65536;
template <bool OUTPHASE>
__device__ __forceinline__ void gla_pair(LAS unsigned char* lds0, const Params& p, int l, int unitA, int unitB, const bf16_t* PROJ, float* CS, float* DEC, const bf16_t* SIN, bf16_t* Y, int tid, int lane, int wid) {
    const int r32 = lane & 31, hi = lane >> 5, d = tid & 63, seg = wid;
    int h[2], r0[2], unit[2];
#pragma unroll
    for (int uu = 0; uu < 2; ++uu) { unit[uu] = uu ? unitB : unitA; const int bhp = unit[uu] >> 7, n = unit[uu] & 127; h[uu] = bhp & 3; r0[uu] = (bhp >> 2) * SEQ + n * 64; }
    u32x2 ggw[2][4]; f32x4 ggn[2][4]; float wa[2][16], ba[2], kv[2][8], qv[2][8];
#pragma unroll
    for (int uu = 0; uu < 2; ++uu) { LAS unsigned char* lds = lds0 + uu * GL_UOFF;
        LAS float* GA1 = (LAS float*)(lds + GL_GA1); LAS bf16_t* VTl = (LAS bf16_t*)(lds + GL_VT); LAS bf16_t* SINT = (LAS bf16_t*)(lds + GL_SINT);
        if (tid < 128) { const int row = tid >> 1, hp = tid & 1; const u32x4 w = *(const u32x4*)(PROJ + (size_t)(r0[uu] + row) * PW + C_GA1 + 8 * hp);
            LAS float* gp = GA1 + row * 16 + 8 * hp; gp[0] = bflo(w.x); gp[1] = bfhi(w.x); gp[2] = bflo(w.y); gp[3] = bfhi(w.y); gp[4] = bflo(w.z); gp[5] = bfhi(w.z); gp[6] = bflo(w.w); gp[7] = bfhi(w.w); }
        { const int dv = tid & 127, part = tid >> 7; unsigned v[16];
#pragma unroll
          for (int i = 0; i < 16; ++i) v[i] = PROJ[(size_t)(r0[uu] + 16 * part + i) * PW + C_GV + h[uu] * 128 + dv];
          u32x4 w0, w1; w0.x = v[0] | (v[1] << 16); w0.y = v[2] | (v[3] << 16); w0.z = v[4] | (v[5] << 16); w0.w = v[6] | (v[7] << 16);
          w1.x = v[8] | (v[9] << 16); w1.y = v[10] | (v[11] << 16); w1.z = v[12] | (v[13] << 16); w1.w = v[14] | (v[15] << 16);
          *(LAS u32x4*)(VTl + dv * 72 + 16 * part) = w0; *(LAS u32x4*)(VTl + dv * 72 + 16 * part + 8) = w1; }
        if (OUTPHASE) {
#pragma unroll
            for (int i = 0; i < 2; ++i) { const int c = tid + 512 * i, dv = c >> 3, part = c & 7; *(LAS u32x4*)(SINT + dv * 72 + part * 8) = *(const u32x4*)(SIN + ((size_t)unit[uu] * 128 + dv) * 64 + part * 8); }
            const int dvb_ = wid >> 1, cb_ = wid & 1;
#pragma unroll
            for (int g = 0; g < 4; ++g) { const int d4 = 32 * dvb_ + 8 * g + 4 * hi; ggw[uu][g] = *(const u32x2*)(PROJ + (size_t)(r0[uu] + 32 * cb_ + r32) * PW + C_GG + h[uu] * 128 + d4); ggn[uu][g] = *(const f32x4*)(p.in[I_GGLA] + l * 512 + h[uu] * 128 + d4); }
        }
#pragma unroll
        for (int i = 0; i < 16; ++i) wa[uu][i] = p.in[I_WA2][(size_t)(l * 16 + i) * 256 + h[uu] * 64 + d];
        ba[uu] = p.in[I_BA][l * 256 + h[uu] * 64 + d];
#pragma unroll
        for (int i = 0; i < 8; ++i) { kv[uu][i] = bf2f(PROJ[(size_t)(r0[uu] + 8 * seg + i) * PW + C_GK + h[uu] * 64 + d]); qv[uu][i] = OUTPHASE ? bf2f(PROJ[(size_t)(r0[uu] + 8 * seg + i) * PW + C_GQ + h[uu] * 64 + d]) : 0.f; }
    }
    __syncthreads();
    float cumv[2][8];
#pragma unroll
    for (int uu = 0; uu < 2; ++uu) { LAS unsigned char* lds = lds0 + uu * GL_UOFF; LAS float* GA1 = (LAS float*)(lds + GL_GA1); LAS float* SEG = (LAS float*)(lds + GL_SEG);
        float run = 0.f;
#pragma unroll
        for (int i = 0; i < 8; ++i) { const LAS float* gp = GA1 + (8 * seg + i) * 16; float z = ba[uu];
#pragma unroll
            for (int j = 0; j < 16; ++j) z += gp[j] * wa[uu][j];
            run += log_sigmoid_(z) * (1.0f / 16.0f); cumv[uu][i] = run; }
        SEG[seg * 64 + d] = run; }
    __syncthreads();
#pragma unroll
    for (int uu = 0; uu < 2; ++uu) { LAS unsigned char* lds = lds0 + uu * GL_UOFF; LAS float* SEG = (LAS float*)(lds + GL_SEG); LAS bf16_t* A8 = (LAS bf16_t*)(lds + GL_A8); LAS bf16_t* KIN = (LAS bf16_t*)(lds + GL_KIN);
        float offs = 0.f, total = 0.f;
#pragma unroll
        for (int s = 0; s < 8; ++s) { const float t = SEG[s * 64 + d]; total += t; if (s < seg) offs += t; }
        if (!OUTPHASE) {
            float ko[8];
#pragma unroll
            for (int i = 0; i < 8; ++i) ko[i] = kv[uu][i] * __expf(total - (cumv[uu][i] + offs));
            u32x4 w; w.x = cvt_pk_bf16(ko[0], ko[1]); w.y = cvt_pk_bf16(ko[2], ko[3]); w.z = cvt_pk_bf16(ko[4], ko[5]); w.w = cvt_pk_bf16(ko[6], ko[7]);
            *(LAS u32x4*)(A8 + d * 72 + 8 * seg) = w;
            if (seg == 0) DEC[(size_t)unit[uu] * 64 + d] = __expf(total);
        } else {
#pragma unroll
            for (int i = 0; i < 8; ++i) { const float c = cumv[uu][i] + offs; const int t = 8 * seg + i;
                A8[t * 72 + d] = (bf16_t)(cvt_pk_bf16(qv[uu][i] * 0.125f * __expf(c), 0.f) & 0xffffu);
                KIN[t * 72 + d] = (bf16_t)(cvt_pk_bf16(kv[uu][i] * __expf(-c), 0.f) & 0xffffu); }
        } }
    __syncthreads();
    if (!OUTPHASE) {
        const int dvb = wid >> 1, dkb = wid & 1;
#pragma unroll
        for (int uu = 0; uu < 2; ++uu) { LAS unsigned char* lds = lds0 + uu * GL_UOFF; LAS bf16_t* A8 = (LAS bf16_t*)(lds + GL_A8); LAS bf16_t* VTl = (LAS bf16_t*)(lds + GL_VT);
            f32x16 acc;
#pragma unroll
            for (int r = 0; r < 16; ++r) acc[r] = 0.f;
#pragma unroll
            for (int ks = 0; ks < 4; ++ks) { const bf16x8 a = *(const LAS bf16x8*)(VTl + (32 * dvb + r32) * 72 + 16 * ks + 8 * hi); const bf16x8 b = *(const LAS bf16x8*)(A8 + (32 * dkb + r32) * 72 + 16 * ks + 8 * hi); acc = MFMA32(a, b, acc); }
            float* cs = CS + (size_t)unit[uu] * 8192;
#pragma unroll
            for (int r = 0; r < 16; ++r) cs[(32 * dvb + (r & 3) + 8 * (r >> 2) + 4 * hi) * 64 + 32 * dkb + r32] = acc[r]; }
        __syncthreads();
    } else {
        const int dvb = wid >> 1, cb = wid & 1;
        f32x16 o[2];
#pragma unroll
        for (int uu = 0; uu < 2; ++uu) { LAS unsigned char* lds = lds0 + uu * GL_UOFF; LAS float* SS = (LAS float*)(lds + GL_SS);
            LAS bf16_t* A8 = (LAS bf16_t*)(lds + GL_A8); LAS bf16_t* KIN = (LAS bf16_t*)(lds + GL_KIN); LAS bf16_t* VTl = (LAS bf16_t*)(lds + GL_VT); LAS bf16_t* SINT = (LAS bf16_t*)(lds + GL_SINT);
            f32x16 at[2];
#pragma unroll
            for (int r = 0; r < 16; ++r) { at[0][r] = 0.f; at[1][r] = 0.f; o[uu][r] = 0.f; }
            bf16x8 qb[4];
#pragma unroll
            for (int ks = 0; ks < 4; ++ks) qb[ks] = *(const LAS bf16x8*)(A8 + (32 * cb + r32) * 72 + 16 * ks + 8 * hi);
#pragma unroll
            for (int sb = 0; sb < 2; ++sb) if (sb <= cb) {
#pragma unroll
                for (int ks = 0; ks < 4; ++ks) { const bf16x8 a = *(const LAS bf16x8*)(KIN + (32 * sb + r32) * 72 + 16 * ks + 8 * hi); at[sb] = MFMA32(a, qb[ks], at[sb]); }
                if (sb == cb) {
#pragma unroll
                    for (int r = 0; r < 16; ++r) if ((r & 3) + 8 * (r >> 2) + 4 * hi > r32) at[sb][r] = 0.f;
                }
#pragma unroll
                for (int s = 0; s < 2; ++s) { const bf16x8 pf = pack8(at[sb], s); const LAS bf16_t* vp = VTl + (32 * dvb + r32) * 72 + 32 * sb + 16 * s + 4 * hi;
                    const s16x4 lo = *(const LAS s16x4*)vp, hh = *(const LAS s16x4*)(vp + 8); const bf16x8 a = __builtin_shufflevector(lo, hh, 0, 1, 2, 3, 4, 5, 6, 7);
                    o[uu] = MFMA32(a, pf, o[uu]); }
            }
#pragma unroll
            for (int ks = 0; ks < 4; ++ks) { const bf16x8 a = *(const LAS bf16x8*)(SINT + (32 * dvb + r32) * 72 + 16 * ks + 8 * hi); o[uu] = MFMA32(a, qb[ks], o[uu]); }
            float ss = 0.f;
#pragma unroll
            for (int r = 0; r < 16; ++r) ss += o[uu][r] * o[uu][r];
            ss = pg8::xsum32(ss);
            if (hi == 0) SS[dvb * 64 + 32 * cb + r32] = ss; }
        __syncthreads();
#pragma unroll
        for (int uu = 0; uu < 2; ++uu) { if (uu == 1 && unitB == unitA) break;
            LAS unsigned char* lds = lds0 + uu * GL_UOFF; LAS float* SS = (LAS float*)(lds + GL_SS);
            const int c = 32 * cb + r32;
            const float tot = SS[c] + SS[64 + c] + SS[128 + c] + SS[192 + c];
            const float rn = __builtin_amdgcn_rsqf(tot * (1.0f / 128.0f) + EPSN);
            const size_t row = (size_t)(r0[uu] + c);
#pragma unroll
            for (int g = 0; g < 4; ++g) { const int d4 = 32 * dvb + 8 * g + 4 * hi;
                const u32x2 gw = ggw[uu][g]; const f32x4 gn = ggn[uu][g];
                const float g0 = bflo(gw.x), g1 = bfhi(gw.x), g2 = bflo(gw.y), g3 = bfhi(gw.y);
                u32x2 w; w.x = cvt_pk_bf16(o[uu][4 * g] * rn * gn[0] * g0 * sigmoidf_(g0), o[uu][4 * g + 1] * rn * gn[1] * g1 * sigmoidf_(g1));
                w.y = cvt_pk_bf16(o[uu][4 * g + 2] * rn * gn[2] * g2 * sigmoidf_(g2), o[uu][4 * g + 3] * rn * gn[3] * g3 * sigmoidf_(g3));
                *(u32x2*)(Y + row * PW + C_GV + h[uu] * 128 + d4) = w; } }
        __syncthreads();
    }
}
#define XB_TMO      128
#define XB_XCNT(j)  (256  + 64 * (j))
#define XB_XSUB(j)  (1280 + 64 * (j))
#define XB_XGEN(j)  (2304 + 64 * (j))
#define XB_TOP      3328
#define XB_TOPGEN   3392
#define XCD_BAR_WORDS 3456
#define XB_SPIN_CAP (1u << 18)

__device__ __forceinline__ unsigned xb_ld(unsigned* p)              { return __hip_atomic_load(p, __ATOMIC_RELAXED, __HIP_MEMORY_SCOPE_AGENT); }
__device__ __forceinline__ unsigned xb_add(unsigned* p, unsigned v) { return __hip_atomic_fetch_add(p, v, __ATOMIC_RELAXED, __HIP_MEMORY_SCOPE_AGENT); }
__device__ __forceinline__ unsigned xb_xcc_id() { return (unsigned)__builtin_amdgcn_s_getreg((3 << 11) | 20) & 0xFu; }
#define XB_SPIN(cond, bar) do { unsigned _sp = 0; while (cond) { __builtin_amdgcn_s_sleep(1); \
    if ((++_sp & 255u) == 0u) { if (xb_ld(&(bar)[XB_TMO])) break; if (_sp > XB_SPIN_CAP) { atomicAdd(&(bar)[XB_TMO], 1u); break; } } } } while (0)

struct XcdBarrier {
    unsigned* bar; unsigned x;
    volatile LAS unsigned* st;
};

__device__ __forceinline__ XcdBarrier xcd_barrier_post(unsigned* bar, volatile LAS unsigned* st) {
    XcdBarrier b; b.bar = bar; b.x = xb_xcc_id(); b.st = st;
    if (threadIdx.x == 0) (void)xb_add(&bar[XB_XCNT(b.x)], 1u);
    return b;
}
__device__ __forceinline__ void xcd_barrier_complete(unsigned* bar, unsigned x, unsigned& nloc, unsigned& nx) {
    const unsigned G = gridDim.x * gridDim.y * gridDim.z;
    unsigned sum, cnt, mine, sp = 0u;
    for (;;) {
        sum = 0u; cnt = 0u; mine = 0u;
#pragma unroll
        for (unsigned j = 0; j < 16; ++j) { const unsigned c = xb_ld(&bar[XB_XCNT(j)]); sum += c; cnt += (c > 0u) ? 1u : 0u; mine = (j == x) ? c : mine; }
        if (sum == G) break;
        __builtin_amdgcn_s_sleep(1);
        if ((++sp & 255u) == 0u) { if (xb_ld(&bar[XB_TMO])) break; if (sp > XB_SPIN_CAP) { atomicAdd(&bar[XB_TMO], 1u); break; } }
    }
    nloc = mine > 0u ? mine : 1u; nx = cnt > 0u ? cnt : 1u;
}

__device__ __forceinline__ void xcd_barrier(const XcdBarrier& b) {
    asm volatile("s_waitcnt vmcnt(0)" ::: "memory");
    __syncthreads();
    if (threadIdx.x == 0) {
        unsigned* bar = b.bar;
        __builtin_amdgcn_s_waitcnt(0);
        unsigned nloc = b.st[0], nx = b.st[1];
        if (nloc == 0u) { xcd_barrier_complete(bar, b.x, nloc, nx); b.st[0] = nloc; b.st[1] = nx; }
        const unsigned old = xb_add(&bar[XB_XSUB(b.x)], 1u);
        const unsigned gen = old / nloc;
        if (old + 1u == (gen + 1u) * nloc) {
            __builtin_amdgcn_fence(__ATOMIC_RELEASE, "agent");
            asm volatile("s_waitcnt vmcnt(0)" ::: "memory");
            const unsigned og = xb_add(&bar[XB_TOP], 1u);
            const unsigned tg = og / nx;
            if (og + 1u == (tg + 1u) * nx) xb_add(&bar[XB_TOPGEN], 1u);
            else XB_SPIN(xb_ld(&bar[XB_TOPGEN]) == tg, bar);
            __builtin_amdgcn_fence(__ATOMIC_ACQUIRE, "agent");
            xb_add(&bar[XB_XGEN(b.x)], 1u);
            asm volatile("s_waitcnt vmcnt(0)" ::: "memory");
        } else {
            XB_SPIN(xb_ld(&bar[XB_XGEN(b.x)]) == gen, bar);
            __builtin_amdgcn_fence(__ATOMIC_ACQUIRE, "agent");
            asm volatile("s_waitcnt vmcnt(0)" ::: "memory");
        }
    }
    __syncthreads();
}
constexpr int LDS_BYTES = 147456;
#define GEMM_PHASE(EPI, g, E) do { pg8::StaticOrder S_; S_.init((g).M, (g).N, G, (int)blockIdx.x); pg8::gemm_phase<EPI, pg8::StaticOrder, true, true>(lds, (g), S_, (E)); } while (0)
__global__ void __launch_bounds__(512, 2) mega_fwd(Params p) {
    extern __shared__ __attribute__((aligned(16))) unsigned char lds_raw[];
    LAS unsigned char* lds = (LAS unsigned char*)lds_raw;
    cg::grid_group grid = cg::this_grid();
    const int G = gridDim.x, bx = blockIdx.x, NGW = G * 8;
#define PH_BEGIN int tid = threadIdx.x; asm volatile("" : "+v"(tid)); const int lane = tid & 63, wid = __builtin_amdgcn_readfirstlane(tid >> 6), gw = bx * 8 + wid; size_t wso_ = 0; asm volatile("" : "+s"(wso_)); unsigned char* ws = p.ws + wso_; (void)lane; (void)gw; (void)ws;
#define WIN ((bf16_t*)(ws + WS_WIN))
#define WMEM ((bf16_t*)(ws + WS_WMEM))
#define WBR ((bf16_t*)(ws + WS_WBR))
#define WOUT ((bf16_t*)(ws + WS_WOUT))
#define WGU ((bf16_t*)(ws + WS_WGU))
#define WDN ((bf16_t*)(ws + WS_WDN))
#define MEMN ((bf16_t*)(ws + WS_MEMN))
#define MKV ((bf16_t*)(ws + WS_MKV))
#define MKN ((bf16_t*)(ws + WS_MKN))
#define MVT ((bf16_t*)(ws + WS_MVT))
#define CUMF ((float*)(ws + WS_CUMF))
#define DEC ((float*)(ws + WS_DEC))
#define VTF ((bf16_t*)(ws + WS_VTF))
#define SIN ((bf16_t*)(ws + WS_SIN))
#define CS ((float*)(ws + WS_CS))
#define MRG ((bf16_t*)((unsigned char*)p.out + (size_t)32 * 1048576))
#define XBF ((bf16_t*)(ws + WS_XBF))
#define KC ((bf16_t*)p.out)
#define SSQ ((float*)(ws + WS_SSQ))
#define PROJ ((bf16_t*)(ws + WS_PROJ))
#define HB ((bf16_t*)(ws + WS_PROJ))

    volatile LAS unsigned* MISC = (volatile LAS unsigned*)(lds + LDS_BYTES - 64);
    if (threadIdx.x < 16) MISC[threadIdx.x] = 0u;
    __syncthreads();
    const XcdBarrier bar = xcd_barrier_post((unsigned*)(p.ws + WS_BAR), MISC);
#define GSYNC() xcd_barrier(bar)
    { PH_BEGIN
        LAS float* scr = (LAS float*)(lds + wid * 16384);
        constexpr int PER_L = 3456 + 512 + 768 + 512 + 2816 + 1408;
        for (int it = gw; it < NL * PER_L; it += NGW) {
            const int l = it / PER_L; int r = it % PER_L; const int ln = lane & 31;
            if (r < 3456) { const int kb = r / 216, nb = r % 216; transpose_item(p.in[I_WIN] + (size_t)l * 1024 * INW, 1024, INW, p.in[I_GMIX] + l * 1024, WIN + (size_t)l * PW * 1024, scr, kb, nb, lane, inmap(nb * 32 + ln)); continue; } r -= 3456;
            if (r < 512) { const int kb = r / 32, nb = r % 32; transpose_item(p.in[I_WMKV] + (size_t)l * 1024 * 1024, 1024, 1024, p.in[I_GMEM] + l * 1024, WMEM + (size_t)l * 1024 * 1024, scr, kb, nb, lane, nb * 32 + ln); continue; } r -= 512;
            if (r < 768) { const int i = r / 256, r2 = r % 256, kb = r2 / 32, nb = r2 % 32; transpose_item(p.in[I_WBR] + (size_t)(l * 3 + i) * 512 * 1024, 512, 1024, nullptr, WBR + (size_t)(l * 3 + i) * 1024 * 512, scr, kb, nb, lane, nb * 32 + ln); continue; } r -= 768;
            if (r < 512) { const int kb = r / 32, nb = r % 32; transpose_item(p.in[I_WOUT] + (size_t)l * 1024 * 1024, 1024, 1024, nullptr, WOUT + (size_t)l * 1024 * 1024, scr, kb, nb, lane, nb * 32 + ln); continue; } r -= 512;
            if (r < 2816) { const int kb = r / 176, nb = r % 176, n0 = nb * 32, t = n0 >> 8, rr = n0 & 255; const bool isup = rr >= 128;
                transpose_item((isup ? p.in[I_WFU] : p.in[I_WFG]) + (size_t)l * 1024 * DFF, 1024, DFF, p.in[I_GFFN] + l * 1024, WGU + (size_t)l * 5632 * 1024, scr, kb, nb, lane, 128 * t + (rr & 127) + ln); continue; } r -= 2816;
            { const int kb = r / 32, nb = r % 32; transpose_item(p.in[I_WFD] + (size_t)l * DFF * 1024, DFF, 1024, nullptr, WDN + (size_t)l * 1024 * DFF, scr, kb, nb, lane, nb * 32 + ln); }
        }
        norm_rows(p.in[I_MEM], MEMN, 1024, gw, NGW, lane);
        if (bx == 0 && tid < NL) {
            float am = 0.f, cm = 0.f;
            for (int i = 0; i < 128; ++i) { am = fmaxf(am, fabsf(p.in[I_GFQ][tid * 128 + i])); cm = fmaxf(cm, fabsf(p.in[I_GFK][tid * 128 + i])); }
            ((float*)(ws + WS_TSK))[tid] = 104.0f + 2.0f * 11.3137085f * am * cm * 1.01f + 1.0f;
        }
    }
    grid.sync();
    { PH_BEGIN pg8::Gemm g{MEMN, WMEM, 1024, 4096, 1024, 1024}; pg8::EpiStore E{MKV, 4096, nullptr}; GEMM_PHASE(pg8::EpiStore, g, E);
      if (G > 64) { if (bx >= 64) xb_rows(p.in[I_X], XBF, SSQ, 2 * MH, (bx - 64) * 8 + wid, (G - 64) * 8, lane); }
      else xb_rows(p.in[I_X], XBF, SSQ, 2 * MH, gw, NGW, lane); }
    GSYNC();
    { PH_BEGIN for (int u = bx; u < 256; u += G) { const int l = u >> 6, b = (u >> 4) & 3, h = (u >> 2) & 3, t = u & 3;
        const bf16_t* src = MKV + (size_t)(b * 256 + t * 64) * 4096 + l * 1024 + h * 128;
        norm128_rows64(src, 4096, MKN + ((size_t)(l * 4 + b) * 256 + t * 64) * 512 + h * 128, 512, p.in[I_GMK] + l * 128, 1.0f, tid);
        vt_tile(src + 512, 4096, MVT + ((size_t)((l * 4 + b) * 4 + h) * 128) * 256 + t * 64, 256, (LAS bf16_t*)lds, tid); } }
    for (int l = 0; l < NL; ++l) {
        for (int hf = 0; hf < 2; ++hf) {
            { PH_BEGIN pg8::Gemm g{XBF + (size_t)hf * MH * 1024, WIN + (size_t)l * PW * 1024, MH, PW, 1024, 1024}; pg8::EpiStore E{PROJ, PW, SSQ + (size_t)hf * MH * 16}; GEMM_PHASE(pg8::EpiStore, g, E); }
            GSYNC();
            { PH_BEGIN const int tid0_ = tid;
              for (int u = bx; u < 32; u += G) { int tid = tid0_; asm volatile("" : "+v"(tid)); const int lane = tid & 63;
                    const int bhp = u >> 2, sg = u & 3, bp = bhp >> 2, h = bhp & 3; const float fb = p.in[I_BFOX][l * 4 + h];
                    float loc[4]; float run = 0.f;
#pragma unroll
                    for (int i = 0; i < 4; ++i) { const float x = bf2f(PROJ[(size_t)(bp * SEQ + sg * 2048 + 4 * tid + i) * PW + C_FF + h]) + fb; run += log_sigmoid_(x); loc[i] = run; }
                    float sc = run;
#pragma unroll
                    for (int o = 1; o < 64; o <<= 1) { const float t = __shfl_up(sc, o); if (lane >= o) sc += t; }
                    LAS float* wt = (LAS float*)lds;
                    if (lane == 63) wt[wid] = sc;
                    __syncthreads();
                    float offs = sc - run;
                    for (int w = 0; w < wid; ++w) offs += wt[w];
                    *(f32x4*)(CUMF + (size_t)bhp * SEQ + sg * 2048 + 4 * tid) = (f32x4){loc[0] + offs, loc[1] + offs, loc[2] + offs, loc[3] + offs};
                    if (tid == 511) ((float*)(ws + WS_TSK))[16 + u] = loc[3] + offs;
                    __syncthreads();
              }
              for (int v0 = bx; v0 < 1024; v0 += 4 * G) { int tid = tid0_; asm volatile("" : "+v"(tid)); prep_batch(PROJ, p.in[I_GFK] + l * 128, KC, VTF, (LAS bf16_t*)lds, v0, G, tid); }
              for (int u = bx; u < 1024; u += 2 * G) { int tid = tid0_; asm volatile("" : "+v"(tid)); const int lane = tid & 63; gla_pair<false>(lds, p, l, u, (u + G < 1024 ? u + G : u), PROJ, CS, DEC, SIN, PROJ, tid, lane, wid); }
              for (int v = bx; v < 256; v += G) { int tid = tid0_; asm volatile("" : "+v"(tid)); const int lane = tid & 63;
                    const int rb = v >> 2, h = v & 3, r0 = rb * 256, bp = r0 / SEQ, b = hf * 2 + bp;
                    attn_unit<false>(lds, p.in[I_GMQ] + l * 128, PROJ + (size_t)r0 * PW + C_MQ + h * 128, PW, MKN + ((size_t)(l * 4 + b) * 256) * 512 + h * 128, 512,
                                     MVT + ((size_t)((l * 4 + b) * 4 + h) * 128) * 256, 256, 64, nullptr, 0.f, 0.f, 0.f, 0.f, 0, 0, 3, PROJ + (size_t)r0 * PW + C_MQ + h * 128, PW, tid, lane, wid);
              }
            }
            GSYNC();
            { PH_BEGIN
                for (int u = bx; u < 512; u += G) {
                    typedef float f32x2v __attribute__((ext_vector_type(2)));
                    const int e2 = u * 64 + lane, bhp = e2 >> 12, dvdk = (e2 & 4095) * 2, dk = dvdk & 63, seg = wid;
                    f32x2v c[16], d[16];
#pragma unroll
                    for (int i = 0; i < 16; ++i) { const size_t unit = (size_t)bhp * 128 + seg * 16 + i; c[i] = *(const f32x2v*)(CS + unit * 8192 + dvdk); d[i] = *(const f32x2v*)(DEC + unit * 64 + dk); }
                    f32x2v sl[16], pl[16]; f32x2v sacc = (f32x2v){0.f, 0.f}, pacc = (f32x2v){1.f, 1.f};
#pragma unroll
                    for (int i = 0; i < 16; ++i) { sl[i] = sacc; pl[i] = pacc; sacc = d[i] * sacc + c[i]; pacc = pacc * d[i]; }
                    LAS f32x4* AB = (LAS f32x4*)lds;
                    AB[seg * 64 + lane] = (f32x4){pacc.x, pacc.y, sacc.x, sacc.y};
                    __syncthreads();
                    f32x2v s0 = (f32x2v){0.f, 0.f};
                    for (int j = 0; j < seg; ++j) { const f32x4 ab = AB[j * 64 + lane]; s0 = (f32x2v){ab[0] * s0.x + ab[2], ab[1] * s0.y + ab[3]}; }
#pragma unroll
                    for (int i = 0; i < 16; ++i) { const size_t unit = (size_t)bhp * 128 + seg * 16 + i; const f32x2v v = sl[i] + pl[i] * s0;
                        *(unsigned*)(SIN + unit * 8192 + dvdk) = cvt_pk_bf16(v.x, v.y); }
                    __syncthreads();
                }
                const int nf = G, fidx = bx;
                const int tid0_ = tid; if (fidx >= 0) for (int u = fidx; u < 256; u += nf) { int tid = tid0_; asm volatile("" : "+v"(tid)); const int lane = tid & 63;
                    const int qb = 31 - (u >> 3), bhp = u & 7, bp = bhp >> 2, h = bhp & 3, q0 = qb * 256; const size_t r0 = (size_t)bp * SEQ + q0;
                    const float* cum = CUMF + (size_t)bhp * SEQ; const float* sgt = (const float*)(ws + WS_TSK) + 16 + bhp * 4;
                    const float o1 = sgt[0], o2 = o1 + sgt[1], o3 = o2 + sgt[2];
                    const int sq_ = q0 >> 11; const float cref = cum[q0] + (sq_ == 0 ? 0.f : sq_ == 1 ? o1 : sq_ == 2 ? o2 : o3);
                    int j0 = 0;
#if FOX_SKIP
                    {
                        const float T = ((const float*)(ws + WS_TSK))[l];
                        const int nt = q0 >> 6;
                        int cnt = 0;
                        if (tid < nt) { const int sk_ = tid >> 5; cnt = (cref - (cum[64 * tid + 63] + (sk_ == 0 ? 0.f : sk_ == 1 ? o1 : sk_ == 2 ? o2 : o3)) < -T) ? 1 : 0; }
                        const unsigned long long bal = __ballot(cnt);
                        LAS int* red = (LAS int*)(lds + 73728);
                        if (lane == 0 && wid < 2) red[wid] = __popcll(bal);
                        __syncthreads();
                        j0 = red[0] + red[1];
                    }
#endif
                    attn_unit<true>(lds, p.in[I_GFQ] + l * 128, PROJ + r0 * PW + C_FQ + h * 128, PW, KC + (size_t)bhp * SEQ * 128, 128, VTF + ((size_t)bhp * 128) * SEQ, 64, 8192,
                                    cum, cref, o1, o2, o3, q0, j0, (q0 >> 6) + 3, PROJ + r0 * PW + C_FQ + h * 128, PW, tid, lane, wid);
                }
            }
            GSYNC();
            { PH_BEGIN const int tid0_ = tid; for (int u = bx; u < 1024; u += 2 * G) { int tid = tid0_; asm volatile("" : "+v"(tid)); const int lane = tid & 63; gla_pair<true>(lds, p, l, u, (u + G < 1024 ? u + G : u), PROJ, CS, DEC, SIN, PROJ, tid, lane, wid); } }
            GSYNC();
            { PH_BEGIN
                pg8::Gemm g{PROJ, WBR + (size_t)l * 3 * 1024 * 512, MH, 3072, 512, PW};
                pg8::EpiGate E{PROJ + C_BG, PW, p.in[I_BGATE] + l * 3072, MRG + (size_t)hf * MH * 1024, 1024};
                pg8::BranchOrder S_; S_.init(MH, G, (int)blockIdx.x); static_assert(C_GV * 2 == 1024 && C_FQ * 2 == 3072 && C_MQ * 2 == 6144, "BranchOrder offsets"); pg8::gemm_phase<pg8::EpiGate, pg8::BranchOrder, true, true>(lds, g, S_, E);
            }
            GSYNC();
        }
        { PH_BEGIN pg8::Gemm g{MRG, WOUT + (size_t)l * 1024 * 1024, 2 * MH, 1024, 1024, 1024}; pg8::EpiResid E{nullptr, XBF, SSQ}; GEMM_PHASE(pg8::EpiResid, g, E); }
        GSYNC();
        { PH_BEGIN pg8::Gemm g{XBF, WGU + (size_t)l * 5632 * 1024, 2 * MH, 5632, 1024, 1024}; pg8::EpiSwiglu E{HB, DFF, SSQ}; GEMM_PHASE(pg8::EpiSwiglu, g, E); }
        GSYNC();
        { PH_BEGIN pg8::Gemm g{HB, WDN + (size_t)l * 1024 * DFF, 2 * MH, 1024, DFF, DFF}; pg8::EpiResid E{l == NL - 1 ? p.out : nullptr, XBF, SSQ}; GEMM_PHASE(pg8::EpiResid, g, E); }
        GSYNC();
    }
}

extern "C" void kernel_launch(void* const* d_in, const int* in_sizes, int n_in, void* d_out, int out_size, void* d_ws, size_t ws_size, hipStream_t stream) {
    static int grid = 0;
    if (grid == 0) {
        int dev = 0, cus = 0, per_cu = 0;
        hipGetDevice(&dev); hipDeviceGetAttribute(&cus, hipDeviceAttributeMultiprocessorCount, dev);
        hipFuncSetAttribute((const void*)mega_fwd, hipFuncAttributeMaxDynamicSharedMemorySize, LDS_BYTES);
        hipOccupancyMaxActiveBlocksPerMultiprocessor(&per_cu, (const void*)mega_fwd, 512, LDS_BYTES);
        if (per_cu < 1) { fprintf(stderr, "kernel_launch: occupancy query says %d blocks/CU\n", per_cu); per_cu = 1; }
        grid = cus * 1;
        if (ws_size < WS_END) { fprintf(stderr, "kernel_launch: workspace too small: %zu < %zu\n", ws_size, (size_t)WS_END); grid = -1; }
        (void)hipGetLastError();
    }
    if (grid < 0) return;
    Params p{};
    for (int i = 0; i < 21; ++i) p.in[i] = (const float*)d_in[i];
    p.out = (float*)d_out; p.ws = (unsigned char*)d_ws;
    hipMemsetAsync((unsigned char*)d_ws + WS_BAR, 0, 16384, stream);
    void* args[] = {&p};
    hipError_t e = hipLaunchCooperativeKernel((const void*)mega_fwd, dim3(grid), dim3(512), args, LDS_BYTES, stream);
    if (e != hipSuccess) fprintf(stderr, "cooperative launch failed: %s (grid %d)\n", hipGetErrorString(e), grid);
}
```

```cpp
#include <hip/hip_runtime.h>
#include <hip/hip_cooperative_groups.h>
#include <cstdio>
#include <cstdint>
#include <cmath>
namespace cg = cooperative_groups;
namespace pg8 {
#define PG8_LAS __attribute__((address_space(3)))
typedef unsigned short bf16_t;
typedef short bf16x8 __attribute__((ext_vector_type(8)));
typedef float f32x4 __attribute__((ext_vector_type(4)));
typedef unsigned u32x4 __attribute__((ext_vector_type(4)));
constexpr int BM = 256, BK = 64, HALF = 128, HTB = HALF * BK * 2  , STAGE_BYTES = 8 * HTB, NXCD = 8, WGM = 8;

__host__ __device__ __forceinline__ int lds_byte(int r, int c) { const int st = (r >> 4) * 2 + (c >> 5), rr = r & 15, cc = c & 31, ob = rr * 64 + cc * 2; return st * 1024 + (ob ^ (((ob >> 9) & 1) << 5)); }
__host__ __device__ __forceinline__ void stage_rc(int b, int& R, int& C) { const int st = b / 1024, sb = b % 1024, swz = sb ^ (((sb >> 9) & 1) << 5); R = (st >> 1) * 16 + swz / 64; C = (st & 1) * 32 + (swz % 64) / 2; }
__host__ __device__ __forceinline__ int perm32(int rho) { const int n = rho >> 4, i = rho & 15; return 8 * (i >> 2) + 4 * n + (i & 3); }

struct Unit { int pm, pn, aoff; };
struct Gemm { const bf16_t* A; const bf16_t* Bt; int M, N, K, lda; };

struct StaticOrder {
    int nM, nN, nwg, G, c;
    __host__ __device__ void init(int M, int N, int G_, int c_) { nM = M / BM; nN = N / BM; nwg = nM * nN; G = G_; c = c_; }
    __host__ __device__ bool next(int i, Unit& u) const {
        const long L = (long)i * G + c; if (L >= nwg) return false;
        int wgid = (int)L; { const int q = nwg / NXCD, r = nwg % NXCD, xcd = wgid % NXCD, off = wgid / NXCD; wgid = (xcd < r ? xcd * (q + 1) : r * (q + 1) + (xcd - r) * q) + off; }
        const int nig = WGM * nN, gid = wgid / nig, fm = gid * WGM, gsz = (nM - fm) < WGM ? (nM - fm) : WGM;
        u.pm = fm + ((wgid % nig) % gsz); u.pn = (wgid % nig) / gsz; u.aoff = 0; return true;
    }
    __device__ __forceinline__ void a_ready(const Unit&) const {}
    __device__ __forceinline__ void done(const Unit&) const {}
};
struct BranchOrder {
    StaticOrder S0;
    __host__ __device__ void init(int M, int G_, int c_) { S0.init(M, 1024, G_, c_); }
    __host__ __device__ bool next(int i, Unit& u) const { const int r = i / 3, b = i - 3 * r; if (!S0.next(r, u)) return false; u.pn += 4 * b; u.aoff = 1024 * (1 + 2 * b + (b >> 1)); return true; }
    __device__ __forceinline__ void a_ready(const Unit&) const {}
    __device__ __forceinline__ void done(const Unit&) const {}
};

typedef float cvt_f32x2_t __attribute__((ext_vector_type(2))); typedef __bf16 cvt_bf16x2_t __attribute__((ext_vector_type(2)));
__device__ __forceinline__ unsigned cvt_pk_bf16(float lo, float hi) { const cvt_f32x2_t v = {lo, hi}; const cvt_bf16x2_t b = __builtin_convertvector(v, cvt_bf16x2_t); return __builtin_bit_cast(unsigned, b); }
typedef float f32x2 __attribute__((ext_vector_type(2)));
typedef float f32x2 __attribute__((ext_vector_type(2)));
__device__ __forceinline__ float bf2f(unsigned short b) { return __uint_as_float((unsigned)b << 16); }
__device__ __forceinline__ float bflo(unsigned w) { return __uint_as_float(w << 16); }
__device__ __forceinline__ float bfhi(unsigned w) { return __uint_as_float(w & 0xffff0000u); }
__device__ __forceinline__ float xsum32(float s) { const auto r = __builtin_amdgcn_permlane32_swap(__float_as_uint(s), __float_as_uint(s), false, false); return __uint_as_float(r[0]) + __uint_as_float(r[1]); }
__device__ __forceinline__ float xmax32(float s) { const auto r = __builtin_amdgcn_permlane32_swap(__float_as_uint(s), __float_as_uint(s), false, false); return fmaxf(__uint_as_float(r[0]), __uint_as_float(r[1])); }
__device__ __forceinline__ float xsum16(float s) { const auto r = __builtin_amdgcn_permlane16_swap(__float_as_uint(s), __float_as_uint(s), false, false); return __uint_as_float(r[0]) + __uint_as_float(r[1]); }
__device__ __forceinline__ float sigmoidf_(float x) { return __builtin_amdgcn_rcpf(1.0f + __builtin_amdgcn_exp2f(-1.4426950408889634f * x)); }
__device__ __forceinline__ float row_rs(const float* ssq, size_t row, int fq) {
    const f32x4 q = *(const f32x4*)(ssq + row * 16 + 4 * fq); float s = (q[0] + q[1]) + (q[2] + q[3]);
    s = xsum16(s); s = xsum32(s);
    return __builtin_amdgcn_rsqf(s * (1.0f / 1024.0f) + 1e-6f);
}
struct EpiStore {
    static constexpr bool PERM = true, AFTER_DRAIN = false;
    bf16_t* O; int ldc; const float* ssq;
    __device__ __forceinline__ void operator()(const f32x4 (&acc)[2][2][4][2], const Unit& u, int wr, int wc, int fr, int fq) const {
        const int row0 = u.pm * BM + wr * 64 + fr, col0 = u.pn * BM + wc * 32 + 8 * fq;
#pragma unroll
        for (int ai = 0; ai < 2; ++ai)
#pragma unroll
            for (int m = 0; m < 4; ++m) { const size_t row = (size_t)(row0 + ai * HALF + m * 16); bf16_t* rowp = O + row * ldc + col0;
                const float rs = ssq ? row_rs(ssq, row, fq) : 1.0f;
#pragma unroll
                for (int bj = 0; bj < 2; ++bj) { const f32x4 v0 = acc[ai][bj][m][0] * rs, v1 = acc[ai][bj][m][1] * rs;
                    u32x4 w; w.x = cvt_pk_bf16(v0[0], v0[1]); w.y = cvt_pk_bf16(v0[2], v0[3]); w.z = cvt_pk_bf16(v1[0], v1[1]); w.w = cvt_pk_bf16(v1[2], v1[3]);
                    *(u32x4*)(rowp + bj * HALF) = w; } }
    }
};
struct EpiGate {
    static constexpr bool PERM = true, AFTER_DRAIN = false;
    const bf16_t* G; int ldg; const float* bias; bf16_t* O; int ldc;
    __device__ __forceinline__ void operator()(const f32x4 (&acc)[2][2][4][2], const Unit& u, int wr, int wc, int fr, int fq) const {
        const int row0 = u.pm * BM + wr * 64 + fr, gcol0 = u.pn * BM + wc * 32 + 8 * fq, col0 = (u.pn & 3) * BM + wc * 32 + 8 * fq; const bool first = u.pn < 4;
#pragma unroll
        for (int bj = 0; bj < 2; ++bj) {
            const f32x4 b0 = *(const f32x4*)(bias + gcol0 + bj * HALF), b1 = *(const f32x4*)(bias + gcol0 + bj * HALF + 4);
#pragma unroll
            for (int ai = 0; ai < 2; ++ai)
#pragma unroll
                for (int m = 0; m < 4; ++m) { const size_t r = (size_t)(row0 + ai * HALF + m * 16);
                    const u32x4 gw = *(const u32x4*)(G + r * ldg + gcol0 + bj * HALF);
                    bf16_t* op = O + r * ldc + col0 + bj * HALF;
                    u32x4 pw = (u32x4){0u, 0u, 0u, 0u}; if (!first) pw = *(const u32x4*)op;
                    const f32x4 v0 = acc[ai][bj][m][0], v1 = acc[ai][bj][m][1];
                    float r0 = bflo(pw.x) + sigmoidf_(bflo(gw.x) + b0[0]) * v0[0], r1 = bfhi(pw.x) + sigmoidf_(bfhi(gw.x) + b0[1]) * v0[1];
                    float r2 = bflo(pw.y) + sigmoidf_(bflo(gw.y) + b0[2]) * v0[2], r3 = bfhi(pw.y) + sigmoidf_(bfhi(gw.y) + b0[3]) * v0[3];
                    float r4 = bflo(pw.z) + sigmoidf_(bflo(gw.z) + b1[0]) * v1[0], r5 = bfhi(pw.z) + sigmoidf_(bfhi(gw.z) + b1[1]) * v1[1];
                    float r6 = bflo(pw.w) + sigmoidf_(bflo(gw.w) + b1[2]) * v1[2], r7 = bfhi(pw.w) + sigmoidf_(bfhi(gw.w) + b1[3]) * v1[3];
                    u32x4 w; w.x = cvt_pk_bf16(r0, r1); w.y = cvt_pk_bf16(r2, r3); w.z = cvt_pk_bf16(r4, r5); w.w = cvt_pk_bf16(r6, r7);
                    *(u32x4*)op = w; }
        }
    }
};
struct EpiResid {
    static constexpr bool PERM = true, AFTER_DRAIN = false;
    float* out; bf16_t* xb; float* ssq;
    __device__ __forceinline__ void operator()(const f32x4 (&acc)[2][2][4][2], const Unit& u, int wr, int wc, int fr, int fq) const {
        const int row0 = u.pm * BM + wr * 64 + fr, col0 = u.pn * BM + wc * 32 + 8 * fq;
#pragma unroll
        for (int ai = 0; ai < 2; ++ai)
#pragma unroll
            for (int m = 0; m < 4; ++m) { const size_t row = (size_t)(row0 + ai * HALF + m * 16), off = row * 1024 + col0; float ss = 0.f;
#pragma unroll
                for (int bj = 0; bj < 2; ++bj) {
                    const u32x4 rw = *(const u32x4*)(xb + off + bj * HALF);
                    const f32x4 a = (f32x4){bflo(rw.x), bfhi(rw.x), bflo(rw.y), bfhi(rw.y)} + acc[ai][bj][m][0], b = (f32x4){bflo(rw.z), bfhi(rw.z), bflo(rw.w), bfhi(rw.w)} + acc[ai][bj][m][1];
                    if (out) { *(f32x4*)(out + off + bj * HALF) = a; *(f32x4*)(out + off + bj * HALF + 4) = b; }
                    ss += (a[0] * a[0] + a[1] * a[1]) + (a[2] * a[2] + a[3] * a[3]) + (b[0] * b[0] + b[1] * b[1]) + (b[2] * b[2] + b[3] * b[3]);
                    u32x4 w; w.x = cvt_pk_bf16(a[0], a[1]); w.y = cvt_pk_bf16(a[2], a[3]); w.z = cvt_pk_bf16(b[0], b[1]); w.w = cvt_pk_bf16(b[2], b[3]);
                    *(u32x4*)(xb + off + bj * HALF) = w; }
                ss = xsum16(ss); ss = xsum32(ss);
                if (fq == 0) ssq[row * 16 + u.pn * 4 + wc] = ss; }
    }
};
struct EpiSwiglu {
    static constexpr bool PERM = true, AFTER_DRAIN = false;
    bf16_t* O; int ldc; const float* ssq;
    __device__ __forceinline__ void operator()(const f32x4 (&acc)[2][2][4][2], const Unit& u, int wr, int wc, int fr, int fq) const {
        const int row0 = u.pm * BM + wr * 64 + fr, col0 = u.pn * HALF + wc * 32 + 8 * fq;
#pragma unroll
        for (int ai = 0; ai < 2; ++ai)
#pragma unroll
            for (int m = 0; m < 4; ++m) { float h[8]; const float rs = row_rs(ssq, (size_t)(row0 + ai * HALF + m * 16), fq);
#pragma unroll
                for (int n = 0; n < 2; ++n)
#pragma unroll
                    for (int j = 0; j < 4; ++j) { const float gt = acc[ai][0][m][n][j] * rs, up = acc[ai][1][m][n][j] * rs; h[4 * n + j] = gt * sigmoidf_(gt) * up; }
                u32x4 w; w.x = cvt_pk_bf16(h[0], h[1]); w.y = cvt_pk_bf16(h[2], h[3]); w.z = cvt_pk_bf16(h[4], h[5]); w.w = cvt_pk_bf16(h[6], h[7]);
                *(u32x4*)(O + (size_t)(row0 + ai * HALF + m * 16) * ldc + col0) = w; }
    }
};
template <class Epi, class Sched, bool ALIGN_EPI = false, bool SP2 = false>
__device__ __forceinline__ void gemm_phase(PG8_LAS unsigned char* lds, const Gemm g, const Sched& S, const Epi& E) {
    int tid_ = threadIdx.x; asm volatile("" : "+v"(tid_)); const int tid = tid_, wid = __builtin_amdgcn_readfirstlane(tid >> 6), lane = tid & 63, wr = wid >> 2, wc = wid & 3, fr = lane & 15, fq = lane >> 4;
    const int K = g.K, nt = K / BK;
    unsigned voffA[2], voffB[2];
#pragma unroll
    for (int i = 0; i < 2; ++i) { int R, C; stage_rc(tid * 16 + i * 8192, R, C); const int Rb = Epi::PERM ? ((R & ~31) + perm32(R & 31)) : R;
        voffA[i] = (unsigned)(R * g.lda + C) * 2u; voffB[i] = (unsigned)(Rb * K + C) * 2u; }
    const size_t kstep = (size_t)(BK * 2);
    const size_t hstepA = (size_t)HALF * g.lda * 2, hstepB = (size_t)HALF * K * 2;
    const size_t tstepA = 2 * hstepA, tstepB = 2 * hstepB;
    const unsigned ldsw = (unsigned)wid * 1024u;
    const int aoff = lds_byte(wr * 64 + fr, fq * 8), boff = lds_byte(wc * 32 + fr, fq * 8);
#define PG8_SA(b, h) (((b) * 2 + (h)) * HTB)
#define PG8_SB(b, h) ((4 + (b) * 2 + (h)) * HTB)
#define PG8_STAGE(bufoff, gbase, voff) do { _Pragma("unroll") for (int _i = 0; _i < 2; ++_i) \
        __builtin_amdgcn_global_load_lds((const unsigned*)((const char*)(gbase) + (voff)[_i]), (PG8_LAS unsigned*)(lds + (bufoff) + ldsw + _i * 8192), 16, 0, 0); } while (0)
#define PG8_LDA(dst, b, h) do { _Pragma("unroll") for (int m = 0; m < 4; ++m) _Pragma("unroll") for (int k = 0; k < 2; ++k) dst[m][k] = *(const PG8_LAS bf16x8*)(lds + PG8_SA(b, h) + aoff + m * 2048 + k * 1024); } while (0)
#define PG8_LDB(dst, b, h) do { _Pragma("unroll") for (int n = 0; n < 2; ++n) _Pragma("unroll") for (int k = 0; k < 2; ++k) dst[n][k] = *(const PG8_LAS bf16x8*)(lds + PG8_SB(b, h) + boff + n * 2048 + k * 1024); } while (0)
#define PG8_MMA(ai, bj, At, Bt) do { __builtin_amdgcn_s_setprio(1); _Pragma("unroll") for (int m = 0; m < 4; ++m) _Pragma("unroll") for (int n = 0; n < 2; ++n) _Pragma("unroll") for (int k = 0; k < 2; ++k) \
        acc[ai][bj][m][n] = __builtin_amdgcn_mfma_f32_16x16x32_bf16(Bt[n][k], At[m][k], acc[ai][bj][m][n], 0, 0, 0); __builtin_amdgcn_s_setprio(0); } while (0)
#define PG8_WAIT_V(n) asm volatile("s_waitcnt vmcnt(" #n ")" ::: "memory")
#define PG8_WAIT_L(n) asm volatile("s_waitcnt lgkmcnt(" #n ")" ::: "memory")
#define PG8_BAR __builtin_amdgcn_s_barrier()
#define PG8_SCHED __builtin_amdgcn_sched_barrier(0)
    Unit cur, nxt; int ui = 0;
    if (!S.next(0, cur)) return;
    f32x4 acc[2][2][4][2];
#pragma unroll
    for (int a = 0; a < 2; ++a)
#pragma unroll
        for (int b = 0; b < 2; ++b)
#pragma unroll
            for (int m = 0; m < 4; ++m)
#pragma unroll
                for (int n = 0; n < 2; ++n) acc[a][b][m][n] = (f32x4){0.f, 0.f, 0.f, 0.f};
    bf16x8 At[4][2], B0[2][2], B1[2][2];
    const char* cA = (const char*)g.A + (size_t)cur.pm * tstepA + cur.aoff; const char* cB = (const char*)g.Bt + (size_t)cur.pn * tstepB;
    S.a_ready(cur);
    if constexpr (SP2) {
        PG8_STAGE(PG8_SB(0, 0), cB, voffB); PG8_STAGE(PG8_SB(0, 1), cB + hstepB, voffB); PG8_STAGE(PG8_SA(0, 0), cA, voffA); PG8_STAGE(PG8_SA(0, 1), cA + hstepA, voffA);
        if (wr == 1) PG8_BAR;
        PG8_WAIT_V(2); PG8_BAR;
        PG8_STAGE(PG8_SB(1, 0), cB + kstep, voffB); PG8_STAGE(PG8_SA(1, 0), cA + kstep, voffA); PG8_STAGE(PG8_SB(1, 1), cB + hstepB + kstep, voffB);
        PG8_WAIT_V(6); PG8_BAR;
    } else {
        PG8_STAGE(PG8_SB(0, 0), cB, voffB); PG8_STAGE(PG8_SA(0, 0), cA, voffA); PG8_STAGE(PG8_SB(0, 1), cB + hstepB, voffB); PG8_STAGE(PG8_SA(0, 1), cA + hstepA, voffA);
        if (wr == 1) PG8_BAR;
        PG8_WAIT_V(4); PG8_BAR;
        PG8_STAGE(PG8_SB(1, 0), cB + kstep, voffB); PG8_STAGE(PG8_SA(1, 0), cA + kstep, voffA); PG8_STAGE(PG8_SB(1, 1), cB + hstepB + kstep, voffB);
        PG8_WAIT_V(6); PG8_BAR;
    }
    for (;;) {
        const bool has_next = S.next(ui + 1, nxt);
        const char* nA = has_next ? (const char*)g.A + (size_t)nxt.pm * tstepA + nxt.aoff : cA; const char* nB = has_next ? (const char*)g.Bt + (size_t)nxt.pn * tstepB : cB;
        for (int t = 0; t < nt; t += 2) {
            const bool last = (t == nt - 2);
            const char* a1 = cA + (size_t)(t + 1) * kstep;
            const char* a2 = last ? nA : cA + (size_t)(t + 2) * kstep; const char* b2 = last ? nB : cB + (size_t)(t + 2) * kstep;
            const char* a3 = a2 + kstep; const char* b3 = b2 + kstep;
            if (last && has_next) S.a_ready(nxt);
            if constexpr (SP2) {
            PG8_LDB(B0, 0, 0); PG8_LDB(B1, 0, 1); PG8_SCHED; PG8_LDA(At, 0, 0); PG8_STAGE(PG8_SA(1, 1), a1 + hstepA, voffA);
            PG8_WAIT_V(8); PG8_WAIT_L(0); PG8_BAR; PG8_MMA(0, 0, At, B0); PG8_MMA(0, 1, At, B1); PG8_BAR; PG8_SCHED;
            PG8_LDA(At, 0, 1); PG8_STAGE(PG8_SB(0, 0), b2, voffB); PG8_STAGE(PG8_SB(0, 1), b2 + hstepB, voffB); PG8_STAGE(PG8_SA(0, 0), a2, voffA);
            PG8_WAIT_V(8); PG8_WAIT_L(0); PG8_BAR; PG8_MMA(1, 0, At, B0); PG8_MMA(1, 1, At, B1); PG8_BAR; PG8_SCHED;
            PG8_LDB(B0, 1, 0); PG8_LDB(B1, 1, 1); PG8_SCHED; PG8_LDA(At, 1, 0); PG8_STAGE(PG8_SA(0, 1), a2 + hstepA, voffA);
            PG8_WAIT_V(8); PG8_WAIT_L(0); PG8_BAR; PG8_MMA(0, 0, At, B0); PG8_MMA(0, 1, At, B1); PG8_BAR; PG8_SCHED;
            PG8_LDA(At, 1, 1); PG8_STAGE(PG8_SB(1, 0), b3, voffB); PG8_STAGE(PG8_SB(1, 1), b3 + hstepB, voffB); PG8_STAGE(PG8_SA(1, 0), a3, voffA);
            PG8_WAIT_V(8); PG8_WAIT_L(0); PG8_BAR; PG8_MMA(1, 0, At, B0); PG8_MMA(1, 1, At, B1); PG8_BAR; PG8_SCHED;
            } else {
            PG8_LDB(B0, 0, 0); PG8_SCHED; PG8_LDA(At, 0, 0); PG8_STAGE(PG8_SA(1, 1), a1 + hstepA, voffA);
            PG8_WAIT_L(8); PG8_BAR; PG8_WAIT_L(0); PG8_MMA(0, 0, At, B0); PG8_BAR; PG8_SCHED;
            PG8_LDB(B1, 0, 1); PG8_STAGE(PG8_SB(0, 0), b2, voffB);
            PG8_BAR; PG8_WAIT_L(0); PG8_MMA(0, 1, At, B1); PG8_BAR;
            PG8_LDA(At, 0, 1); PG8_STAGE(PG8_SA(0, 0), a2, voffA);
            PG8_BAR; PG8_WAIT_L(0); PG8_MMA(1, 0, At, B0); PG8_BAR; PG8_SCHED;
            PG8_STAGE(PG8_SB(0, 1), b2 + hstepB, voffB);
            PG8_WAIT_V(6); PG8_BAR; PG8_MMA(1, 1, At, B1); PG8_BAR;
            PG8_LDB(B0, 1, 0); PG8_SCHED; PG8_LDA(At, 1, 0); PG8_STAGE(PG8_SA(0, 1), a2 + hstepA, voffA);
            PG8_WAIT_L(8); PG8_BAR; PG8_WAIT_L(0); PG8_MMA(0, 0, At, B0); PG8_BAR; PG8_SCHED;
            PG8_LDB(B1, 1, 1); PG8_STAGE(PG8_SB(1, 0), b3, voffB);
            PG8_BAR; PG8_WAIT_L(0); PG8_MMA(0, 1, At, B1); PG8_BAR;
            PG8_LDA(At, 1, 1); PG8_STAGE(PG8_SA(1, 0), a3, voffA);
            PG8_BAR; PG8_WAIT_L(0); PG8_MMA(1, 0, At, B0); PG8_BAR; PG8_SCHED;
            PG8_STAGE(PG8_SB(1, 1), b3 + hstepB, voffB);
            PG8_WAIT_V(6); PG8_BAR; PG8_MMA(1, 1, At, B1); PG8_BAR;
            }
        }
        if constexpr (ALIGN_EPI) { if (wr == 0) PG8_BAR; }
        if constexpr (!Epi::AFTER_DRAIN) { E(acc, cur, wr, wc, fr, fq); S.done(cur); }
        if (!has_next) break;
#pragma unroll
        for (int a = 0; a < 2; ++a)
#pragma unroll
            for (int b = 0; b < 2; ++b)
#pragma unroll
                for (int m = 0; m < 4; ++m)
#pragma unroll
                    for (int n = 0; n < 2; ++n) acc[a][b][m][n] = (f32x4){0.f, 0.f, 0.f, 0.f};
        cur = nxt; cA = nA; cB = nB; ++ui;
        if constexpr (ALIGN_EPI) { if (wr == 1) PG8_BAR; }
    }
    PG8_WAIT_V(0);
    if constexpr (!ALIGN_EPI) { if (wr == 0) PG8_BAR; }
    PG8_BAR;
    if constexpr (Epi::AFTER_DRAIN) { E.fused(acc, cur, wr, wc, fr, fq, lds, wid, lane); S.done(cur); }
#undef PG8_SA
#undef PG8_SB
#undef PG8_STAGE
#undef PG8_LDA
#undef PG8_LDB
#undef PG8_MMA
#undef PG8_WAIT_V
#undef PG8_WAIT_L
#undef PG8_BAR
#undef PG8_SCHED
}
}

#define LAS __attribute__((address_space(3)))
typedef unsigned short bf16_t;
typedef short bf16x8 __attribute__((ext_vector_type(8)));
typedef short s16x4 __attribute__((ext_vector_type(4)));
typedef float f32x4 __attribute__((ext_vector_type(4)));
typedef float f32x16 __attribute__((ext_vector_type(16)));
typedef unsigned u32x4 __attribute__((ext_vector_type(4)));
typedef unsigned u32x2 __attribute__((ext_vector_type(2)));
using pg8::cvt_pk_bf16; using pg8::bf2f; using pg8::bflo; using pg8::bfhi; using pg8::sigmoidf_;

constexpr int SEQ = 8192, DM = 1024, NL = 4, MH = 16384, PW = 6912, DFF = 2816, INW = 6676, YW = 1536;
constexpr int C_GQ = 0, C_GK = 256, C_GV = 512, C_GG = 1024, C_FQ = 1536, C_FK = 2048, C_FV = 2560, C_MQ = 3072, C_BG = 3584, C_GA1 = 6656, C_FF = 6672;
constexpr float EPSN = 1e-6f, LOG2E = 1.4426950408889634f;
#ifndef FOX_SKIP
#define FOX_SKIP 1
#endif
constexpr size_t WS_WIN = 0, WS_WMEM = WS_WIN + (size_t)NL * PW * 1024 * 2, WS_WBR = WS_WMEM + (size_t)4096 * 1024 * 2, WS_WOUT = WS_WBR + (size_t)NL * 3 * 1024 * 512 * 2,
    WS_WGU = WS_WOUT + (size_t)NL * 1024 * 1024 * 2, WS_WDN = WS_WGU + (size_t)NL * 5632 * 1024 * 2,
    WS_MKN = WS_WDN + (size_t)NL * 1024 * DFF * 2, WS_MVT = WS_MKN + (size_t)NL * 1024 * 512 * 2, WS_CUMF = WS_MVT + (size_t)NL * 16 * 128 * 256 * 2, WS_DEC = WS_CUMF + (size_t)8 * SEQ * 4,
    WS_VTF = WS_DEC + (size_t)1024 * 64 * 4, WS_SIN = WS_VTF + (size_t)8 * 128 * SEQ * 2, WS_CS = WS_SIN + (size_t)1024 * 128 * 64 * 2, WS_XBF = WS_CS + (size_t)1024 * 128 * 64 * 4,
    WS_PROJ = WS_XBF + (size_t)2 * MH * 1024 * 2, WS_TSK = WS_PROJ + (size_t)MH * PW * 2, WS_BAR = WS_TSK + 256, WS_SSQ = WS_BAR + 16384, WS_MKV = WS_SSQ + (size_t)2 * MH * 16 * 4, WS_END = WS_MKV + (size_t)1024 * 4096 * 2;
constexpr size_t WS_MEMN = WS_PROJ;
static_assert((size_t)2 * MH * DFF * 2 <= (size_t)MH * PW * 2, "full-batch FFN hidden overlays PROJ");
static_assert(WS_END <= (size_t)536870912, "workspace map exceeds 512 MiB");
static_assert((size_t)MH * 1024 * 2 <= (size_t)1024 * 128 * 64 * 4, "MRG overlays CS");

struct Params { const float* in[21]; float* out; unsigned char* ws; };
enum { I_X = 0, I_MEM, I_GMIX, I_WIN, I_WA2, I_BA, I_GGLA, I_BFOX, I_GFQ, I_GFK, I_GMEM, I_WMKV, I_GMQ, I_GMK, I_BGATE, I_WBR, I_WOUT, I_GFFN, I_WFG, I_WFU, I_WFD };

__device__ __forceinline__ float wave_sum(float v) {
#pragma unroll
    for (int o = 1; o < 64; o <<= 1) v += __shfl_xor(v, o);
    return v;
}
__device__ __forceinline__ float log_sigmoid_(float x) { return fminf(x, 0.f) - __logf(1.0f + __expf(-fabsf(x))); }
#define LDS_WAIT() asm volatile("s_waitcnt lgkmcnt(0)" ::: "memory")

__device__ __forceinline__ int inmap(int n) { if (n < 1536) return n; if (n < 3072) return n + 16; if (n < 6656) return n + 20; if (n < 6672) return 1536 + (n - 6656); if (n < 6676) return 3088 + (n - 6672); return -1; }

__device__ __forceinline__ void transpose_item(const float* W, int K, int Ns, const float* gain, bf16_t* WT, LAS float* scr, int kb, int nb, int lane, int sc) {
    const int k0 = 64 * kb, n0 = 32 * nb, c = lane & 7;
    float v[32];
    const float* wp = W + (size_t)(k0 + (lane >> 5)) * Ns + (sc >= 0 ? sc : 0);
#pragma unroll
    for (int i = 0; i < 32; ++i) v[i] = wp[(size_t)(2 * i) * Ns];
    f32x4 g0 = (f32x4){1.f, 1.f, 1.f, 1.f}, g1 = g0;
    if (gain) { g0 = *(const f32x4*)(gain + k0 + 8 * c); g1 = *(const f32x4*)(gain + k0 + 8 * c + 4); }
    if (sc < 0) {
#pragma unroll
        for (int i = 0; i < 32; ++i) v[i] = 0.f;
    }
#pragma unroll
    for (int i = 0; i < 32; ++i) scr[(2 * i + (lane >> 5)) * 33 + (lane & 31)] = v[i];
    LDS_WAIT();
#pragma unroll
    for (int j = 0; j < 4; ++j) { const int n = (lane >> 3) + 8 * j; const LAS float* s = scr + (8 * c) * 33 + n;
        u32x4 o; o.x = cvt_pk_bf16(s[0 * 33] * g0[0], s[1 * 33] * g0[1]); o.y = cvt_pk_bf16(s[2 * 33] * g0[2], s[3 * 33] * g0[3]); o.z = cvt_pk_bf16(s[4 * 33] * g1[0], s[5 * 33] * g1[1]); o.w = cvt_pk_bf16(s[6 * 33] * g1[2], s[7 * 33] * g1[3]);
        *(u32x4*)(WT + (size_t)(n0 + n) * K + k0 + 8 * c) = o; }
    LDS_WAIT();
}
__device__ __forceinline__ void norm_rows(const float* X, bf16_t* XN, int nrows, int gw, int NGW, int lane) {
    for (int m = gw; m < nrows; m += NGW) {
        const f32x4* xr = (const f32x4*)(X + (size_t)m * DM) + lane; f32x4 v[4]; float s = 0.f;
#pragma unroll
        for (int j = 0; j < 4; ++j) { v[j] = xr[64 * j]; s += (v[j].x * v[j].x + v[j].y * v[j].y) + (v[j].z * v[j].z + v[j].w * v[j].w); }
        const float r = __builtin_amdgcn_rsqf(wave_sum(s) * (1.0f / DM) + EPSN);
        u32x2* o8 = (u32x2*)(XN + (size_t)m * DM) + lane;
#pragma unroll
        for (int j = 0; j < 4; ++j) { u32x2 w; w.x = cvt_pk_bf16(v[j].x * r, v[j].y * r); w.y = cvt_pk_bf16(v[j].z * r, v[j].w * r); o8[64 * j] = w; }
    }
}
__device__ __forceinline__ void norm128_rows64(const bf16_t* src, size_t spitch, bf16_t* dst, size_t dpitch, const float* gain, float scale, int tid) {
    const int sub = tid & 15; float g[8];
#pragma unroll
    for (int j = 0; j < 8; ++j) g[j] = gain[sub * 8 + j] * scale;
#pragma unroll
    for (int pass = 0; pass < 2; ++pass) { const int row = pass * 32 + (tid >> 4);
        const u32x4 w = *(const u32x4*)(src + (size_t)row * spitch + sub * 8);
        float v[8] = {bflo(w.x), bfhi(w.x), bflo(w.y), bfhi(w.y), bflo(w.z), bfhi(w.z), bflo(w.w), bfhi(w.w)};
        float ss = 0.f;
#pragma unroll
        for (int j = 0; j < 8; ++j) ss += v[j] * v[j];
        ss += __shfl_xor(ss, 1); ss += __shfl_xor(ss, 2); ss += __shfl_xor(ss, 4); ss += __shfl_xor(ss, 8);
        const float r = __builtin_amdgcn_rsqf(ss * (1.0f / 128.0f) + EPSN);
        u32x4 o; o.x = cvt_pk_bf16(v[0] * r * g[0], v[1] * r * g[1]); o.y = cvt_pk_bf16(v[2] * r * g[2], v[3] * r * g[3]); o.z = cvt_pk_bf16(v[4] * r * g[4], v[5] * r * g[5]); o.w = cvt_pk_bf16(v[6] * r * g[6], v[7] * r * g[7]);
        *(u32x4*)(dst + (size_t)row * dpitch + sub * 8) = o; }
}
__device__ __forceinline__ void vt_tile(const bf16_t* src, size_t spitch, bf16_t* dst, size_t dpitch, LAS bf16_t* T, int tid) {
#pragma unroll
    for (int i = 0; i < 2; ++i) { const int c = tid + 512 * i, row = c >> 4, part = c & 15; const u32x4 w = *(const u32x4*)(src + (size_t)row * spitch + part * 8); *(LAS u32x4*)(T + row * 136 + part * 8) = w; }
    __syncthreads();
    const int d = tid & 127, part = tid >> 7; unsigned v[16];
#pragma unroll
    for (int i = 0; i < 16; ++i) v[i] = T[(16 * part + i) * 136 + d];
    u32x4 w0, w1; w0.x = v[0] | (v[1] << 16); w0.y = v[2] | (v[3] << 16); w0.z = v[4] | (v[5] << 16); w0.w = v[6] | (v[7] << 16);
    w1.x = v[8] | (v[9] << 16); w1.y = v[10] | (v[11] << 16); w1.z = v[12] | (v[13] << 16); w1.w = v[14] | (v[15] << 16);
    *(u32x4*)(dst + (size_t)d * dpitch + 16 * part) = w0; *(u32x4*)(dst + (size_t)d * dpitch + 16 * part + 8) = w1;
    __syncthreads();
}
__device__ __forceinline__ void prep_batch(const bf16_t* PROJp, const float* gk, bf16_t* KCp, bf16_t* VTFp, LAS bf16_t* T, int v0, int vs, int tid) {
    const int sub = tid & 15, row = tid >> 4;
    u32x4 w[4][2], vw[4][2];
#pragma unroll
    for (int q = 0; q < 4; ++q) { const int v = v0 + q * vs; if (v < 1024) { const int r0 = (v >> 2) * 64, h = v & 3; const bf16_t* rowp = PROJp + (size_t)r0 * PW;
#pragma unroll
        for (int ps = 0; ps < 2; ++ps) w[q][ps] = *(const u32x4*)(rowp + (size_t)(ps * 32 + row) * PW + C_FK + h * 128 + sub * 8);
#pragma unroll
        for (int i = 0; i < 2; ++i) { const int c = tid + 512 * i; vw[q][i] = *(const u32x4*)(rowp + (size_t)(c >> 4) * PW + C_FV + h * 128 + (c & 15) * 8); } } }
    float g[8];
#pragma unroll
    for (int j = 0; j < 8; ++j) g[j] = gk[sub * 8 + j];
#pragma unroll
    for (int q = 0; q < 4; ++q) { const int v = v0 + q * vs; if (v < 1024) { const int r0 = (v >> 2) * 64, h = v & 3, bp = r0 / SEQ, s0 = r0 % SEQ;
        bf16_t* kdst = KCp + ((size_t)(bp * 4 + h) * SEQ + s0) * 128;
#pragma unroll
        for (int ps = 0; ps < 2; ++ps) { const u32x4 x = w[q][ps];
            float f[8] = {bflo(x.x), bfhi(x.x), bflo(x.y), bfhi(x.y), bflo(x.z), bfhi(x.z), bflo(x.w), bfhi(x.w)};
            float ss = 0.f;
#pragma unroll
            for (int j = 0; j < 8; ++j) ss += f[j] * f[j];
            ss += __shfl_xor(ss, 1); ss += __shfl_xor(ss, 2); ss += __shfl_xor(ss, 4); ss += __shfl_xor(ss, 8);
            const float r = __builtin_amdgcn_rsqf(ss * (1.0f / 128.0f) + EPSN);
            u32x4 o; o.x = cvt_pk_bf16(f[0] * r * g[0], f[1] * r * g[1]); o.y = cvt_pk_bf16(f[2] * r * g[2], f[3] * r * g[3]); o.z = cvt_pk_bf16(f[4] * r * g[4], f[5] * r * g[5]); o.w = cvt_pk_bf16(f[6] * r * g[6], f[7] * r * g[7]);
            *(u32x4*)(kdst + (ps * 32 + row) * 128 + sub * 8) = o; }
#pragma unroll
        for (int i = 0; i < 2; ++i) { const int c = tid + 512 * i; *(LAS u32x4*)(T + q * 8704 + (c >> 4) * 136 + (c & 15) * 8) = vw[q][i]; } } }
    __syncthreads();
    const int d = tid & 127, part = tid >> 7;
#pragma unroll
    for (int q = 0; q < 4; ++q) { const int v = v0 + q * vs; if (v < 1024) { const int r0 = (v >> 2) * 64, h = v & 3, bp = r0 / SEQ, s0 = r0 % SEQ;
        bf16_t* vtdst = VTFp + ((size_t)(bp * 4 + h) * 128 + (s0 >> 6)) * 8192; unsigned e[16];
#pragma unroll
        for (int i = 0; i < 16; ++i) e[i] = T[q * 8704 + (16 * part + i) * 136 + d];
        u32x4 w0, w1; w0.x = e[0] | (e[1] << 16); w0.y = e[2] | (e[3] << 16); w0.z = e[4] | (e[5] << 16); w0.w = e[6] | (e[7] << 16);
        w1.x = e[8] | (e[9] << 16); w1.y = e[10] | (e[11] << 16); w1.z = e[12] | (e[13] << 16); w1.w = e[14] | (e[15] << 16);
        *(u32x4*)(vtdst + d * 64 + 16 * part) = w0; *(u32x4*)(vtdst + d * 64 + 16 * part + 8) = w1; } }
    __syncthreads();
}
__device__ __forceinline__ void xb_rows(const float* X, bf16_t* XB, float* ssq, int nrows, int gw, int NGW, int lane) {
    for (int m = gw; m < nrows; m += NGW) {
        const f32x4* xr = (const f32x4*)(X + (size_t)m * DM) + lane; f32x4 v[4]; float s = 0.f;
#pragma unroll
        for (int j = 0; j < 4; ++j) { v[j] = xr[64 * j]; s += (v[j].x * v[j].x + v[j].y * v[j].y) + (v[j].z * v[j].z + v[j].w * v[j].w); }
        s = wave_sum(s);
        u32x2* o8 = (u32x2*)(XB + (size_t)m * DM) + lane;
#pragma unroll
        for (int j = 0; j < 4; ++j) { u32x2 w; w.x = cvt_pk_bf16(v[j].x, v[j].y); w.y = cvt_pk_bf16(v[j].z, v[j].w); o8[64 * j] = w; }
        if (lane < 16) ssq[(size_t)m * 16 + lane] = lane == 0 ? s : 0.f;
    }
}
#define MFMA32(a, b, c) __builtin_amdgcn_mfma_f32_32x32x16_bf16((a), (b), (c), 0, 0, 0)
__device__ __forceinline__ bf16x8 pack8(const f32x16& x, int s) {
    u32x4 p; p.x = cvt_pk_bf16(x[8 * s], x[8 * s + 1]); p.y = cvt_pk_bf16(x[8 * s + 2], x[8 * s + 3]); p.z = cvt_pk_bf16(x[8 * s + 4], x[8 * s + 5]); p.w = cvt_pk_bf16(x[8 * s + 6], x[8 * s + 7]);
    return __builtin_bit_cast(bf16x8, p);
}
constexpr int AT_K = 0, AT_V = 34816, AT_B = 71680, AT_Q = 73984;
template <bool FOX>
__device__ __forceinline__ void attn_tile(const LAS unsigned char* Kb, const LAS unsigned char* Vb, const LAS float* bb, const LAS unsigned char* Qw, f32x16 (&o)[4], float& mrun, float& lrun,
                                          int k0, int qw0, int qlane, int r32, int hi) {
    if (FOX && k0 > qw0 + 31) return;
    f32x16 st[2];
#pragma unroll
    for (int kb = 0; kb < 2; ++kb)
#pragma unroll
        for (int r = 0; r < 16; ++r) st[kb][r] = 0.f;
#pragma unroll
    for (int hb = 0; hb < 2; ++hb) {
        bf16x8 qf[4], ka[4][2];
#pragma unroll
        for (int k4 = 0; k4 < 4; ++k4) { const int ks = 4 * hb + k4; qf[k4] = *(const LAS bf16x8*)(Qw + (r32 * 136 + 16 * ks + 8 * hi) * 2);
            ka[k4][0] = *(const LAS bf16x8*)(Kb + (r32 * 136 + 16 * ks + 8 * hi) * 2); ka[k4][1] = *(const LAS bf16x8*)(Kb + ((32 + r32) * 136 + 16 * ks + 8 * hi) * 2); }
        __builtin_amdgcn_sched_barrier(0);
#pragma unroll
        for (int k4 = 0; k4 < 4; ++k4) { st[0] = MFMA32(ka[k4][0], qf[k4], st[0]); st[1] = MFMA32(ka[k4][1], qf[k4], st[1]); }
        __builtin_amdgcn_sched_barrier(0);
    }
    if (FOX) {
#pragma unroll
        for (int kb = 0; kb < 2; ++kb)
#pragma unroll
            for (int g = 0; g < 4; ++g) { const f32x4 bv = *(const LAS f32x4*)(bb + 32 * kb + 8 * g + 4 * hi);
#pragma unroll
                for (int i = 0; i < 4; ++i) st[kb][4 * g + i] += bv[i]; }
        if (k0 + 63 > qw0) {
#pragma unroll
            for (int kb = 0; kb < 2; ++kb)
#pragma unroll
                for (int r = 0; r < 16; ++r) { const int key = k0 + 32 * kb + (r & 3) + 8 * (r >> 2) + 4 * hi; if (key > qlane) st[kb][r] = -INFINITY; }
        }
    }
    float mx = st[0][0];
#pragma unroll
    for (int r = 1; r < 16; ++r) mx = fmaxf(mx, st[0][r]);
#pragma unroll
    for (int r = 0; r < 16; ++r) mx = fmaxf(mx, st[1][r]);
    mx = pg8::xmax32(mx);
    const float mnew = fmaxf(mrun, mx), msafe = (mnew == -INFINITY) ? 0.f : mnew;
    const float alpha = (mrun == -INFINITY) ? 0.f : __builtin_amdgcn_exp2f(mrun - msafe);
    float rs = 0.f;
#pragma unroll
    for (int kb = 0; kb < 2; ++kb)
#pragma unroll
        for (int r = 0; r < 16; ++r) { const float pv = __builtin_amdgcn_exp2f(st[kb][r] - msafe); st[kb][r] = pv; rs += pv; }
    rs = pg8::xsum32(rs);
    lrun = lrun * alpha + rs; mrun = mnew;
#pragma unroll
    for (int i = 0; i < 4; ++i)
#pragma unroll
        for (int r = 0; r < 16; ++r) o[i][r] *= alpha;
    s16x4 vlo[2][4], vhi[2][4];
#define AT_VLD(buf, g) do { _Pragma("unroll") for (int db = 0; db < 4; ++db) { const LAS unsigned char* vp = Vb + ((32 * db + r32) * 72 + 16 * (g) + 4 * hi) * 2; \
        vlo[buf][db] = *(const LAS s16x4*)vp; vhi[buf][db] = *(const LAS s16x4*)(vp + 16); } } while (0)
    AT_VLD(0, 0);
#pragma unroll
    for (int g = 0; g < 4; ++g) {
        __builtin_amdgcn_sched_barrier(0);
        if (g < 3) AT_VLD((g + 1) & 1, g + 1);
        const bf16x8 pf = pack8(st[g >> 1], g & 1);
        __builtin_amdgcn_sched_barrier(0);
#pragma unroll
        for (int db = 0; db < 4; ++db) { const bf16x8 a = __builtin_shufflevector(vlo[g & 1][db], vhi[g & 1][db], 0, 1, 2, 3, 4, 5, 6, 7); o[db] = MFMA32(a, pf, o[db]); }
    }
#undef AT_VLD
}
template <bool FOX>
__device__ __forceinline__ void attn_unit(LAS unsigned char* lds, const float* qgain, const bf16_t* Q, size_t qpitch, const bf16_t* K, size_t kpitch, const bf16_t* VT, size_t vpitch, int vtile,
                                          const float* cum, float cref, float o1, float o2, float o3, int q0, int j0, int j1, bf16_t* O, size_t opitch, int tid, int lane, int wid) {
    const int r32 = lane & 31, hi = lane >> 5, qw0 = q0 + 32 * wid, qlane = qw0 + r32;
    const LAS unsigned char* Qw = lds + AT_Q + wid * (32 * 136 * 2);
    {
        bf16x8 qf[8];
#pragma unroll
        for (int ks = 0; ks < 8; ++ks) qf[ks] = *(const bf16x8*)(Q + (unsigned)((32 * wid + r32) * (int)qpitch + 16 * ks + 8 * hi));
        float ss = 0.f;
#pragma unroll
        for (int ks = 0; ks < 8; ++ks)
#pragma unroll
            for (int j = 0; j < 8; ++j) { const float x = bf2f((unsigned short)qf[ks][j]); ss += x * x; }
        ss = pg8::xsum32(ss);
        const float rq = (__builtin_amdgcn_rsqf(ss * (1.0f / 128.0f) + EPSN)) * (0.08838834764831845f * LOG2E);
#pragma unroll
        for (int ks = 0; ks < 8; ++ks) { const f32x4 ga = *(const f32x4*)(qgain + 16 * ks + 8 * hi), gb = *(const f32x4*)(qgain + 16 * ks + 8 * hi + 4);
            u32x4 w; w.x = cvt_pk_bf16(bf2f((unsigned short)qf[ks][0]) * rq * ga[0], bf2f((unsigned short)qf[ks][1]) * rq * ga[1]);
            w.y = cvt_pk_bf16(bf2f((unsigned short)qf[ks][2]) * rq * ga[2], bf2f((unsigned short)qf[ks][3]) * rq * ga[3]);
            w.z = cvt_pk_bf16(bf2f((unsigned short)qf[ks][4]) * rq * gb[0], bf2f((unsigned short)qf[ks][5]) * rq * gb[1]);
            w.w = cvt_pk_bf16(bf2f((unsigned short)qf[ks][6]) * rq * gb[2], bf2f((unsigned short)qf[ks][7]) * rq * gb[3]);
            *(LAS u32x4*)(lds + AT_Q + wid * (32 * 136 * 2) + (r32 * 136 + 16 * ks + 8 * hi) * 2) = w; }
    }
    f32x16 o[4];
#pragma unroll
    for (int i = 0; i < 4; ++i)
#pragma unroll
        for (int r = 0; r < 16; ++r) o[i][r] = 0.f;
    float mrun = -INFINITY, lrun = 0.f;
    const int kkey0 = tid >> 4, kpart = tid & 15, vd0 = tid >> 3, vpart = tid & 7;
    u32x4 kA[2], vA[2], kB[2], vB[2]; float bA = 0.f, bB = 0.f;
#define AT_LOAD(kr, vr, br, j) do { _Pragma("unroll") for (int i_ = 0; i_ < 2; ++i_) { \
        kr[i_] = *(const u32x4*)(K + (unsigned)((64 * (j) + kkey0 + 32 * i_) * (int)kpitch + kpart * 8)); \
        vr[i_] = *(const u32x4*)(VT + (unsigned)((vd0 + 64 * i_) * (int)vpitch + vtile * (j) + vpart * 8)); } \
        if (FOX) { const int sj_ = (j) >> 5; br = (cref - (cum[64 * (j) + (tid & 63)] + (sj_ == 0 ? 0.f : sj_ == 1 ? o1 : sj_ == 2 ? o2 : o3))) * LOG2E; } } while (0)
#define AT_STORE(kr, vr, br, buf) do { _Pragma("unroll") for (int i_ = 0; i_ < 2; ++i_) { \
        *(LAS u32x4*)(lds + AT_K + (buf) * 17408 + ((kkey0 + 32 * i_) * 136 + kpart * 8) * 2) = kr[i_]; \
        *(LAS u32x4*)(lds + AT_V + (buf) * 18432 + ((vd0 + 64 * i_) * 72 + vpart * 8) * 2) = vr[i_]; } \
        if (FOX && tid < 64) ((LAS float*)(lds + AT_B))[(buf) * 64 + tid] = br; } while (0)
#define AT_TILE(buf, j) attn_tile<FOX>(lds + AT_K + (buf) * 17408, lds + AT_V + (buf) * 18432, (const LAS float*)(lds + AT_B) + (buf) * 64, Qw, o, mrun, lrun, 64 * (j), qw0, qlane, r32, hi)
#define AT_BAR() asm volatile("s_waitcnt lgkmcnt(0)\n\ts_barrier" ::: "memory")
    AT_LOAD(kA, vA, bA, j0);
    AT_LOAD(kB, vB, bB, (j0 + 1 <= j1 ? j0 + 1 : j1));
    AT_STORE(kA, vA, bA, 0);
    AT_BAR();
    for (int j = j0; j <= j1; j += 2) {
        AT_LOAD(kA, vA, bA, (j + 2 <= j1 ? j + 2 : j1));
        __builtin_amdgcn_sched_barrier(0);
        AT_TILE(0, j);
        if (j + 1 <= j1) AT_STORE(kB, vB, bB, 1);
        AT_BAR();
        if (j + 1 > j1) break;
        AT_LOAD(kB, vB, bB, (j + 3 <= j1 ? j + 3 : j1));
        __builtin_amdgcn_sched_barrier(0);
        AT_TILE(1, j + 1);
        if (j + 2 <= j1) AT_STORE(kA, vA, bA, 0);
        AT_BAR();
    }
#undef AT_BAR
#undef AT_LOAD
#undef AT_STORE
#undef AT_TILE
    const float rl = __builtin_amdgcn_rcpf(lrun);
    int lr_ = lane; asm volatile("" : "+v"(lr_));
    bf16_t* orow = O + (unsigned)((32 * wid + (lr_ & 31)) * (int)opitch);
#pragma unroll
    for (int db = 0; db < 4; ++db)
#pragma unroll
        for (int g = 0; g < 4; ++g) { u32x2 w; w.x = cvt_pk_bf16(o[db][4 * g] * rl, o[db][4 * g + 1] * rl); w.y = cvt_pk_bf16(o[db][4 * g + 2] * rl, o[db][4 * g + 3] * rl);
            *(u32x2*)(orow + 32 * db + 8 * g + 4 * (lr_ >> 5)) = w; }
}
constexpr int GL_GA1 = 0, GL_SEG = 4096, GL_SS = 6144, GL_A8 = 8192, GL_KIN = 17408, GL_VT = 26624, GL_SINT = 45056, GL_UOFF = 65536;
template <bool OUTPHASE>
__device__ __forceinline__ void gla_pair(LAS unsigned char* lds0, const Params& p, int l, int unitA, int unitB, const bf16_t* PROJ, float* CS, float* DEC, const bf16_t* SIN, bf16_t* Y, int tid, int lane, int wid) {
    const int r32 = lane & 31, hi = lane >> 5, d = tid & 63, seg = wid;
    int h[2], r0[2], unit[2];
#pragma unroll
    for (int uu = 0; uu < 2; ++uu) { unit[uu] = uu ? unitB : unitA; const int bhp = unit[uu] >> 7, n = unit[uu] & 127; h[uu] = bhp & 3; r0[uu] = (bhp >> 2) * SEQ + n * 64; }
    u32x2 ggw[2][4]; f32x4 ggn[2][4]; float wa[2][16], ba[2], kv[2][8], qv[2][8];
#pragma unroll
    for (int uu = 0; uu < 2; ++uu) { LAS unsigned char* lds = lds0 + uu * GL_UOFF;
        LAS float* GA1 = (LAS float*)(lds + GL_GA1); LAS bf16_t* VTl = (LAS bf16_t*)(lds + GL_VT); LAS bf16_t* SINT = (LAS bf16_t*)(lds + GL_SINT);
        if (tid < 128) { const int row = tid >> 1, hp = tid & 1; const u32x4 w = *(const u32x4*)(PROJ + (size_t)(r0[uu] + row) * PW + C_GA1 + 8 * hp);
            LAS float* gp = GA1 + row * 16 + 8 * hp; gp[0] = bflo(w.x); gp[1] = bfhi(w.x); gp[2] = bflo(w.y); gp[3] = bfhi(w.y); gp[4] = bflo(w.z); gp[5] = bfhi(w.z); gp[6] = bflo(w.w); gp[7] = bfhi(w.w); }
        { const int dv = tid & 127, part = tid >> 7; unsigned v[16];
#pragma unroll
          for (int i = 0; i < 16; ++i) v[i] = PROJ[(size_t)(r0[uu] + 16 * part + i) * PW + C_GV + h[uu] * 128 + dv];
          u32x4 w0, w1; w0.x = v[0] | (v[1] << 16); w0.y = v[2] | (v[3] << 16); w0.z = v[4] | (v[5] << 16); w0.w = v[6] | (v[7] << 16);
          w1.x = v[8] | (v[9] << 16); w1.y = v[10] | (v[11] << 16); w1.z = v[12] | (v[13] << 16); w1.w = v[14] | (v[15] << 16);
          *(LAS u32x4*)(VTl + dv * 72 + 16 * part) = w0; *(LAS u32x4*)(VTl + dv * 72 + 16 * part + 8) = w1; }
        if (OUTPHASE) {
#pragma unroll
            for (int i = 0; i < 2; ++i) { const int c = tid + 512 * i, dv = c >> 3, part = c & 7; *(LAS u32x4*)(SINT + dv * 72 + part * 8) = *(const u32x4*)(SIN + ((size_t)unit[uu] * 128 + dv) * 64 + part * 8); }
            const int dvb_ = wid >> 1, cb_ = wid & 1;
#pragma unroll
            for (int g = 0; g < 4; ++g) { const int d4 = 32 * dvb_ + 8 * g + 4 * hi; ggw[uu][g] = *(const u32x2*)(PROJ + (size_t)(r0[uu] + 32 * cb_ + r32) * PW + C_GG + h[uu] * 128 + d4); ggn[uu][g] = *(const f32x4*)(p.in[I_GGLA] + l * 512 + h[uu] * 128 + d4); }
        }
#pragma unroll
        for (int i = 0; i < 16; ++i) wa[uu][i] = p.in[I_WA2][(size_t)(l * 16 + i) * 256 + h[uu] * 64 + d];
        ba[uu] = p.in[I_BA][l * 256 + h[uu] * 64 + d];
#pragma unroll
        for (int i = 0; i < 8; ++i) { kv[uu][i] = bf2f(PROJ[(size_t)(r0[uu] + 8 * seg + i) * PW + C_GK + h[uu] * 64 + d]); qv[uu][i] = OUTPHASE ? bf2f(PROJ[(size_t)(r0[uu] + 8 * seg + i) * PW + C_GQ + h[uu] * 64 + d]) : 0.f; }
    }
    __syncthreads();
    float cumv[2][8];
#pragma unroll
    for (int uu = 0; uu < 2; ++uu) { LAS unsigned char* lds = lds0 + uu * GL_UOFF; LAS float* GA1 = (LAS float*)(lds + GL_GA1); LAS float* SEG = (LAS float*)(lds + GL_SEG);
        float run = 0.f;
#pragma unroll
        for (int i = 0; i < 8; ++i) { const LAS float* gp = GA1 + (8 * seg + i) * 16; float z = ba[uu];
#pragma unroll
            for (int j = 0; j < 16; ++j) z += gp[j] * wa[uu][j];
            run += log_sigmoid_(z) * (1.0f / 16.0f); cumv[uu][i] = run; }
        SEG[seg * 64 + d] = run; }
    __syncthreads();
#pragma unroll
    for (int uu = 0; uu < 2; ++uu) { LAS unsigned char* lds = lds0 + uu * GL_UOFF; LAS float* SEG = (LAS float*)(lds + GL_SEG); LAS bf16_t* A8 = (LAS bf16_t*)(lds + GL_A8); LAS bf16_t* KIN = (LAS bf16_t*)(lds + GL_KIN);
        float offs = 0.f, total = 0.f;
#pragma unroll
        for (int s = 0; s < 8; ++s) { const float t = SEG[s * 64 + d]; total += t; if (s < seg) offs += t; }
        if (!OUTPHASE) {
            float ko[8];
#pragma unroll
            for (int i = 0; i < 8; ++i) ko[i] = kv[uu][i] * __expf(total - (cumv[uu][i] + offs));
            u32x4 w; w.x = cvt_pk_bf16(ko[0], ko[1]); w.y = cvt_pk_bf16(ko[2], ko[3]); w.z = cvt_pk_bf16(ko[4], ko[5]); w.w = cvt_pk_bf16(ko[6], ko[7]);
            *(LAS u32x4*)(A8 + d * 72 + 8 * seg) = w;
            if (seg == 0) DEC[(size_t)unit[uu] * 64 + d] = __expf(total);
        } else {
#pragma unroll
            for (int i = 0; i < 8; ++i) { const float c = cumv[uu][i] + offs; const int t = 8 * seg + i;
                A8[t * 72 + d] = (bf16_t)(cvt_pk_bf16(qv[uu][i] * 0.125f * __expf(c), 0.f) & 0xffffu);
                KIN[t * 72 + d] = (bf16_t)(cvt_pk_bf16(kv[uu][i] * __expf(-c), 0.f) & 0xffffu); }
        } }
    __syncthreads();
    if (!OUTPHASE) {
        const int dvb = wid >> 1, dkb = wid & 1;
#pragma unroll
        for (int uu = 0; uu < 2; ++uu) { LAS unsigned char* lds = lds0 + uu * GL_UOFF; LAS bf16_t* A8 = (LAS bf16_t*)(lds + GL_A8); LAS bf16_t* VTl = (LAS bf16_t*)(lds + GL_VT);
            f32x16 acc;
#pragma unroll
            for (int r = 0; r < 16; ++r) acc[r] = 0.f;
#pragma unroll
            for (int ks = 0; ks < 4; ++ks) { const bf16x8 a = *(const LAS bf16x8*)(VTl + (32 * dvb + r32) * 72 + 16 * ks + 8 * hi); const bf16x8 b = *(const LAS bf16x8*)(A8 + (32 * dkb + r32) * 72 + 16 * ks + 8 * hi); acc = MFMA32(a, b, acc); }
            float* cs = CS + (size_t)unit[uu] * 8192;
#pragma unroll
            for (int r = 0; r < 16; ++r) cs[(32 * dvb + (r & 3) + 8 * (r >> 2) + 4 * hi) * 64 + 32 * dkb + r32] = acc[r]; }
        __syncthreads();
    } else {
        const int dvb = wid >> 1, cb = wid & 1;
        f32x16 o[2];
#pragma unroll
        for (int uu = 0; uu < 2; ++uu) { LAS unsigned char* lds = lds0 + uu * GL_UOFF; LAS float* SS = (LAS float*)(lds + GL_SS);
            LAS bf16_t* A8 = (LAS bf16_t*)(lds + GL_A8); LAS bf16_t* KIN = (LAS bf16_t*)(lds + GL_KIN); LAS bf16_t* VTl = (LAS bf16_t*)(lds + GL_VT); LAS bf16_t* SINT = (LAS bf16_t*)(lds + GL_SINT);
            f32x16 at[2];
#pragma unroll
            for (int r = 0; r < 16; ++r) { at[0][r] = 0.f; at[1][r] = 0.f; o[uu][r] = 0.f; }
            bf16x8 qb[4];
#pragma unroll
            for (int ks = 0; ks < 4; ++ks) qb[ks] = *(const LAS bf16x8*)(A8 + (32 * cb + r32) * 72 + 16 * ks + 8 * hi);
#pragma unroll
            for (int sb = 0; sb < 2; ++sb) if (sb <= cb) {
#pragma unroll
                for (int ks = 0; ks < 4; ++ks) { const bf16x8 a = *(const LAS bf16x8*)(KIN + (32 * sb + r32) * 72 + 16 * ks + 8 * hi); at[sb] = MFMA32(a, qb[ks], at[sb]); }
                if (sb == cb) {
#pragma unroll
                    for (int r = 0; r < 16; ++r) if ((r & 3) + 8 * (r >> 2) + 4 * hi > r32) at[sb][r] = 0.f;
                }
#pragma unroll
                for (int s = 0; s < 2; ++s) { const bf16x8 pf = pack8(at[sb], s); const LAS bf16_t* vp = VTl + (32 * dvb + r32) * 72 + 32 * sb + 16 * s + 4 * hi;
                    const s16x4 lo = *(const LAS s16x4*)vp, hh = *(const LAS s16x4*)(vp + 8); const bf16x8 a = __builtin_shufflevector(lo, hh, 0, 1, 2, 3, 4, 5, 6, 7);
                    o[uu] = MFMA32(a, pf, o[uu]); }
            }
#pragma unroll
            for (int ks = 0; ks < 4; ++ks) { const bf16x8 a = *(const LAS bf16x8*)(SINT + (32 * dvb + r32) * 72 + 16 * ks + 8 * hi); o[uu] = MFMA32(a, qb[ks], o[uu]); }
            float ss = 0.f;
#pragma unroll
            for (int r = 0; r < 16; ++r) ss += o[uu][r] * o[uu][r];
            ss = pg8::xsum32(ss);
            if (hi == 0) SS[dvb * 64 + 32 * cb + r32] = ss; }
        __syncthreads();
#pragma unroll
        for (int uu = 0; uu < 2; ++uu) { if (uu == 1 && unitB == unitA) break;
            LAS unsigned char* lds = lds0 + uu * GL_UOFF; LAS float* SS = (LAS float*)(lds + GL_SS);
            const int c = 32 * cb + r32;
            const float tot = SS[c] + SS[64 + c] + SS[128 + c] + SS[192 + c];
            const float rn = __builtin_amdgcn_rsqf(tot * (1.0f / 128.0f) + EPSN);
            const size_t row = (size_t)(r0[uu] + c);
#pragma unroll
            for (int g = 0; g < 4; ++g) { const int d4 = 32 * dvb + 8 * g + 4 * hi;
                const u32x2 gw = ggw[uu][g]; const f32x4 gn = ggn[uu][g];
                const float g0 = bflo(gw.x), g1 = bfhi(gw.x), g2 = bflo(gw.y), g3 = bfhi(gw.y);
                u32x2 w; w.x = cvt_pk_bf16(o[uu][4 * g] * rn * gn[0] * g0 * sigmoidf_(g0), o[uu][4 * g + 1] * rn * gn[1] * g1 * sigmoidf_(g1));
                w.y = cvt_pk_bf16(o[uu][4 * g + 2] * rn * gn[2] * g2 * sigmoidf_(g2), o[uu][4 * g + 3] * rn * gn[3] * g3 * sigmoidf_(g3));
                *(u32x2*)(Y + row * PW + C_GV + h[uu] * 128 + d4) = w; } }
        __syncthreads();
    }
}
#define XB_TMO      128
#define XB_XCNT(j)  (256  + 64 * (j))
#define XB_XSUB(j)  (1280 + 64 * (j))
#define XB_XGEN(j)  (2304 + 64 * (j))
#define XB_TOP      3328
#define XB_TOPGEN   3392
#define XCD_BAR_WORDS 3456
#define XB_SPIN_CAP (1u << 18)

__device__ __forceinline__ unsigned xb_ld(unsigned* p)              { return __hip_atomic_load(p, __ATOMIC_RELAXED, __HIP_MEMORY_SCOPE_AGENT); }
__device__ __forceinline__ unsigned xb_add(unsigned* p, unsigned v) { return __hip_atomic_fetch_add(p, v, __ATOMIC_RELAXED, __HIP_MEMORY_SCOPE_AGENT); }
__device__ __forceinline__ unsigned xb_xcc_id() { return (unsigned)__builtin_amdgcn_s_getreg((3 << 11) | 20) & 0xFu; }
#define XB_SPIN(cond, bar) do { unsigned _sp = 0; while (cond) { __builtin_amdgcn_s_sleep(1); \
    if ((++_sp & 255u) == 0u) { if (xb_ld(&(bar)[XB_TMO])) break; if (_sp > XB_SPIN_CAP) { atomicAdd(&(bar)[XB_TMO], 1u); break; } } } } while (0)

struct XcdBarrier {
    unsigned* bar; unsigned x;
    volatile LAS unsigned* st;
};

__device__ __forceinline__ XcdBarrier xcd_barrier_post(unsigned* bar, volatile LAS unsigned* st) {
    XcdBarrier b; b.bar = bar; b.x = xb_xcc_id(); b.st = st;
    if (threadIdx.x == 0) (void)xb_add(&bar[XB_XCNT(b.x)], 1u);
    return b;
}
__device__ __forceinline__ void xcd_barrier_complete(unsigned* bar, unsigned x, unsigned& nloc, unsigned& nx) {
    const unsigned G = gridDim.x * gridDim.y * gridDim.z;
    unsigned sum, cnt, mine, sp = 0u;
    for (;;) {
        sum = 0u; cnt = 0u; mine = 0u;
#pragma unroll
        for (unsigned j = 0; j < 16; ++j) { const unsigned c = xb_ld(&bar[XB_XCNT(j)]); sum += c; cnt += (c > 0u) ? 1u : 0u; mine = (j == x) ? c : mine; }
        if (sum == G) break;
        __builtin_amdgcn_s_sleep(1);
        if ((++sp & 255u) == 0u) { if (xb_ld(&bar[XB_TMO])) break; if (sp > XB_SPIN_CAP) { atomicAdd(&bar[XB_TMO], 1u); break; } }
    }
    nloc = mine > 0u ? mine : 1u; nx = cnt > 0u ? cnt : 1u;
}

__device__ __forceinline__ void xcd_barrier(const XcdBarrier& b) {
    asm volatile("s_waitcnt vmcnt(0)" ::: "memory");
    __syncthreads();
    if (threadIdx.x == 0) {
        unsigned* bar = b.bar;
        __builtin_amdgcn_s_waitcnt(0);
        unsigned nloc = b.st[0], nx = b.st[1];
        if (nloc == 0u) { xcd_barrier_complete(bar, b.x, nloc, nx); b.st[0] = nloc; b.st[1] = nx; }
        const unsigned old = xb_add(&bar[XB_XSUB(b.x)], 1u);
        const unsigned gen = old / nloc;
        if (old + 1u == (gen + 1u) * nloc) {
            __builtin_amdgcn_fence(__ATOMIC_RELEASE, "agent");
            asm volatile("s_waitcnt vmcnt(0)" ::: "memory");
            const unsigned og = xb_add(&bar[XB_TOP], 1u);
            const unsigned tg = og / nx;
            if (og + 1u == (tg + 1u) * nx) xb_add(&bar[XB_TOPGEN], 1u);
            else XB_SPIN(xb_ld(&bar[XB_TOPGEN]) == tg, bar);
            __builtin_amdgcn_fence(__ATOMIC_ACQUIRE, "agent");
            xb_add(&bar[XB_XGEN(b.x)], 1u);
            asm volatile("s_waitcnt vmcnt(0)" ::: "memory");
        } else {
            XB_SPIN(xb_ld(&bar[XB_XGEN(b.x)]) == gen, bar);
            __builtin_amdgcn_fence(__ATOMIC_ACQUIRE, "agent");
            asm volatile("s_waitcnt vmcnt(0)" ::: "memory");
        }
    }
    __syncthreads();
}
constexpr int LDS_BYTES = 147456;
#define GEMM_PHASE(EPI, g, E) do { pg8::StaticOrder S_; S_.init((g).M, (g).N, G, (int)blockIdx.x); pg8::gemm_phase<EPI, pg8::StaticOrder, true, true>(lds, (g), S_, (E)); } while (0)
__global__ void __launch_bounds__(512, 2) mega_fwd(Params p) {
    extern __shared__ __attribute__((aligned(16))) unsigned char lds_raw[];
    LAS unsigned char* lds = (LAS unsigned char*)lds_raw;
    cg::grid_group grid = cg::this_grid();
    const int G = gridDim.x, bx = blockIdx.x, NGW = G * 8;
#define PH_BEGIN int tid = threadIdx.x; asm volatile("" : "+v"(tid)); const int lane = tid & 63, wid = __builtin_amdgcn_readfirstlane(tid >> 6), gw = bx * 8 + wid; size_t wso_ = 0; asm volatile("" : "+s"(wso_)); unsigned char* ws = p.ws + wso_; (void)lane; (void)gw; (void)ws;
#define WIN ((bf16_t*)(ws + WS_WIN))
#define WMEM ((bf16_t*)(ws + WS_WMEM))
#define WBR ((bf16_t*)(ws + WS_WBR))
#define WOUT ((bf16_t*)(ws + WS_WOUT))
#define WGU ((bf16_t*)(ws + WS_WGU))
#define WDN ((bf16_t*)(ws + WS_WDN))
#define MEMN ((bf16_t*)(ws + WS_MEMN))
#define MKV ((bf16_t*)(ws + WS_MKV))
#define MKN ((bf16_t*)(ws + WS_MKN))
#define MVT ((bf16_t*)(ws + WS_MVT))
#define CUMF ((float*)(ws + WS_CUMF))
#define DEC ((float*)(ws + WS_DEC))
#define VTF ((bf16_t*)(ws + WS_VTF))
#define SIN ((bf16_t*)(ws + WS_SIN))
#define CS ((float*)(ws + WS_CS))
#define MRG ((bf16_t*)((unsigned char*)p.out + (size_t)32 * 1048576))
#define XBF ((bf16_t*)(ws + WS_XBF))
#define KC ((bf16_t*)p.out)
#define SSQ ((float*)(ws + WS_SSQ))
#define PROJ ((bf16_t*)(ws + WS_PROJ))
#define HB ((bf16_t*)(ws + WS_PROJ))

    volatile LAS unsigned* MISC = (volatile LAS unsigned*)(lds + LDS_BYTES - 64);
    if (threadIdx.x < 16) MISC[threadIdx.x] = 0u;
    __syncthreads();
    const XcdBarrier bar = xcd_barrier_post((unsigned*)(p.ws + WS_BAR), MISC);
#define GSYNC() xcd_barrier(bar)
    { PH_BEGIN
        LAS float* scr = (LAS float*)(lds + wid * 16384);
        constexpr int PER_L = 3456 + 512 + 768 + 512 + 2816 + 1408;
        for (int it = gw; it < NL * PER_L; it += NGW) {
            const int l = it / PER_L; int r = it % PER_L; const int ln = lane & 31;
            if (r < 3456) { const int kb = r / 216, nb = r % 216; transpose_item(p.in[I_WIN] + (size_t)l * 1024 * INW, 1024, INW, p.in[I_GMIX] + l * 1024, WIN + (size_t)l * PW * 1024, scr, kb, nb, lane, inmap(nb * 32 + ln)); continue; } r -= 3456;
            if (r < 512) { const int kb = r / 32, nb = r % 32; transpose_item(p.in[I_WMKV] + (size_t)l * 1024 * 1024, 1024, 1024, p.in[I_GMEM] + l * 1024, WMEM + (size_t)l * 1024 * 1024, scr, kb, nb, lane, nb * 32 + ln); continue; } r -= 512;
            if (r < 768) { const int i = r / 256, r2 = r % 256, kb = r2 / 32, nb = r2 % 32; transpose_item(p.in[I_WBR] + (size_t)(l * 3 + i) * 512 * 1024, 512, 1024, nullptr, WBR + (size_t)(l * 3 + i) * 1024 * 512, scr, kb, nb, lane, nb * 32 + ln); continue; } r -= 768;
            if (r < 512) { const int kb = r / 32, nb = r % 32; transpose_item(p.in[I_WOUT] + (size_t)l * 1024 * 1024, 1024, 1024, nullptr, WOUT + (size_t)l * 1024 * 1024, scr, kb, nb, lane, nb * 32 + ln); continue; } r -= 512;
            if (r < 2816) { const int kb = r / 176, nb = r % 176, n0 = nb * 32, t = n0 >> 8, rr = n0 & 255; const bool isup = rr >= 128;
                transpose_item((isup ? p.in[I_WFU] : p.in[I_WFG]) + (size_t)l * 1024 * DFF, 1024, DFF, p.in[I_GFFN] + l * 1024, WGU + (size_t)l * 5632 * 1024, scr, kb, nb, lane, 128 * t + (rr & 127) + ln); continue; } r -= 2816;
            { const int kb = r / 32, nb = r % 32; transpose_item(p.in[I_WFD] + (size_t)l * DFF * 1024, DFF, 1024, nullptr, WDN + (size_t)l * 1024 * DFF, scr, kb, nb, lane, nb * 32 + ln); }
        }
        norm_rows(p.in[I_MEM], MEMN, 1024, gw, NGW, lane);
        if (bx == 0 && tid < NL) {
            float am = 0.f, cm = 0.f;
            for (int i = 0; i < 128; ++i) { am = fmaxf(am, fabsf(p.in[I_GFQ][tid * 128 + i])); cm = fmaxf(cm, fabsf(p.in[I_GFK][tid * 128 + i])); }
            ((float*)(ws + WS_TSK))[tid] = 104.0f + 2.0f * 11.3137085f * am * cm * 1.01f + 1.0f;
        }
    }
    grid.sync();
    { PH_BEGIN pg8::Gemm g{MEMN, WMEM, 1024, 4096, 1024, 1024}; pg8::EpiStore E{MKV, 4096, nullptr}; GEMM_PHASE(pg8::EpiStore, g, E);
      if (G > 64) { if (bx >= 64) xb_rows(p.in[I_X], XBF, SSQ, 2 * MH, (bx - 64) * 8 + wid, (G - 64) * 8, lane); }
      else xb_rows(p.in[I_X], XBF, SSQ, 2 * MH, gw, NGW, lane); }
    GSYNC();
    { PH_BEGIN for (int u = bx; u < 256; u += G) { const int l = u >> 6, b = (u >> 4) & 3, h = (u >> 2) & 3, t = u & 3;
        const bf16_t* src = MKV + (size_t)(b * 256 + t * 64) * 4096 + l * 1024 + h * 128;
        norm128_rows64(src, 4096, MKN + ((size_t)(l * 4 + b) * 256 + t * 64) * 512 + h * 128, 512, p.in[I_GMK] + l * 128, 1.0f, tid);
        vt_tile(src + 512, 4096, MVT + ((size_t)((l * 4 + b) * 4 + h) * 128) * 256 + t * 64, 256, (LAS bf16_t*)lds, tid); } }
    for (int l = 0; l < NL; ++l) {
        for (int hf = 0; hf < 2; ++hf) {
            { PH_BEGIN pg8::Gemm g{XBF + (size_t)hf * MH * 1024, WIN + (size_t)l * PW * 1024, MH, PW, 1024, 1024}; pg8::EpiStore E{PROJ, PW, SSQ + (size_t)hf * MH * 16}; GEMM_PHASE(pg8::EpiStore, g, E); }
            GSYNC();
            { PH_BEGIN const int tid0_ = tid;
              for (int u = bx; u < 32; u += G) { int tid = tid0_; asm volatile("" : "+v"(tid)); const int lane = tid & 63;
                    const int bhp = u >> 2, sg = u & 3, bp = bhp >> 2, h = bhp & 3; const float fb = p.in[I_BFOX][l * 4 + h];
                    float loc[4]; float run = 0.f;
#pragma unroll
                    for (int i = 0; i < 4; ++i) { const float x = bf2f(PROJ[(size_t)(bp * SEQ + sg * 2048 + 4 * tid + i) * PW + C_FF + h]) + fb; run += log_sigmoid_(x); loc[i] = run; }
                    float sc = run;
#pragma unroll
                    for (int o = 1; o < 64; o <<= 1) { const float t = __shfl_up(sc, o); if (lane >= o) sc += t; }
                    LAS float* wt = (LAS float*)lds;
                    if (lane == 63) wt[wid] = sc;
                    __syncthreads();
                    float offs = sc - run;
                    for (int w = 0; w < wid; ++w) offs += wt[w];
                    *(f32x4*)(CUMF + (size_t)bhp * SEQ + sg * 2048 + 4 * tid) = (f32x4){loc[0] + offs, loc[1] + offs, loc[2] + offs, loc[3] + offs};
                    if (tid == 511) ((float*)(ws + WS_TSK))[16 + u] = loc[3] + offs;
                    __syncthreads();
              }
              for (int v0 = bx; v0 < 1024; v0 += 4 * G) { int tid = tid0_; asm volatile("" : "+v"(tid)); prep_batch(PROJ, p.in[I_GFK] + l * 128, KC, VTF, (LAS bf16_t*)lds, v0, G, tid); }
              for (int u = bx; u < 1024; u += 2 * G) { int tid = tid0_; asm volatile("" : "+v"(tid)); const int lane = tid & 63; gla_pair<false>(lds, p, l, u, (u + G < 1024 ? u + G : u), PROJ, CS, DEC, SIN, PROJ, tid, lane, wid); }
              for (int v = bx; v < 256; v += G) { int tid = tid0_; asm volatile("" : "+v"(tid)); const int lane = tid & 63;
                    const int rb = v >> 2, h = v & 3, r0 = rb * 256, bp = r0 / SEQ, b = hf * 2 + bp;
                    attn_unit<false>(lds, p.in[I_GMQ] + l * 128, PROJ + (size_t)r0 * PW + C_MQ + h * 128, PW, MKN + ((size_t)(l * 4 + b) * 256) * 512 + h * 128, 512,
                                     MVT + ((size_t)((l * 4 + b) * 4 + h) * 128) * 256, 256, 64, nullptr, 0.f, 0.f, 0.f, 0.f, 0, 0, 3, PROJ + (size_t)r0 * PW + C_MQ + h * 128, PW, tid, lane, wid);
              }
            }
            GSYNC();
            { PH_BEGIN
                for (int u = bx; u < 512; u += G) {
                    typedef float f32x2v __attribute__((ext_vector_type(2)));
                    const int e2 = u * 64 + lane, bhp = e2 >> 12, dvdk = (e2 & 4095) * 2, dk = dvdk & 63, seg = wid;
                    f32x2v c[16], d[16];
#pragma unroll
                    for (int i = 0; i < 16; ++i) { const size_t unit = (size_t)bhp * 128 + seg * 16 + i; c[i] = *(const f32x2v*)(CS + unit * 8192 + dvdk); d[i] = *(const f32x2v*)(DEC + unit * 64 + dk); }
                    f32x2v sl[16], pl[16]; f32x2v sacc = (f32x2v){0.f, 0.f}, pacc = (f32x2v){1.f, 1.f};
#pragma unroll
                    for (int i = 0; i < 16; ++i) { sl[i] = sacc; pl[i] = pacc; sacc = d[i] * sacc + c[i]; pacc = pacc * d[i]; }
                    LAS f32x4* AB = (LAS f32x4*)lds;
                    AB[seg * 64 + lane] = (f32x4){pacc.x, pacc.y, sacc.x, sacc.y};
                    __syncthreads();
                    f32x2v s0 = (f32x2v){0.f, 0.f};
                    for (int j = 0; j < seg; ++j) { const f32x4 ab = AB[j * 64 + lane]; s0 = (f32x2v){ab[0] * s0.x + ab[2], ab[1] * s0.y + ab[3]}; }
#pragma unroll
                    for (int i = 0; i < 16; ++i) { const size_t unit = (size_t)bhp * 128 + seg * 16 + i; const f32x2v v = sl[i] + pl[i] * s0;
                        *(unsigned*)(SIN + unit * 8192 + dvdk) = cvt_pk_bf16(v.x, v.y); }
                    __syncthreads();
                }
                const int nf = G, fidx = bx;
                const int tid0_ = tid; if (fidx >= 0) for (int u = fidx; u < 256; u += nf) { int tid = tid0_; asm volatile("" : "+v"(tid)); const int lane = tid & 63;
                    const int qb = 31 - (u >> 3), bhp = u & 7, bp = bhp >> 2, h = bhp & 3, q0 = qb * 256; const size_t r0 = (size_t)bp * SEQ + q0;
                    const float* cum = CUMF + (size_t)bhp * SEQ; const float* sgt = (const float*)(ws + WS_TSK) + 16 + bhp * 4;
                    const float o1 = sgt[0], o2 = o1 + sgt[1], o3 = o2 + sgt[2];
                    const int sq_ = q0 >> 11; const float cref = cum[q0] + (sq_ == 0 ? 0.f : sq_ == 1 ? o1 : sq_ == 2 ? o2 : o3);
                    int j0 = 0;
#if FOX_SKIP
                    {
                        const float T = ((const float*)(ws + WS_TSK))[l];
                        const int nt = q0 >> 6;
                        int cnt = 0;
                        if (tid < nt) { const int sk_ = tid >> 5; cnt = (cref - (cum[64 * tid + 63] + (sk_ == 0 ? 0.f : sk_ == 1 ? o1 : sk_ == 2 ? o2 : o3)) < -T) ? 1 : 0; }
                        const unsigned long long bal = __ballot(cnt);
                        LAS int* red = (LAS int*)(lds + 73728);
                        if (lane == 0 && wid < 2) red[wid] = __popcll(bal);
                        __syncthreads();
                        j0 = red[0] + red[1];
                    }
#endif
                    attn_unit<true>(lds, p.in[I_GFQ] + l * 128, PROJ + r0 * PW + C_FQ + h * 128, PW, KC + (size_t)bhp * SEQ * 128, 128, VTF + ((size_t)bhp * 128) * SEQ, 64, 8192,
                                    cum, cref, o1, o2, o3, q0, j0, (q0 >> 6) + 3, PROJ + r0 * PW + C_FQ + h * 128, PW, tid, lane, wid);
                }
            }
            GSYNC();
            { PH_BEGIN const int tid0_ = tid; for (int u = bx; u < 1024; u += 2 * G) { int tid = tid0_; asm volatile("" : "+v"(tid)); const int lane = tid & 63; gla_pair<true>(lds, p, l, u, (u + G < 1024 ? u + G : u), PROJ, CS, DEC, SIN, PROJ, tid, lane, wid); } }
            GSYNC();
            { PH_BEGIN
                pg8::Gemm g{PROJ, WBR + (size_t)l * 3 * 1024 * 512, MH, 3072, 512, PW};
                pg8::EpiGate E{PROJ + C_BG, PW, p.in[I_BGATE] + l * 3072, MRG + (size_t)hf * MH * 1024, 1024};
                pg8::BranchOrder S_; S_.init(MH, G, (int)blockIdx.x); static_assert(C_GV * 2 == 1024 && C_FQ * 2 == 3072 && C_MQ * 2 == 6144, "BranchOrder offsets"); pg8::gemm_phase<pg8::EpiGate, pg8::BranchOrder, true, true>(lds, g, S_, E);
            }
            GSYNC();
        }
        { PH_BEGIN pg8::Gemm g{MRG, WOUT + (size_t)l * 1024 * 1024, 2 * MH, 1024, 1024, 1024}; pg8::EpiResid E{nullptr, XBF, SSQ}; GEMM_PHASE(pg8::EpiResid, g, E); }
        GSYNC();
        { PH_BEGIN pg8::Gemm g{XBF, WGU + (size_t)l * 5632 * 1024, 2 * MH, 5632, 1024, 1024}; pg8::EpiSwiglu E{HB, DFF, SSQ}; GEMM_PHASE(pg8::EpiSwiglu, g, E); }
        GSYNC();
        { PH_BEGIN pg8::Gemm g{HB, WDN + (size_t)l * 1024 * DFF, 2 * MH, 1024, DFF, DFF}; pg8::EpiResid E{l == NL - 1 ? p.out : nullptr, XBF, SSQ}; GEMM_PHASE(pg8::EpiResid, g, E); }
        GSYNC();
    }
}

extern "C" void kernel_launch(void* const* d_in, const int* in_sizes, int n_in, void* d_out, int out_size, void* d_ws, size_t ws_size, hipStream_t stream) {
    static int grid = 0;
    if (grid == 0) {
        int dev = 0, cus = 0, per_cu = 0;
        hipGetDevice(&dev); hipDeviceGetAttribute(&cus, hipDeviceAttributeMultiprocessorCount, dev);
        hipFuncSetAttribute((const void*)mega_fwd, hipFuncAttributeMaxDynamicSharedMemorySize, LDS_BYTES);
        hipOccupancyMaxActiveBlocksPerMultiprocessor(&per_cu, (const void*)mega_fwd, 512, LDS_BYTES);
        if (per_cu < 1) { fprintf(stderr, "kernel_launch: occupancy query says %d blocks/CU\n", per_cu); per_cu = 1; }
        grid = cus * 1;
        if (ws_size < WS_END) { fprintf(stderr, "kernel_launch: workspace too small: %zu < %zu\n", ws_size, (size_t)WS_END); grid = -1; }
        (void)hipGetLastError();
    }
    if (grid < 0) return;
    Params p{};
    for (int i = 0; i < 21; ++i) p.in[i] = (const float*)d_in[i];
    p.out = (float*)d_out; p.ws = (unsigned char*)d_ws;
    hipMemsetAsync((unsigned char*)d_ws + WS_BAR, 0, 16384, stream);
    void* args[] = {&p};
    hipError_t e = hipLaunchCooperativeKernel((const void*)mega_fwd, dim3(grid), dim3(512), args, LDS_BYTES, stream);
    if (e != hipSuccess) fprintf(stderr, "cooperative launch failed: %s (grid %d)\n", hipGetErrorString(e), grid);
}
```

```cpp
#include <hip/hip_runtime.h>
#include <hip/hip_cooperative_groups.h>
#include <cstdio>
#include <cstdint>
#include <cmath>
namespace cg = cooperative_groups;
namespace pg8 {
#define PG8_LAS __attribute__((address_space(3)))
typedef unsigned short bf16_t;
typedef short bf16x8 __attribute__((ext_vector_type(8)));
typedef float f32x4 __attribute__((ext_vector_type(4)));
typedef unsigned u32x4 __attribute__((ext_vector_type(4)));
constexpr int BM = 256, BK = 64, HALF = 128, HTB = HALF * BK * 2  , STAGE_BYTES = 8 * HTB, NXCD = 8, WGM = 8;

__host__ __device__ __forceinline__ int lds_byte(int r, int c) { const int st = (r >> 4) * 2 + (c >> 5), rr = r & 15, cc = c & 31, ob = rr * 64 + cc * 2; return st * 1024 + (ob ^ (((ob >> 9) & 1) << 5)); }
__host__ __device__ __forceinline__ void stage_rc(int b, int& R, int& C) { const int st = b / 1024, sb = b % 1024, swz = sb ^ (((sb >> 9) & 1) << 5); R = (st >> 1) * 16 + swz / 64; C = (st & 1) * 32 + (swz % 64) / 2; }
__host__ __device__ __forceinline__ int perm32(int rho) { const int n = rho >> 4, i = rho & 15; return 8 * (i >> 2) + 4 * n + (i & 3); }

struct Unit { int pm, pn, aoff; };
struct Gemm { const bf16_t* A; const bf16_t* Bt; int M, N, K, lda; };

struct StaticOrder {
    int nM, nN, nwg, G, c;
    __host__ __device__ void init(int M, int N, int G_, int c_) { nM = M / BM; nN = N / BM; nwg = nM * nN; G = G_; c = c_; }
    __host__ __device__ bool next(int i, Unit& u) const {
        const long L = (long)i * G + c; if (L >= nwg) return false;
        int wgid = (int)L; { const int q = nwg / NXCD, r = nwg % NXCD, xcd = wgid % NXCD, off = wgid / NXCD; wgid = (xcd < r ? xcd * (q + 1) : r * (q + 1) + (xcd - r) * q) + off; }
        const int nig = WGM * nN, gid = wgid / nig, fm = gid * WGM, gsz = (nM - fm) < WGM ? (nM - fm) : WGM;
        u.pm = fm + ((wgid % nig) % gsz); u.pn = (wgid % nig) / gsz; u.aoff = 0; return true;
    }
    __device__ __forceinline__ void a_ready(const Unit&) const {}
    __device__ __forceinline__ void done(const Unit&) const {}
};
struct BranchOrder {
    StaticOrder S0;
    __host__ __device__ void init(int M, int G_, int c_) { S0.init(M, 1024, G_, c_); }
    __host__ __device__ bool next(int i, Unit& u) const { const int r = i / 3, b = i - 3 * r; if (!S0.next(r, u)) return false; u.pn += 4 * b; u.aoff = 1024 * (1 + 2 * b + (b >> 1)); return true; }
    __device__ __forceinline__ void a_ready(const Unit&) const {}
    __device__ __forceinline__ void done(const Unit&) const {}
};

typedef float cvt_f32x2_t __attribute__((ext_vector_type(2))); typedef __bf16 cvt_bf16x2_t __attribute__((ext_vector_type(2)));
__device__ __forceinline__ unsigned cvt_pk_bf16(float lo, float hi) { const cvt_f32x2_t v = {lo, hi}; const cvt_bf16x2_t b = __builtin_convertvector(v, cvt_bf16x2_t); return __builtin_bit_cast(unsigned, b); }
typedef float f32x2 __attribute__((ext_vector_type(2)));
typedef float f32x2 __attribute__((ext_vector_type(2)));
__device__ __forceinline__ float bf2f(unsigned short b) { return __uint_as_float((unsigned)b << 16); }
__device__ __forceinline__ float bflo(unsigned w) { return __uint_as_float(w << 16); }
__device__ __forceinline__ float bfhi(unsigned w) { return __uint_as_float(w & 0xffff0000u); }
__device__ __forceinline__ float xsum32(float s) { const auto r = __builtin_amdgcn_permlane32_swap(__float_as_uint(s), __float_as_uint(s), false, false); return __uint_as_float(r[0]) + __uint_as_float(r[1]); }
__device__ __forceinline__ float xmax32(float s) { const auto r = __builtin_amdgcn_permlane32_swap(__float_as_uint(s), __float_as_uint(s), false, false); return fmaxf(__uint_as_float(r[0]), __uint_as_float(r[1])); }
__device__ __forceinline__ float xsum16(float s) { const auto r = __builtin_amdgcn_permlane16_swap(__float_as_uint(s), __float_as_uint(s), false, false); return __uint_as_float(r[0]) + __uint_as_float(r[1]); }
__device__ __forceinline__ float sigmoidf_(float x) { return __builtin_amdgcn_rcpf(1.0f + __builtin_amdgcn_exp2f(-1.4426950408889634f * x)); }
__device__ __forceinline__ float row_rs(const float* ssq, size_t row, int fq) {
    const f32x4 q = *(const f32x4*)(ssq + row * 16 + 4 * fq); float s = (q[0] + q[1]) + (q[2] + q[3]);
    s = xsum16(s); s = xsum32(s);
    return __builtin_amdgcn_rsqf(s * (1.0f / 1024.0f) + 1e-6f);
}
struct EpiStore {
    static constexpr bool PERM = true, AFTER_DRAIN = false;
    bf16_t* O; int ldc; const float* ssq;
    __device__ __forceinline__ void operator()(const f32x4 (&acc)[2][2][4][2], const Unit& u, int wr, int wc, int fr, int fq) const {
        const int row0 = u.pm * BM + wr * 64 + fr, col0 = u.pn * BM + wc * 32 + 8 * fq;
#pragma unroll
        for (int ai = 0; ai < 2; ++ai)
#pragma unroll
            for (int m = 0; m < 4; ++m) { const size_t row = (size_t)(row0 + ai * HALF + m * 16); bf16_t* rowp = O + row * ldc + col0;
                const float rs = ssq ? row_rs(ssq, row, fq) : 1.0f;
#pragma unroll
                for (int bj = 0; bj < 2; ++bj) { const f32x4 v0 = acc[ai][bj][m][0] * rs, v1 = acc[ai][bj][m][1] * rs;
                    u32x4 w; w.x = cvt_pk_bf16(v0[0], v0[1]); w.y = cvt_pk_bf16(v0[2], v0[3]); w.z = cvt_pk_bf16(v1[0], v1[1]); w.w = cvt_pk_bf16(v1[2], v1[3]);
                    *(u32x4*)(rowp + bj * HALF) = w; } }
    }
};
struct EpiGate {
    static constexpr bool PERM = true, AFTER_DRAIN = false;
    const bf16_t* G; int ldg; const float* bias; bf16_t* O; int ldc;
    __device__ __forceinline__ void operator()(const f32x4 (&acc)[2][2][4][2], const Unit& u, int wr, int wc, int fr, int fq) const {
        const int row0 = u.pm * BM + wr * 64 + fr, gcol0 = u.pn * BM + wc * 32 + 8 * fq, col0 = (u.pn & 3) * BM + wc * 32 + 8 * fq; const bool first = u.pn < 4;
#pragma unroll
        for (int bj = 0; bj < 2; ++bj) {
            const f32x4 b0 = *(const f32x4*)(bias + gcol0 + bj * HALF), b1 = *(const f32x4*)(bias + gcol0 + bj * HALF + 4);
#pragma unroll
            for (int ai = 0; ai < 2; ++ai)
#pragma unroll
                for (int m = 0; m < 4; ++m) { const size_t r = (size_t)(row0 + ai * HALF + m * 16);
                    const u32x4 gw = *(const u32x4*)(G + r * ldg + gcol0 + bj * HALF);
                    bf16_t* op = O + r * ldc + col0 + bj * HALF;
                    u32x4 pw = (u32x4){0u, 0u, 0u, 0u}; if (!first) pw = *(const u32x4*)op;
                    const f32x4 v0 = acc[ai][bj][m][0], v1 = acc[ai][bj][m][1];
                    float r0 = bflo(pw.x) + sigmoidf_(bflo(gw.x) + b0[0]) * v0[0], r1 = bfhi(pw.x) + sigmoidf_(bfhi(gw.x) + b0[1]) * v0[1];
                    float r2 = bflo(pw.y) + sigmoidf_(bflo(gw.y) + b0[2]) * v0[2], r3 = bfhi(pw.y) + sigmoidf_(bfhi(gw.y) + b0[3]) * v0[3];
                    float r4 = bflo(pw.z) + sigmoidf_(bflo(gw.z) + b1[0]) * v1[0], r5 = bfhi(pw.z) + sigmoidf_(bfhi(gw.z) + b1[1]) * v1[1];
                    float r6 = bflo(pw.w) + sigmoidf_(bflo(gw.w) + b1[2]) * v1[2], r7 = bfhi(pw.w) + sigmoidf_(bfhi(gw.w) + b1[3]) * v1[3];
                    u32x4 w; w.x = cvt_pk_bf16(r0, r1); w.y = cvt_pk_bf16(r2, r3); w.z = cvt_pk_bf16(r4, r5); w.w = cvt_pk_bf16(r6, r7);
                    *(u32x4*)op = w; }
        }
    }
};
struct EpiResid {
    static constexpr bool PERM = true, AFTER_DRAIN = false;
    float* out; bf16_t* xb; float* ssq;
    __device__ __forceinline__ void operator()(const f32x4 (&acc)[2][2][4][2], const Unit& u, int wr, int wc, int fr, int fq) const {
        const int row0 = u.pm * BM + wr * 64 + fr, col0 = u.pn * BM + wc * 32 + 8 * fq;
#pragma unroll
        for (int ai = 0; ai < 2; ++ai)
#pragma unroll
            for (int m = 0; m < 4; ++m) { const size_t row = (size_t)(row0 + ai * HALF + m * 16), off = row * 1024 + col0; float ss = 0.f;
#pragma unroll
                for (int bj = 0; bj < 2; ++bj) {
                    const u32x4 rw = *(const u32x4*)(xb + off + bj * HALF);
                    const f32x4 a = (f32x4){bflo(rw.x), bfhi(rw.x), bflo(rw.y), bfhi(rw.y)} + acc[ai][bj][m][0], b = (f32x4){bflo(rw.z), bfhi(rw.z), bflo(rw.w), bfhi(rw.w)} + acc[ai][bj][m][1];
                    if (out) { *(f32x4*)(out + off + bj * HALF) = a; *(f32x4*)(out + off + bj * HALF + 4) = b; }
                    ss += (a[0] * a[0] + a[1] * a[1]) + (a[2] * a[2] + a[3] * a[3]) + (b[0] * b[0] + b[1] * b[1]) + (b[2] * b[2] + b[3] * b[3]);
                    u32x4 w; w.x = cvt_pk_bf16(a[0], a[1]); w.y = cvt_pk_bf16(a[2], a[3]); w.z = cvt_pk_bf16(b[0], b[1]); w.w = cvt_pk_bf16(b[2], b[3]);
                    *(u32x4*)(xb + off + bj * HALF) = w; }
                ss = xsum16(ss); ss = xsum32(ss);
                if (fq == 0) ssq[row * 16 + u.pn * 4 + wc] = ss; }
    }
};
struct EpiSwiglu {
    static constexpr bool PERM = true, AFTER_DRAIN = false;
    bf16_t* O; int ldc; const float* ssq;
    __device__ __forceinline__ void operator()(const f32x4 (&acc)[2][2][4][2], const Unit& u, int wr, int wc, int fr, int fq) const {
        const int row0 = u.pm * BM + wr * 64 + fr, col0 = u.pn * HALF + wc * 32 + 8 * fq;
#pragma unroll
        for (int ai = 0; ai < 2; ++ai)
#pragma unroll
            for (int m = 0; m < 4; ++m) { float h[8]; const float rs = row_rs(ssq, (size_t)(row0 + ai * HALF + m * 16), fq);
#pragma unroll
                for (int n = 0; n < 2; ++n)
#pragma unroll
                    for (int j = 0; j < 4; ++j) { const float gt = acc[ai][0][m][n][j] * rs, up = acc[ai][1][m][n][j] * rs; h[4 * n + j] = gt * sigmoidf_(gt) * up; }
                u32x4 w; w.x = cvt_pk_bf16(h[0], h[1]); w.y = cvt_pk_bf16(h[2], h[3]); w.z = cvt_pk_bf16(h[4], h[5]); w.w = cvt_pk_bf16(h[6], h[7]);
                *(u32x4*)(O + (size_t)(row0 + ai * HALF + m * 16) * ldc + col0) = w; }
    }
};
template <class Epi, class Sched, bool ALIGN_EPI = false, bool SP2 = false>
__device__ __forceinline__ void gemm_phase(PG8_LAS unsigned char* lds, const Gemm g, const Sched& S, const Epi& E) {
    int tid_ = threadIdx.x; asm volatile("" : "+v"(tid_)); const int tid = tid_, wid = __builtin_amdgcn_readfirstlane(tid >> 6), lane = tid & 63, wr = wid >> 2, wc = wid & 3, fr = lane & 15, fq = lane >> 4;
    const int K = g.K, nt = K / BK;
    unsigned voffA[2], voffB[2];
#pragma unroll
    for (int i = 0; i < 2; ++i) { int R, C; stage_rc(tid * 16 + i * 8192, R, C); const int Rb = Epi::PERM ? ((R & ~31) + perm32(R & 31)) : R;
        voffA[i] = (unsigned)(R * g.lda + C) * 2u; voffB[i] = (unsigned)(Rb * K + C) * 2u; }
    const size_t kstep = (size_t)(BK * 2);
    const size_t hstepA = (size_t)HALF * g.lda * 2, hstepB = (size_t)HALF * K * 2;
    const size_t tstepA = 2 * hstepA, tstepB = 2 * hstepB;
    const unsigned ldsw = (unsigned)wid * 1024u;
    const int aoff = lds_byte(wr * 64 + fr, fq * 8), boff = lds_byte(wc * 32 + fr, fq * 8);
#define PG8_SA(b, h) (((b) * 2 + (h)) * HTB)
#define PG8_SB(b, h) ((4 + (b) * 2 + (h)) * HTB)
#define PG8_STAGE(bufoff, gbase, voff) do { _Pragma("unroll") for (int _i = 0; _i < 2; ++_i) \
        __builtin_amdgcn_global_load_lds((const unsigned*)((const char*)(gbase) + (voff)[_i]), (PG8_LAS unsigned*)(lds + (bufoff) + ldsw + _i * 8192), 16, 0, 0); } while (0)
#define PG8_LDA(dst, b, h) do { _Pragma("unroll") for (int m = 0; m < 4; ++m) _Pragma("unroll") for (int k = 0; k < 2; ++k) dst[m][k] = *(const PG8_LAS bf16x8*)(lds + PG8_SA(b, h) + aoff + m * 2048 + k * 1024); } while (0)
#define PG8_LDB(dst, b, h) do { _Pragma("unroll") for (int n = 0; n < 2; ++n) _Pragma("unroll") for (int k = 0; k < 2; ++k) dst[n][k] = *(const PG8_LAS bf16x8*)(lds + PG8_SB(b, h) + boff + n * 2048 + k * 1024); } while (0)
#define PG8_MMA(ai, bj, At, Bt) do { __builtin_amdgcn_s_setprio(1); _Pragma("unroll") for (int m = 0; m < 4; ++m) _Pragma("unroll") for (int n = 0; n < 2; ++n) _Pragma("unroll") for (int k = 0; k < 2; ++k) \
        acc[ai][bj][m][n] = __builtin_amdgcn_mfma_f32_16x16x32_bf16(Bt[n][k], At[m][k], acc[ai][bj][m][n], 0, 0, 0); __builtin_amdgcn_s_setprio(0); } while (0)
#define PG8_WAIT_V(n) asm volatile("s_waitcnt vmcnt(" #n ")" ::: "memory")
#define PG8_WAIT_L(n) asm volatile("s_waitcnt lgkmcnt(" #n ")" ::: "memory")
#define PG8_BAR __builtin_amdgcn_s_barrier()
#define PG8_SCHED __builtin_amdgcn_sched_barrier(0)
    Unit cur, nxt; int ui = 0;
    if (!S.next(0, cur)) return;
    f32x4 acc[2][2][4][2];
#pragma unroll
    for (int a = 0; a < 2; ++a)
#pragma unroll
        for (int b = 0; b < 2; ++b)
#pragma unroll
            for (int m = 0; m < 4; ++m)
#pragma unroll
                for (int n = 0; n < 2; ++n) acc[a][b][m][n] = (f32x4){0.f, 0.f, 0.f, 0.f};
    bf16x8 At[4][2], B0[2][2], B1[2][2];
    const char* cA = (const char*)g.A + (size_t)cur.pm * tstepA + cur.aoff; const char* cB = (const char*)g.Bt + (size_t)cur.pn * tstepB;
    S.a_ready(cur);
    if constexpr (SP2) {
        PG8_STAGE(PG8_SB(0, 0), cB, voffB); PG8_STAGE(PG8_SB(0, 1), cB + hstepB, voffB); PG8_STAGE(PG8_SA(0, 0), cA, voffA); PG8_STAGE(PG8_SA(0, 1), cA + hstepA, voffA);
        if (wr == 1) PG8_BAR;
        PG8_WAIT_V(2); PG8_BAR;
        PG8_STAGE(PG8_SB(1, 0), cB + kstep, voffB); PG8_STAGE(PG8_SA(1, 0), cA + kstep, voffA); PG8_STAGE(PG8_SB(1, 1), cB + hstepB + kstep, voffB);
        PG8_WAIT_V(6); PG8_BAR;
    } else {
        PG8_STAGE(PG8_SB(0, 0), cB, voffB); PG8_STAGE(PG8_SA(0, 0), cA, voffA); PG8_STAGE(PG8_SB(0, 1), cB + hstepB, voffB); PG8_STAGE(PG8_SA(0, 1), cA + hstepA, voffA);
        if (wr == 1) PG8_BAR;
        PG8_WAIT_V(4); PG8_BAR;
        PG8_STAGE(PG8_SB(1, 0), cB + kstep, voffB); PG8_STAGE(PG8_SA(1, 0), cA + kstep, voffA); PG8_STAGE(PG8_SB(1, 1), cB + hstepB + kstep, voffB);
        PG8_WAIT_V(6); PG8_BAR;
    }
    for (;;) {
        const bool has_next = S.next(ui + 1, nxt);
        const char* nA = has_next ? (const char*)g.A + (size_t)nxt.pm * tstepA + nxt.aoff : cA; const char* nB = has_next ? (const char*)g.Bt + (size_t)nxt.pn * tstepB : cB;
        for (int t = 0; t < nt; t += 2) {
            const bool last = (t == nt - 2);
            const char* a1 = cA + (size_t)(t + 1) * kstep;
            const char* a2 = last ? nA : cA + (size_t)(t + 2) * kstep; const char* b2 = last ? nB : cB + (size_t)(t + 2) * kstep;
            const char* a3 = a2 + kstep; const char* b3 = b2 + kstep;
            if (last && has_next) S.a_ready(nxt);
            if constexpr (SP2) {
            PG8_LDB(B0, 0, 0); PG8_LDB(B1, 0, 1); PG8_SCHED; PG8_LDA(At, 0, 0); PG8_STAGE(PG8_SA(1, 1), a1 + hstepA, voffA);
            PG8_WAIT_V(8); PG8_WAIT_L(0); PG8_BAR; PG8_MMA(0, 0, At, B0); PG8_MMA(0, 1, At, B1); PG8_BAR; PG8_SCHED;
            PG8_LDA(At, 0, 1); PG8_STAGE(PG8_SB(0, 0), b2, voffB); PG8_STAGE(PG8_SB(0, 1), b2 + hstepB, voffB); PG8_STAGE(PG8_SA(0, 0), a2, voffA);
            PG8_WAIT_V(8); PG8_WAIT_L(0); PG8_BAR; PG8_MMA(1, 0, At, B0); PG8_MMA(1, 1, At, B1); PG8_BAR; PG8_SCHED;
            PG8_LDB(B0, 1, 0); PG8_LDB(B1, 1, 1); PG8_SCHED; PG8_LDA(At, 1, 0); PG8_STAGE(PG8_SA(0, 1), a2 + hstepA, voffA);
            PG8_WAIT_V(8); PG8_WAIT_L(0); PG8_BAR; PG8_MMA(0, 0, At, B0); PG8_MMA(0, 1, At, B1); PG8_BAR; PG8_SCHED;
            PG8_LDA(At, 1, 1); PG8_STAGE(PG8_SB(1, 0), b3, voffB); PG8_STAGE(PG8_SB(1, 1), b3 + hstepB, voffB); PG8_STAGE(PG8_SA(1, 0), a3, voffA);
            PG8_WAIT_V(8); PG8_WAIT_L(0); PG8_BAR; PG8_MMA(1, 0, At, B0); PG8_MMA(1, 1, At, B1); PG8_BAR; PG8_SCHED;
            } else {
            PG8_LDB(B0, 0, 0); PG8_SCHED; PG8_LDA(At, 0, 0); PG8_STAGE(PG8_SA(1, 1), a1 + hstepA, voffA);
            PG8_WAIT_L(8); PG8_BAR; PG8_WAIT_L(0); PG8_MMA(0, 0, At, B0); PG8_BAR; PG8_SCHED;
            PG8_LDB(B1, 0, 1); PG8_STAGE(PG8_SB(0, 0), b2, voffB);
            PG8_BAR; PG8_WAIT_L(0); PG8_MMA(0, 1, At, B1); PG8_BAR;
            PG8_LDA(At, 0, 1); PG8_STAGE(PG8_SA(0, 0), a2, voffA);
            PG8_BAR; PG8_WAIT_L(0); PG8_MMA(1, 0, At, B0); PG8_BAR; PG8_SCHED;
            PG8_STAGE(PG8_SB(0, 1), b2 + hstepB, voffB);
            PG8_WAIT_V(6); PG8_BAR; PG8_MMA(1, 1, At, B1); PG8_BAR;
            PG8_LDB(B0, 1, 0); PG8_SCHED; PG8_LDA(At, 1, 0); PG8_STAGE(PG8_SA(0, 1), a2 + hstepA, voffA);
            PG8_WAIT_L(8); PG8_BAR; PG8_WAIT_L(0); PG8_MMA(0, 0, At, B0); PG8_BAR; PG8_SCHED;
            PG8_LDB(B1, 1, 1); PG8_STAGE(PG8_SB(1, 0), b3, voffB);
            PG8_BAR; PG8_WAIT_L(0); PG8_MMA(0, 1, At, B1); PG8_BAR;
            PG8_LDA(At, 1, 1); PG8_STAGE(PG8_SA(1, 0), a3, voffA);
            PG8_BAR; PG8_WAIT_L(0); PG8_MMA(1, 0, At, B0); PG8_BAR; PG8_SCHED;
            PG8_STAGE(PG8_SB(1, 1), b3 + hstepB, voffB);
            PG8_WAIT_V(6); PG8_BAR; PG8_MMA(1, 1, At, B1); PG8_BAR;
            }
        }
        if constexpr (ALIGN_EPI) { if (wr == 0) PG8_BAR; }
        if constexpr (!Epi::AFTER_DRAIN) { E(acc, cur, wr, wc, fr, fq); S.done(cur); }
        if (!has_next) break;
#pragma unroll
        for (int a = 0; a < 2; ++a)
#pragma unroll
            for (int b = 0; b < 2; ++b)
#pragma unroll
                for (int m = 0; m < 4; ++m)
#pragma unroll
                    for (int n = 0; n < 2; ++n) acc[a][b][m][n] = (f32x4){0.f, 0.f, 0.f, 0.f};
        cur = nxt; cA = nA; cB = nB; ++ui;
        if constexpr (ALIGN_EPI) { if (wr == 1) PG8_BAR; }
    }
    PG8_WAIT_V(0);
    if constexpr (!ALIGN_EPI) { if (wr == 0) PG8_BAR; }
    PG8_BAR;
    if constexpr (Epi::AFTER_DRAIN) { E.fused(acc, cur, wr, wc, fr, fq, lds, wid, lane); S.done(cur); }
#undef PG8_SA
#undef PG8_SB
#undef PG8_STAGE
#undef PG8_LDA
#undef PG8_LDB
#undef PG8_MMA
#undef PG8_WAIT_V
#undef PG8_WAIT_L
#undef PG8_BAR
#undef PG8_SCHED
}
}

#define LAS __attribute__((address_space(3)))
typedef unsigned short bf16_t;
typedef short bf16x8 __attribute__((ext_vector_type(8)));
typedef short s16x4 __attribute__((ext_vector_type(4)));
typedef float f32x4 __attribute__((ext_vector_type(4)));
typedef float f32x16 __attribute__((ext_vector_type(16)));
typedef unsigned u32x4 __attribute__((ext_vector_type(4)));
typedef unsigned u32x2 __attribute__((ext_vector_type(2)));
using pg8::cvt_pk_bf16; using pg8::bf2f; using pg8::bflo; using pg8::bfhi; using pg8::sigmoidf_;

constexpr int SEQ = 8192, DM = 1024, NL = 4, MH = 16384, PW = 6912, DFF = 2816, INW = 6676, YW = 1536;
constexpr int C_GQ = 0, C_GK = 256, C_GV = 512, C_GG = 1024, C_FQ = 1536, C_FK = 2048, C_FV = 2560, C_MQ = 3072, C_BG = 3584, C_GA1 = 6656, C_FF = 6672;
constexpr float EPSN = 1e-6f, LOG2E = 1.4426950408889634f;
#ifndef FOX_SKIP
#define FOX_SKIP 1
#endif
constexpr size_t WS_WIN = 0, WS_WMEM = WS_WIN + (size_t)NL * PW * 1024 * 2, WS_WBR = WS_WMEM + (size_t)4096 * 1024 * 2, WS_WOUT = WS_WBR + (size_t)NL * 3 * 1024 * 512 * 2,
    WS_WGU = WS_WOUT + (size_t)NL * 1024 * 1024 * 2, WS_WDN = WS_WGU + (size_t)NL * 5632 * 1024 * 2,
    WS_MKN = WS_WDN + (size_t)NL * 1024 * DFF * 2, WS_MVT = WS_MKN + (size_t)NL * 1024 * 512 * 2, WS_CUMF = WS_MVT + (size_t)NL * 16 * 128 * 256 * 2, WS_DEC = WS_CUMF + (size_t)8 * SEQ * 4,
    WS_VTF = WS_DEC + (size_t)1024 * 64 * 4, WS_SIN = WS_VTF + (size_t)8 * 128 * SEQ * 2, WS_CS = WS_SIN + (size_t)1024 * 128 * 64 * 2, WS_XBF = WS_CS + (size_t)1024 * 128 * 64 * 4,
    WS_PROJ = WS_XBF + (size_t)2 * MH * 1024 * 2, WS_TSK = WS_PROJ + (size_t)MH * PW * 2, WS_BAR = WS_TSK + 256, WS_SSQ = WS_BAR + 16384, WS_MKV = WS_SSQ + (size_t)2 * MH * 16 * 4, WS_END = WS_MKV + (size_t)1024 * 4096 * 2;
constexpr size_t WS_MEMN = WS_PROJ;
static_assert((size_t)2 * MH * DFF * 2 <= (size_t)MH * PW * 2, "full-batch FFN hidden overlays PROJ");
static_assert(WS_END <= (size_t)536870912, "workspace map exceeds 512 MiB");
static_assert((size_t)MH * 1024 * 2 <= (size_t)1024 * 128 * 64 * 4, "MRG overlays CS");

struct Params { const float* in[21]; float* out; unsigned char* ws; };
enum { I_X = 0, I_MEM, I_GMIX, I_WIN, I_WA2, I_BA, I_GGLA, I_BFOX, I_GFQ, I_GFK, I_GMEM, I_WMKV, I_GMQ, I_GMK, I_BGATE, I_WBR, I_WOUT, I_GFFN, I_WFG, I_WFU, I_WFD };

__device__ __forceinline__ float wave_sum(float v) {
#pragma unroll
    for (int o = 1; o < 64; o <<= 1) v += __shfl_xor(v, o);
    return v;
}
__device__ __forceinline__ float log_sigmoid_(float x) { return fminf(x, 0.f) - __logf(1.0f + __expf(-fabsf(x))); }
#define LDS_WAIT() asm volatile("s_waitcnt lgkmcnt(0)" ::: "memory")

__device__ __forceinline__ int inmap(int n) { if (n < 1536) return n; if (n < 3072) return n + 16; if (n < 6656) return n + 20; if (n < 6672) return 1536 + (n - 6656); if (n < 6676) return 3088 + (n - 6672); return -1; }

__device__ __forceinline__ void transpose_item(const float* W, int K, int Ns, const float* gain, bf16_t* WT, LAS float* scr, int kb, int nb, int lane, int sc) {
    const int k0 = 64 * kb, n0 = 32 * nb, c = lane & 7;
    float v[32];
    const float* wp = W + (size_t)(k0 + (lane >> 5)) * Ns + (sc >= 0 ? sc : 0);
#pragma unroll
    for (int i = 0; i < 32; ++i) v[i] = wp[(size_t)(2 * i) * Ns];
    f32x4 g0 = (f32x4){1.f, 1.f, 1.f, 1.f}, g1 = g0;
    if (gain) { g0 = *(const f32x4*)(gain + k0 + 8 * c); g1 = *(const f32x4*)(gain + k0 + 8 * c + 4); }
    if (sc < 0) {
#pragma unroll
        for (int i = 0; i < 32; ++i) v[i] = 0.f;
    }
#pragma unroll
    for (int i = 0; i < 32; ++i) scr[(2 * i + (lane >> 5)) * 33 + (lane & 31)] = v[i];
    LDS_WAIT();
#pragma unroll
    for (int j = 0; j < 4; ++j) { const int n = (lane >> 3) + 8 * j; const LAS float* s = scr + (8 * c) * 33 + n;
        u32x4 o; o.x = cvt_pk_bf16(s[0 * 33] * g0[0], s[1 * 33] * g0[1]); o.y = cvt_pk_bf16(s[2 * 33] * g0[2], s[3 * 33] * g0[3]); o.z = cvt_pk_bf16(s[4 * 33] * g1[0], s[5 * 33] * g1[1]); o.w = cvt_pk_bf16(s[6 * 33] * g1[2], s[7 * 33] * g1[3]);
        *(u32x4*)(WT + (size_t)(n0 + n) * K + k0 + 8 * c) = o; }
    LDS_WAIT();
}
__device__ __forceinline__ void norm_rows(const float* X, bf16_t* XN, int nrows, int gw, int NGW, int lane) {
    for (int m = gw; m < nrows; m += NGW) {
        const f32x4* xr = (const f32x4*)(X + (size_t)m * DM) + lane; f32x4 v[4]; float s = 0.f;
#pragma unroll
        for (int j = 0; j < 4; ++j) { v[j] = xr[64 * j]; s += (v[j].x * v[j].x + v[j].y * v[j].y) + (v[j].z * v[j].z + v[j].w * v[j].w); }
        const float r = __builtin_amdgcn_rsqf(wave_sum(s) * (1.0f / DM) + EPSN);
        u32x2* o8 = (u32x2*)(XN + (size_t)m * DM) + lane;
#pragma unroll
        for (int j = 0; j < 4; ++j) { u32x2 w; w.x = cvt_pk_bf16(v[j].x * r, v[j].y * r); w.y = cvt_pk_bf16(v[j].z * r, v[j].w * r); o8[64 * j] = w; }
    }
}
__device__ __forceinline__ void norm128_rows64(const bf16_t* src, size_t spitch, bf16_t* dst, size_t dpitch, const float* gain, float scale, int tid) {
    const int sub = tid & 15; float g[8];
#pragma unroll
    for (int j = 0; j < 8; ++j) g[j] = gain[sub * 8 + j] * scale;
#pragma unroll
    for (int pass = 0; pass < 2; ++pass) { const int row = pass * 32 + (tid >> 4);
        const u32x4 w = *(const u32x4*)(src + (size_t)row * spitch + sub * 8);
        float v[8] = {bflo(w.x), bfhi(w.x), bflo(w.y), bfhi(w.y), bflo(w.z), bfhi(w.z), bflo(w.w), bfhi(w.w)};
        float ss = 0.f;
#pragma unroll
        for (int j = 0; j < 8; ++j) ss += v[j] * v[j];
        ss += __shfl_xor(ss, 1); ss += __shfl_xor(ss, 2); ss += __shfl_xor(ss, 4); ss += __shfl_xor(ss, 8);
        const float r = __builtin_amdgcn_rsqf(ss * (1.0f / 128.0f) + EPSN);
        u32x4 o; o.x = cvt_pk_bf16(v[0] * r * g[0], v[1] * r * g[1]); o.y = cvt_pk_bf16(v[2] * r * g[2], v[3] * r * g[3]); o.z = cvt_pk_bf16(v[4] * r * g[4], v[5] * r * g[5]); o.w = cvt_pk_bf16(v[6] * r * g[6], v[7] * r * g[7]);
        *(u32x4*)(dst + (size_t)row * dpitch + sub * 8) = o; }
}
__device__ __forceinline__ void vt_tile(const bf16_t* src, size_t spitch, bf16_t* dst, size_t dpitch, LAS bf16_t* T, int tid) {
#pragma unroll
    for (int i = 0; i < 2; ++i) { const int c = tid + 512 * i, row = c >> 4, part = c & 15; const u32x4 w = *(const u32x4*)(src + (size_t)row * spitch + part * 8); *(LAS u32x4*)(T + row * 136 + part * 8) = w; }
    __syncthreads();
    const int d = tid & 127, part = tid >> 7; unsigned v[16];
#pragma unroll
    for (int i = 0; i < 16; ++i) v[i] = T[(16 * part + i) * 136 + d];
    u32x4 w0, w1; w0.x = v[0] | (v[1] << 16); w0.y = v[2] | (v[3] << 16); w0.z = v[4] | (v[5] << 16); w0.w = v[6] | (v[7] << 16);
    w1.x = v[8] | (v[9] << 16); w1.y = v[10] | (v[11] << 16); w1.z = v[12] | (v[13] << 16); w1.w = v[14] | (v[15] << 16);
    *(u32x4*)(dst + (size_t)d * dpitch + 16 * part) = w0; *(u32x4*)(dst + (size_t)d * dpitch + 16 * part + 8) = w1;
    __syncthreads();
}
__device__ __forceinline__ void prep_batch(const bf16_t* PROJp, const float* gk, bf16_t* KCp, bf16_t* VTFp, LAS bf16_t* T, int v0, int vs, int tid) {
    const int sub = tid & 15, row = tid >> 4;
    u32x4 w[4][2], vw[4][2];
#pragma unroll
    for (int q = 0; q < 4; ++q) { const int v = v0 + q * vs; if (v < 1024) { const int r0 = (v >> 2) * 64, h = v & 3; const bf16_t* rowp = PROJp + (size_t)r0 * PW;
#pragma unroll
        for (int ps = 0; ps < 2; ++ps) w[q][ps] = *(const u32x4*)(rowp + (size_t)(ps * 32 + row) * PW + C_FK + h * 128 + sub * 8);
#pragma unroll
        for (int i = 0; i < 2; ++i) { const int c = tid + 512 * i; vw[q][i] = *(const u32x4*)(rowp + (size_t)(c >> 4) * PW + C_FV + h * 128 + (c & 15) * 8); } } }
    float g[8];
#pragma unroll
    for (int j = 0; j < 8; ++j) g[j] = gk[sub * 8 + j];
#pragma unroll
    for (int q = 0; q < 4; ++q) { const int v = v0 + q * vs; if (v < 1024) { const int r0 = (v >> 2) * 64, h = v & 3, bp = r0 / SEQ, s0 = r0 % SEQ;
        bf16_t* kdst = KCp + ((size_t)(bp * 4 + h) * SEQ + s0) * 128;
#pragma unroll
        for (int ps = 0; ps < 2; ++ps) { const u32x4 x = w[q][ps];
            float f[8] = {bflo(x.x), bfhi(x.x), bflo(x.y), bfhi(x.y), bflo(x.z), bfhi(x.z), bflo(x.w), bfhi(x.w)};
            float ss = 0.f;
#pragma unroll
            for (int j = 0; j < 8; ++j) ss += f[j] * f[j];
            ss += __shfl_xor(ss, 1); ss += __shfl_xor(ss, 2); ss += __shfl_xor(ss, 4); ss += __shfl_xor(ss, 8);
            const float r = __builtin_amdgcn_rsqf(ss * (1.0f / 128.0f) + EPSN);
            u32x4 o; o.x = cvt_pk_bf16(f[0] * r * g[0], f[1] * r * g[1]); o.y = cvt_pk_bf16(f[2] * r * g[2], f[3] * r * g[3]); o.z = cvt_pk_bf16(f[4] * r * g[4], f[5] * r * g[5]); o.w = cvt_pk_bf16(f[6] * r * g[6], f[7] * r * g[7]);
            *(u32x4*)(kdst + (ps * 32 + row) * 128 + sub * 8) = o; }
#pragma unroll
        for (int i = 0; i < 2; ++i) { const int c = tid + 512 * i; *(LAS u32x4*)(T + q * 8704 + (c >> 4) * 136 + (c & 15) * 8) = vw[q][i]; } } }
    __syncthreads();
    const int d = tid & 127, part = tid >> 7;
#pragma unroll
    for (int q = 0; q < 4; ++q) { const int v = v0 + q * vs; if (v < 1024) { const int r0 = (v >> 2) * 64, h = v & 3, bp = r0 / SEQ, s0 = r0 % SEQ;
        bf16_t* vtdst = VTFp + ((size_t)(bp * 4 + h) * 128 + (s0 >> 6)) * 8192; unsigned e[16];
#pragma unroll
        for (int i = 0; i < 16; ++i) e[i] = T[q * 8704 + (16 * part + i) * 136 + d];
        u32x4 w0, w1; w0.x = e[0] | (e[1] << 16); w0.y = e[2] | (e[3] << 16); w0.z = e[4] | (e[5] << 16); w0.w = e[6] | (e[7] << 16);
        w1.x = e[8] | (e[9] << 16); w1.y = e[10] | (e[11] << 16); w1.z = e[12] | (e[13] << 16); w1.w = e[14] | (e[15] << 16);
        *(u32x4*)(vtdst + d * 64 + 16 * part) = w0; *(u32x4*)(vtdst + d * 64 + 16 * part + 8) = w1; } }
    __syncthreads();
}
__device__ __forceinline__ void xb_rows(const float* X, bf16_t* XB, float* ssq, int nrows, int gw, int NGW, int lane) {
    for (int m = gw; m < nrows; m += NGW) {
        const f32x4* xr = (const f32x4*)(X + (size_t)m * DM) + lane; f32x4 v[4]; float s = 0.f;
#pragma unroll
        for (int j = 0; j < 4; ++j) { v[j] = xr[64 * j]; s += (v[j].x * v[j].x + v[j].y * v[j].y) + (v[j].z * v[j].z + v[j].w * v[j].w); }
        s = wave_sum(s);
        u32x2* o8 = (u32x2*)(XB + (size_t)m * DM) + lane;
#pragma unroll
        for (int j = 0; j < 4; ++j) { u32x2 w; w.x = cvt_pk_bf16(v[j].x, v[j].y); w.y = cvt_pk_bf16(v[j].z, v[j].w); o8[64 * j] = w; }
        if (lane < 16) ssq[(size_t)m * 16 + lane] = lane == 0 ? s : 0.f;
    }
}
#define MFMA32(a, b, c) __builtin_amdgcn_mfma_f32_32x32x16_bf16((a), (b), (c), 0, 0, 0)
__device__ __forceinline__ bf16x8 pack8(const f32x16& x, int s) {
    u32x4 p; p.x = cvt_pk_bf16(x[8 * s], x[8 * s + 1]); p.y = cvt_pk_bf16(x[8 * s + 2], x[8 * s + 3]); p.z = cvt_pk_bf16(x[8 * s + 4], x[8 * s + 5]); p.w = cvt_pk_bf16(x[8 * s + 6], x[8 * s + 7]);
    return __builtin_bit_cast(bf16x8, p);
}
constexpr int AT_K = 0, AT_V = 34816, AT_B = 71680, AT_Q = 73984;
template <bool FOX>
__device__ __forceinline__ void attn_tile(const LAS unsigned char* Kb, const LAS unsigned char* Vb, const LAS float* bb, const LAS unsigned char* Qw, f32x16 (&o)[4], float& mrun, float& lrun,
                                          int k0, int qw0, int qlane, int r32, int hi, float dcw, float Tskip) {
    if (FOX && k0 > qw0 + 31) return;
    if (FOX && dcw + bb[63] * 0.6931471805599453f < -Tskip) return;
    f32x16 st[2];
#pragma unroll
    for (int kb = 0; kb < 2; ++kb)
#pragma unroll
        for (int r = 0; r < 16; ++r) st[kb][r] = 0.f;
#pragma unroll
    for (int hb = 0; hb < 2; ++hb) {
        bf16x8 qf[4], ka[4][2];
#pragma unroll
        for (int k4 = 0; k4 < 4; ++k4) { const int ks = 4 * hb + k4; qf[k4] = *(const LAS bf16x8*)(Qw + (r32 * 136 + 16 * ks + 8 * hi) * 2);
            ka[k4][0] = *(const LAS bf16x8*)(Kb + (r32 * 136 + 16 * ks + 8 * hi) * 2); ka[k4][1] = *(const LAS bf16x8*)(Kb + ((32 + r32) * 136 + 16 * ks + 8 * hi) * 2); }
        __builtin_amdgcn_sched_barrier(0);
#pragma unroll
        for (int k4 = 0; k4 < 4; ++k4) { st[0] = MFMA32(ka[k4][0], qf[k4], st[0]); st[1] = MFMA32(ka[k4][1], qf[k4], st[1]); }
        __builtin_amdgcn_sched_barrier(0);
    }
    if (FOX) {
#pragma unroll
        for (int kb = 0; kb < 2; ++kb)
#pragma unroll
            for (int g = 0; g < 4; ++g) { const f32x4 bv = *(const LAS f32x4*)(bb + 32 * kb + 8 * g + 4 * hi);
#pragma unroll
                for (int i = 0; i < 4; ++i) st[kb][4 * g + i] += bv[i]; }
        if (k0 + 63 > qw0) {
#pragma unroll
            for (int kb = 0; kb < 2; ++kb)
#pragma unroll
                for (int r = 0; r < 16; ++r) { const int key = k0 + 32 * kb + (r & 3) + 8 * (r >> 2) + 4 * hi; if (key > qlane) st[kb][r] = -INFINITY; }
        }
    }
    float mx = st[0][0];
#pragma unroll
    for (int r = 1; r < 16; ++r) mx = fmaxf(mx, st[0][r]);
#pragma unroll
    for (int r = 0; r < 16; ++r) mx = fmaxf(mx, st[1][r]);
    mx = pg8::xmax32(mx);
    const float mnew = fmaxf(mrun, mx), msafe = (mnew == -INFINITY) ? 0.f : mnew;
    const float alpha = (mrun == -INFINITY) ? 0.f : __builtin_amdgcn_exp2f(mrun - msafe);
    float rs = 0.f;
#pragma unroll
    for (int kb = 0; kb < 2; ++kb)
#pragma unroll
        for (int r = 0; r < 16; ++r) { const float pv = __builtin_amdgcn_exp2f(st[kb][r] - msafe); st[kb][r] = pv; rs += pv; }
    rs = pg8::xsum32(rs);
    lrun = lrun * alpha + rs; mrun = mnew;
#pragma unroll
    for (int i = 0; i < 4; ++i)
#pragma unroll
        for (int r = 0; r < 16; ++r) o[i][r] *= alpha;
    s16x4 vlo[2][4], vhi[2][4];
#define AT_VLD(buf, g) do { _Pragma("unroll") for (int db = 0; db < 4; ++db) { const LAS unsigned char* vp = Vb + ((32 * db + r32) * 72 + 16 * (g) + 4 * hi) * 2; \
        vlo[buf][db] = *(const LAS s16x4*)vp; vhi[buf][db] = *(const LAS s16x4*)(vp + 16); } } while (0)
    AT_VLD(0, 0);
#pragma unroll
    for (int g = 0; g < 4; ++g) {
        __builtin_amdgcn_sched_barrier(0);
        if (g < 3) AT_VLD((g + 1) & 1, g + 1);
        const bf16x8 pf = pack8(st[g >> 1], g & 1);
        __builtin_amdgcn_sched_barrier(0);
#pragma unroll
        for (int db = 0; db < 4; ++db) { const bf16x8 a = __builtin_shufflevector(vlo[g & 1][db], vhi[g & 1][db], 0, 1, 2, 3, 4, 5, 6, 7); o[db] = MFMA32(a, pf, o[db]); }
    }
#undef AT_VLD
}
template <bool FOX>
__device__ __forceinline__ void attn_unit(LAS unsigned char* lds, const float* qgain, const bf16_t* Q, size_t qpitch, const bf16_t* K, size_t kpitch, const bf16_t* VT, size_t vpitch, int vtile,
                                          const float* cum, float cref, float o1, float o2, float o3, float Tskip, int q0, int j0, int j1, bf16_t* O, size_t opitch, int tid, int lane, int wid) {
    const int r32 = lane & 31, hi = lane >> 5, qw0 = q0 + 32 * wid, qlane = qw0 + r32;
    float dcw = 0.f; if (FOX) dcw = cum[qw0] - cum[q0];
    const LAS unsigned char* Qw = lds + AT_Q + wid * (32 * 136 * 2);
    {
        bf16x8 qf[8];
#pragma unroll
        for (int ks = 0; ks < 8; ++ks) qf[ks] = *(const bf16x8*)(Q + (unsigned)((32 * wid + r32) * (int)qpitch + 16 * ks + 8 * hi));
        float ss = 0.f;
#pragma unroll
        for (int ks = 0; ks < 8; ++ks)
#pragma unroll
            for (int j = 0; j < 8; ++j) { const float x = bf2f((unsigned short)qf[ks][j]); ss += x * x; }
        ss = pg8::xsum32(ss);
        const float rq = (__builtin_amdgcn_rsqf(ss * (1.0f / 128.0f) + EPSN)) * (0.08838834764831845f * LOG2E);
#pragma unroll
        for (int ks = 0; ks < 8; ++ks) { const f32x4 ga = *(const f32x4*)(qgain + 16 * ks + 8 * hi), gb = *(const f32x4*)(qgain + 16 * ks + 8 * hi + 4);
            u32x4 w; w.x = cvt_pk_bf16(bf2f((unsigned short)qf[ks][0]) * rq * ga[0], bf2f((unsigned short)qf[ks][1]) * rq * ga[1]);
            w.y = cvt_pk_bf16(bf2f((unsigned short)qf[ks][2]) * rq * ga[2], bf2f((unsigned short)qf[ks][3]) * rq * ga[3]);
            w.z = cvt_pk_bf16(bf2f((unsigned short)qf[ks][4]) * rq * gb[0], bf2f((unsigned short)qf[ks][5]) * rq * gb[1]);
            w.w = cvt_pk_bf16(bf2f((unsigned short)qf[ks][6]) * rq * gb[2], bf2f((unsigned short)qf[ks][7]) * rq * gb[3]);
            *(LAS u32x4*)(lds + AT_Q + wid * (32 * 136 * 2) + (r32 * 136 + 16 * ks + 8 * hi) * 2) = w; }
    }
    f32x16 o[4];
#pragma unroll
    for (int i = 0; i < 4; ++i)
#pragma unroll
        for (int r = 0; r < 16; ++r) o[i][r] = 0.f;
    float mrun = -INFINITY, lrun = 0.f;
    const int kkey0 = tid >> 4, kpart = tid & 15, vd0 = tid >> 3, vpart = tid & 7;
    u32x4 kA[2], vA[2], kB[2], vB[2]; float bA = 0.f, bB = 0.f;
#define AT_LOAD(kr, vr, br, j) do { _Pragma("unroll") for (int i_ = 0; i_ < 2; ++i_) { \
        kr[i_] = *(const u32x4*)(K + (unsigned)((64 * (j) + kkey0 + 32 * i_) * (int)kpitch + kpart * 8)); \
        vr[i_] = *(const u32x4*)(VT + (unsigned)((vd0 + 64 * i_) * (int)vpitch + vtile * (j) + vpart * 8)); } \
        if (FOX) { const int sj_ = (j) >> 5; br = (cref - (cum[64 * (j) + (tid & 63)] + (sj_ == 0 ? 0.f : sj_ == 1 ? o1 : sj_ == 2 ? o2 : o3))) * LOG2E; } } while (0)
#define AT_STORE(kr, vr, br, buf) do { _Pragma("unroll") for (int i_ = 0; i_ < 2; ++i_) { \
        *(LAS u32x4*)(lds + AT_K + (buf) * 17408 + ((kkey0 + 32 * i_) * 136 + kpart * 8) * 2) = kr[i_]; \
        *(LAS u32x4*)(lds + AT_V + (buf) * 18432 + ((vd0 + 64 * i_) * 72 + vpart * 8) * 2) = vr[i_]; } \
        if (FOX && tid < 64) ((LAS float*)(lds + AT_B))[(buf) * 64 + tid] = br; } while (0)
#define AT_TILE(buf, j) attn_tile<FOX>(lds + AT_K + (buf) * 17408, lds + AT_V + (buf) * 18432, (const LAS float*)(lds + AT_B) + (buf) * 64, Qw, o, mrun, lrun, 64 * (j), qw0, qlane, r32, hi, dcw, Tskip)
#define AT_BAR() asm volatile("s_waitcnt lgkmcnt(0)\n\ts_barrier" ::: "memory")
    AT_LOAD(kA, vA, bA, j0);
    AT_LOAD(kB, vB, bB, (j0 + 1 <= j1 ? j0 + 1 : j1));
    AT_STORE(kA, vA, bA, 0);
    AT_BAR();
    for (int j = j0; j <= j1; j += 2) {
        AT_LOAD(kA, vA, bA, (j + 2 <= j1 ? j + 2 : j1));
        __builtin_amdgcn_sched_barrier(0);
        AT_TILE(0, j);
        if (j + 1 <= j1) AT_STORE(kB, vB, bB, 1);
        AT_BAR();
        if (j + 1 > j1) break;
        AT_LOAD(kB, vB, bB, (j + 3 <= j1 ? j + 3 : j1));
        __builtin_amdgcn_sched_barrier(0);
        AT_TILE(1, j + 1);
        if (j + 2 <= j1) AT_STORE(kA, vA, bA, 0);
        AT_BAR();
    }
#undef AT_BAR
#undef AT_LOAD
#undef AT_STORE
#undef AT_TILE
    const float rl = __builtin_amdgcn_rcpf(lrun);
    int lr_ = lane; asm volatile("" : "+v"(lr_));
    bf16_t* orow = O + (unsigned)((32 * wid + (lr_ & 31)) * (int)opitch);
#pragma unroll
    for (int db = 0; db < 4; ++db)
#pragma unroll
        for (int g = 0; g < 4; ++g) { u32x2 w; w.x = cvt_pk_bf16(o[db][4 * g] * rl, o[db][4 * g + 1] * rl); w.y = cvt_pk_bf16(o[db][4 * g + 2] * rl, o[db][4 * g + 3] * rl);
            *(u32x2*)(orow + 32 * db + 8 * g + 4 * (lr_ >> 5)) = w; }
}
constexpr int GL_GA1 = 0, GL_SEG = 4096, GL_SS = 6144, GL_A8 = 8192, GL_KIN = 17408, GL_VT = 26624, GL_SINT = 45056, GL_UOFF = 65536;
template <bool OUTPHASE>
__device__ __forceinline__ void gla_pair(LAS unsigned char* lds0, const Params& p, int l, int unitA, int unitB, const bf16_t* PROJ, float* CS, float* DEC, const bf16_t* SIN, bf16_t* Y, int tid, int lane, int wid) {
    const int r32 = lane & 31, hi = lane >> 5, d = tid & 63, seg = wid;
    int h[2], r0[2], unit[2];
#pragma unroll
    for (int uu = 0; uu < 2; ++uu) { unit[uu] = uu ? unitB : unitA; const int bhp = unit[uu] >> 7, n = unit[uu] & 127; h[uu] = bhp & 3; r0[uu] = (bhp >> 2) * SEQ + n * 64; }
    u32x2 ggw[2][4]; f32x4 ggn[2][4]; float wa[2][16], ba[2], kv[2][8], qv[2][8];
#pragma unroll
    for (int uu = 0; uu < 2; ++uu) { LAS unsigned char* lds = lds0 + uu * GL_UOFF;
        LAS float* GA1 = (LAS float*)(lds + GL_GA1); LAS bf16_t* VTl = (LAS bf16_t*)(lds + GL_VT); LAS bf16_t* SINT = (LAS bf16_t*)(lds + GL_SINT);
        if (tid < 128) { const int row = tid >> 1, hp = tid & 1; const u32x4 w = *(const u32x4*)(PROJ + (size_t)(r0[uu] + row) * PW + C_GA1 + 8 * hp);
            LAS float* gp = GA1 + row * 16 + 8 * hp; gp[0] = bflo(w.x); gp[1] = bfhi(w.x); gp[2] = bflo(w.y); gp[3] = bfhi(w.y); gp[4] = bflo(w.z); gp[5] = bfhi(w.z); gp[6] = bflo(w.w); gp[7] = bfhi(w.w); }
        { const int dv = tid & 127, part = tid >> 7; unsigned v[16];
#pragma unroll
          for (int i = 0; i < 16; ++i) v[i] = PROJ[(size_t)(r0[uu] + 16 * part + i) * PW + C_GV + h[uu] * 128 + dv];
          u32x4 w0, w1; w0.x = v[0] | (v[1] << 16); w0.y = v[2] | (v[3] << 16); w0.z = v[4] | (v[5] << 16); w0.w = v[6] | (v[7] << 16);
          w1.x = v[8] | (v[9] << 16); w1.y = v[10] | (v[11] << 16); w1.z = v[12] | (v[13] << 16); w1.w = v[14] | (v[15] << 16);
          *(LAS u32x4*)(VTl + dv * 72 + 16 * part) = w0; *(LAS u32x4*)(VTl + dv * 72 + 16 * part + 8) = w1; }
        if (OUTPHASE) {
#pragma unroll
            for (int i = 0; i < 2; ++i) { const int c = tid + 512 * i, dv = c >> 3, part = c & 7; *(LAS u32x4*)(SINT + dv * 72 + part * 8) = *(const u32x4*)(SIN + ((size_t)unit[uu] * 128 + dv) * 64 + part * 8); }
            const int dvb_ = wid >> 1, cb_ = wid & 1;
#pragma unroll
            for (int g = 0; g < 4; ++g) { const int d4 = 32 * dvb_ + 8 * g + 4 * hi; ggw[uu][g] = *(const u32x2*)(PROJ + (size_t)(r0[uu] + 32 * cb_ + r32) * PW + C_GG + h[uu] * 128 + d4); ggn[uu][g] = *(const f32x4*)(p.in[I_GGLA] + l * 512 + h[uu] * 128 + d4); }
        }
#pragma unroll
        for (int i = 0; i < 16; ++i) wa[uu][i] = p.in[I_WA2][(size_t)(l * 16 + i) * 256 + h[uu] * 64 + d];
        ba[uu] = p.in[I_BA][l * 256 + h[uu] * 64 + d];
#pragma unroll
        for (int i = 0; i < 8; ++i) { kv[uu][i] = bf2f(PROJ[(size_t)(r0[uu] + 8 * seg + i) * PW + C_GK + h[uu] * 64 + d]); qv[uu][i] = OUTPHASE ? bf2f(PROJ[(size_t)(r0[uu] + 8 * seg + i) * PW + C_GQ + h[uu] * 64 + d]) : 0.f; }
    }
    __syncthreads();
    float cumv[2][8];
#pragma unroll
    for (int uu = 0; uu < 2; ++uu) { LAS unsigned char* lds = lds0 + uu * GL_UOFF; LAS float* GA1 = (LAS float*)(lds + GL_GA1); LAS float* SEG = (LAS float*)(lds + GL_SEG);
        float run = 0.f;
#pragma unroll
        for (int i = 0; i < 8; ++i) { const LAS float* gp = GA1 + (8 * seg + i) * 16; float z = ba[uu];
#pragma unroll
            for (int j = 0; j < 16; ++j) z += gp[j] * wa[uu][j];
            run += log_sigmoid_(z) * (1.0f / 16.0f); cumv[uu][i] = run; }
        SEG[seg * 64 + d] = run; }
    __syncthreads();
#pragma unroll
    for (int uu = 0; uu < 2; ++uu) { LAS unsigned char* lds = lds0 + uu * GL_UOFF; LAS float* SEG = (LAS float*)(lds + GL_SEG); LAS bf16_t* A8 = (LAS bf16_t*)(lds + GL_A8); LAS bf16_t* KIN = (LAS bf16_t*)(lds + GL_KIN);
        float offs = 0.f, total = 0.f;
#pragma unroll
        for (int s = 0; s < 8; ++s) { const float t = SEG[s * 64 + d]; total += t; if (s < seg) offs += t; }
        if (!OUTPHASE) {
            float ko[8];
#pragma unroll
            for (int i = 0; i < 8; ++i) ko[i] = kv[uu][i] * __expf(total - (cumv[uu][i] + offs));
            u32x4 w; w.x = cvt_pk_bf16(ko[0], ko[1]); w.y = cvt_pk_bf16(ko[2], ko[3]); w.z = cvt_pk_bf16(ko[4], ko[5]); w.w = cvt_pk_bf16(ko[6], ko[7]);
            *(LAS u32x4*)(A8 + d * 72 + 8 * seg) = w;
            if (seg == 0) DEC[(size_t)unit[uu] * 64 + d] = __expf(total);
        } else {
#pragma unroll
            for (int i = 0; i < 8; ++i) { const float c = cumv[uu][i] + offs; const int t = 8 * seg + i;
                A8[t * 72 + d] = (bf16_t)(cvt_pk_bf16(qv[uu][i] * 0.125f * __expf(c), 0.f) & 0xffffu);
                KIN[t * 72 + d] = (bf16_t)(cvt_pk_bf16(kv[uu][i] * __expf(-c), 0.f) & 0xffffu); }
        } }
    __syncthreads();
    if (!OUTPHASE) {
        const int dvb = wid >> 1, dkb = wid & 1;
#pragma unroll
        for (int uu = 0; uu < 2; ++uu) { LAS unsigned char* lds = lds0 + uu * GL_UOFF; LAS bf16_t* A8 = (LAS bf16_t*)(lds + GL_A8); LAS bf16_t* VTl = (LAS bf16_t*)(lds + GL_VT);
            f32x16 acc;
#pragma unroll
            for (int r = 0; r < 16; ++r) acc[r] = 0.f;
#pragma unroll
            for (int ks = 0; ks < 4; ++ks) { const bf16x8 a = *(const LAS bf16x8*)(VTl + (32 * dvb + r32) * 72 + 16 * ks + 8 * hi); const bf16x8 b = *(const LAS bf16x8*)(A8 + (32 * dkb + r32) * 72 + 16 * ks + 8 * hi); acc = MFMA32(a, b, acc); }
            float* cs = CS + (size_t)unit[uu] * 8192;
#pragma unroll
            for (int r = 0; r < 16; ++r) cs[(32 * dvb + (r & 3) + 8 * (r >> 2) + 4 * hi) * 64 + 32 * dkb + r32] = acc[r]; }
        __syncthreads();
    } else {
        const int dvb = wid >> 1, cb = wid & 1;
        f32x16 o[2];
#pragma unroll
        for (int uu = 0; uu < 2; ++uu) { LAS unsigned char* lds = lds0 + uu * GL_UOFF; LAS float* SS = (LAS float*)(lds + GL_SS);
            LAS bf16_t* A8 = (LAS bf16_t*)(lds + GL_A8); LAS bf16_t* KIN = (LAS bf16_t*)(lds + GL_KIN); LAS bf16_t* VTl = (LAS bf16_t*)(lds + GL_VT); LAS bf16_t* SINT = (LAS bf16_t*)(lds + GL_SINT);
            f32x16 at[2];
#pragma unroll
            for (int r = 0; r < 16; ++r) { at[0][r] = 0.f; at[1][r] = 0.f; o[uu][r] = 0.f; }
            bf16x8 qb[4];
#pragma unroll
            for (int ks = 0; ks < 4; ++ks) qb[ks] = *(const LAS bf16x8*)(A8 + (32 * cb + r32) * 72 + 16 * ks + 8 * hi);
#pragma unroll
            for (int sb = 0; sb < 2; ++sb) if (sb <= cb) {
#pragma unroll
                for (int ks = 0; ks < 4; ++ks) { const bf16x8 a = *(const LAS bf16x8*)(KIN + (32 * sb + r32) * 72 + 16 * ks + 8 * hi); at[sb] = MFMA32(a, qb[ks], at[sb]); }
                if (sb == cb) {
#pragma unroll
                    for (int r = 0; r < 16; ++r) if ((r & 3) + 8 * (r >> 2) + 4 * hi > r32) at[sb][r] = 0.f;
                }
#pragma unroll
                for (int s = 0; s < 2; ++s) { const bf16x8 pf = pack8(at[sb], s); const LAS bf16_t* vp = VTl + (32 * dvb + r32) * 72 + 32 * sb + 16 * s + 4 * hi;
                    const s16x4 lo = *(const LAS s16x4*)vp, hh = *(const LAS s16x4*)(vp + 8); const bf16x8 a = __builtin_shufflevector(lo, hh, 0, 1, 2, 3, 4, 5, 6, 7);
                    o[uu] = MFMA32(a, pf, o[uu]); }
            }
#pragma unroll
            for (int ks = 0; ks < 4; ++ks) { const bf16x8 a = *(const LAS bf16x8*)(SINT + (32 * dvb + r32) * 72 + 16 * ks + 8 * hi); o[uu] = MFMA32(a, qb[ks], o[uu]); }
            float ss = 0.f;
#pragma unroll
            for (int r = 0; r < 16; ++r) ss += o[uu][r] * o[uu][r];
            ss = pg8::xsum32(ss);
            if (hi == 0) SS[dvb * 64 + 32 * cb + r32] = ss; }
        __syncthreads();
#pragma unroll
        for (int uu = 0; uu < 2; ++uu) { if (uu == 1 && unitB == unitA) break;
            LAS unsigned char* lds = lds0 + uu * GL_UOFF; LAS float* SS = (LAS float*)(lds + GL_SS);
            const int c = 32 * cb + r32;
            const float tot = SS[c] + SS[64 + c] + SS[128 + c] + SS[192 + c];
            const float rn = __builtin_amdgcn_rsqf(tot * (1.0f / 128.0f) + EPSN);
            const size_t row = (size_t)(r0[uu] + c);
#pragma unroll
            for (int g = 0; g < 4; ++g) { const int d4 = 32 * dvb + 8 * g + 4 * hi;
                const u32x2 gw = ggw[uu][g]; const f32x4 gn = ggn[uu][g];
                const float g0 = bflo(gw.x), g1 = bfhi(gw.x), g2 = bflo(gw.y), g3 = bfhi(gw.y);
                u32x2 w; w.x = cvt_pk_bf16(o[uu][4 * g] * rn * gn[0] * g0 * sigmoidf_(g0), o[uu][4 * g + 1] * rn * gn[1] * g1 * sigmoidf_(g1));
                w.y = cvt_pk_bf16(o[uu][4 * g + 2] * rn * gn[2] * g2 * sigmoidf_(g2), o[uu][4 * g + 3] * rn * gn[3] * g3 * sigmoidf_(g3));
                *(u32x2*)(Y + row * PW + C_GV + h[uu] * 128 + d4) = w; } }
        __syncthreads();
    }
}
#define XB_TMO      128
#define XB_XCNT(j)  (256  + 64 * (j))
#define XB_XSUB(j)  (1280 + 64 * (j))
#define XB_XGEN(j)  (2304 + 64 * (j))
#define XB_TOP      3328
#define XB_TOPGEN   3392
#define XCD_BAR_WORDS 3456
#define XB_SPIN_CAP (1u << 18)

__device__ __forceinline__ unsigned xb_ld(unsigned* p)              { return __hip_atomic_load(p, __ATOMIC_RELAXED, __HIP_MEMORY_SCOPE_AGENT); }
__device__ __forceinline__ unsigned xb_add(unsigned* p, unsigned v) { return __hip_atomic_fetch_add(p, v, __ATOMIC_RELAXED, __HIP_MEMORY_SCOPE_AGENT); }
__device__ __forceinline__ unsigned xb_xcc_id() { return (unsigned)__builtin_amdgcn_s_getreg((3 << 11) | 20) & 0xFu; }
#define XB_SPIN(cond, bar) do { unsigned _sp = 0; while (cond) { __builtin_amdgcn_s_sleep(1); \
    if ((++_sp & 255u) == 0u) { if (xb_ld(&(bar)[XB_TMO])) break; if (_sp > XB_SPIN_CAP) { atomicAdd(&(bar)[XB_TMO], 1u); break; } } } } while (0)

struct XcdBarrier {
    unsigned* bar; unsigned x;
    volatile LAS unsigned* st;
};

__device__ __forceinline__ XcdBarrier xcd_barrier_post(unsigned* bar, volatile LAS unsigned* st) {
    XcdBarrier b; b.bar = bar; b.x = xb_xcc_id(); b.st = st;
    if (threadIdx.x == 0) (void)xb_add(&bar[XB_XCNT(b.x)], 1u);
    return b;
}
__device__ __forceinline__ void xcd_barrier_complete(unsigned* bar, unsigned x, unsigned& nloc, unsigned& nx) {
    const unsigned G = gridDim.x * gridDim.y * gridDim.z;
    unsigned sum, cnt, mine, sp = 0u;
    for (;;) {
        sum = 0u; cnt = 0u; mine = 0u;
#pragma unroll
        for (unsigned j = 0; j < 16; ++j) { const unsigned c = xb_ld(&bar[XB_XCNT(j)]); sum += c; cnt += (c > 0u) ? 1u : 0u; mine = (j == x) ? c : mine; }
        if (sum == G) break;
        __builtin_amdgcn_s_sleep(1);
        if ((++sp & 255u) == 0u) { if (xb_ld(&bar[XB_TMO])) break; if (sp > XB_SPIN_CAP) { atomicAdd(&bar[XB_TMO], 1u); break; } }
    }
    nloc = mine > 0u ? mine : 1u; nx = cnt > 0u ? cnt : 1u;
}

__device__ __forceinline__ void xcd_barrier(const XcdBarrier& b) {
    asm volatile("s_waitcnt vmcnt(0)" ::: "memory");
    __syncthreads();
    if (threadIdx.x == 0) {
        unsigned* bar = b.bar;
        __builtin_amdgcn_s_waitcnt(0);
        unsigned nloc = b.st[0], nx = b.st[1];
        if (nloc == 0u) { xcd_barrier_complete(bar, b.x, nloc, nx); b.st[0] = nloc; b.st[1] = nx; }
        const unsigned old = xb_add(&bar[XB_XSUB(b.x)], 1u);
        const unsigned gen = old / nloc;
        if (old + 1u == (gen + 1u) * nloc) {
            __builtin_amdgcn_fence(__ATOMIC_RELEASE, "agent");
            asm volatile("s_waitcnt vmcnt(0)" ::: "memory");
            const unsigned og = xb_add(&bar[XB_TOP], 1u);
            const unsigned tg = og / nx;
            if (og + 1u == (tg + 1u) * nx) xb_add(&bar[XB_TOPGEN], 1u);
            else XB_SPIN(xb_ld(&bar[XB_TOPGEN]) == tg, bar);
            __builtin_amdgcn_fence(__ATOMIC_ACQUIRE, "agent");
            xb_add(&bar[XB_XGEN(b.x)], 1u);
            asm volatile("s_waitcnt vmcnt(0)" ::: "memory");
        } else {
            XB_SPIN(xb_ld(&bar[XB_XGEN(b.x)]) == gen, bar);
            __builtin_amdgcn_fence(__ATOMIC_ACQUIRE, "agent");
            asm volatile("s_waitcnt vmcnt(0)" ::: "memory");
        }
    }
    __syncthreads();
}
constexpr int LDS_BYTES = 147456;
#define GEMM_PHASE(EPI, g, E) do { pg8::StaticOrder S_; S_.init((g).M, (g).N, G, (int)blockIdx.x); pg8::gemm_phase<EPI, pg8::StaticOrder, true, true>(lds, (g), S_, (E)); } while (0)
__global__ void __launch_bounds__(512, 2) mega_fwd(Params p) {
    extern __shared__ __attribute__((aligned(16))) unsigned char lds_raw[];
    LAS unsigned char* lds = (LAS unsigned char*)lds_raw;
    cg::grid_group grid = cg::this_grid();
    const int G = gridDim.x, bx = blockIdx.x, NGW = G * 8;
#define PH_BEGIN int tid = threadIdx.x; asm volatile("" : "+v"(tid)); const int lane = tid & 63, wid = __builtin_amdgcn_readfirstlane(tid >> 6), gw = bx * 8 + wid; size_t wso_ = 0; asm volatile("" : "+s"(wso_)); unsigned char* ws = p.ws + wso_; (void)lane; (void)gw; (void)ws;
#define WIN ((bf16_t*)(ws + WS_WIN))
#define WMEM ((bf16_t*)(ws + WS_WMEM))
#define WBR ((bf16_t*)(ws + WS_WBR))
#define WOUT ((bf16_t*)(ws + WS_WOUT))
#define WGU ((bf16_t*)(ws + WS_WGU))
#define WDN ((bf16_t*)(ws + WS_WDN))
#define MEMN ((bf16_t*)(ws + WS_MEMN))
#define MKV ((bf16_t*)(ws + WS_MKV))
#define MKN ((bf16_t*)(ws + WS_MKN))
#define MVT ((bf16_t*)(ws + WS_MVT))
#define CUMF ((float*)(ws + WS_CUMF))
#define DEC ((float*)(ws + WS_DEC))
#define VTF ((bf16_t*)(ws + WS_VTF))
#define SIN ((bf16_t*)(ws + WS_SIN))
#define CS ((float*)(ws + WS_CS))
#define MRG ((bf16_t*)((unsigned char*)p.out + (size_t)32 * 1048576))
#define XBF ((bf16_t*)(ws + WS_XBF))
#define KC ((bf16_t*)p.out)
#define SSQ ((float*)(ws + WS_SSQ))
#define PROJ ((bf16_t*)(ws + WS_PROJ))
#define HB ((bf16_t*)(ws + WS_PROJ))

    volatile LAS unsigned* MISC = (volatile LAS unsigned*)(lds + LDS_BYTES - 64);
    if (threadIdx.x < 16) MISC[threadIdx.x] = 0u;
    __syncthreads();
    const XcdBarrier bar = xcd_barrier_post((unsigned*)(p.ws + WS_BAR), MISC);
#define GSYNC() xcd_barrier(bar)
    { PH_BEGIN
        LAS float* scr = (LAS float*)(lds + wid * 16384);
        constexpr int PER_L = 3456 + 512 + 768 + 512 + 2816 + 1408;
        for (int it = gw; it < NL * PER_L; it += NGW) {
            const int l = it / PER_L; int r = it % PER_L; const int ln = lane & 31;
            if (r < 3456) { const int kb = r / 216, nb = r % 216; transpose_item(p.in[I_WIN] + (size_t)l * 1024 * INW, 1024, INW, p.in[I_GMIX] + l * 1024, WIN + (size_t)l * PW * 1024, scr, kb, nb, lane, inmap(nb * 32 + ln)); continue; } r -= 3456;
            if (r < 512) { const int kb = r / 32, nb = r % 32; transpose_item(p.in[I_WMKV] + (size_t)l * 1024 * 1024, 1024, 1024, p.in[I_GMEM] + l * 1024, WMEM + (size_t)l * 1024 * 1024, scr, kb, nb, lane, nb * 32 + ln); continue; } r -= 512;
            if (r < 768) { const int i = r / 256, r2 = r % 256, kb = r2 / 32, nb = r2 % 32; transpose_item(p.in[I_WBR] + (size_t)(l * 3 + i) * 512 * 1024, 512, 1024, nullptr, WBR + (size_t)(l * 3 + i) * 1024 * 512, scr, kb, nb, lane, nb * 32 + ln); continue; } r -= 768;
            if (r < 512) { const int kb = r / 32, nb = r % 32; transpose_item(p.in[I_WOUT] + (size_t)l * 1024 * 1024, 1024, 1024, nullptr, WOUT + (size_t)l * 1024 * 1024, scr, kb, nb, lane, nb * 32 + ln); continue; } r -= 512;
            if (r < 2816) { const int kb = r / 176, nb = r % 176, n0 = nb * 32, t = n0 >> 8, rr = n0 & 255; const bool isup = rr >= 128;
                transpose_item((isup ? p.in[I_WFU] : p.in[I_WFG]) + (size_t)l * 1024 * DFF, 1024, DFF, p.in[I_GFFN] + l * 1024, WGU + (size_t)l * 5632 * 1024, scr, kb, nb, lane, 128 * t + (rr & 127) + ln); continue; } r -= 2816;
            { const int kb = r / 32, nb = r % 32; transpose_item(p.in[I_WFD] + (size_t)l * DFF * 1024, DFF, 1024, nullptr, WDN + (size_t)l * 1024 * DFF, scr, kb, nb, lane, nb * 32 + ln); }
        }
        norm_rows(p.in[I_MEM], MEMN, 1024, gw, NGW, lane);
        if (bx == 0 && tid < NL) {
            float am = 0.f, cm = 0.f;
            for (int i = 0; i < 128; ++i) { am = fmaxf(am, fabsf(p.in[I_GFQ][tid * 128 + i])); cm = fmaxf(cm, fabsf(p.in[I_GFK][tid * 128 + i])); }
            ((float*)(ws + WS_TSK))[tid] = 104.0f + 2.0f * 11.3137085f * am * cm * 1.01f + 1.0f;
        }
    }
    grid.sync();
    { PH_BEGIN pg8::Gemm g{MEMN, WMEM, 1024, 4096, 1024, 1024}; pg8::EpiStore E{MKV, 4096, nullptr}; GEMM_PHASE(pg8::EpiStore, g, E);
      if (G > 64) { if (bx >= 64) xb_rows(p.in[I_X], XBF, SSQ, 2 * MH, (bx - 64) * 8 + wid, (G - 64) * 8, lane); }
      else xb_rows(p.in[I_X], XBF, SSQ, 2 * MH, gw, NGW, lane); }
    GSYNC();
    { PH_BEGIN for (int u = bx; u < 256; u += G) { const int l = u >> 6, b = (u >> 4) & 3, h = (u >> 2) & 3, t = u & 3;
        const bf16_t* src = MKV + (size_t)(b * 256 + t * 64) * 4096 + l * 1024 + h * 128;
        norm128_rows64(src, 4096, MKN + ((size_t)(l * 4 + b) * 256 + t * 64) * 512 + h * 128, 512, p.in[I_GMK] + l * 128, 1.0f, tid);
        vt_tile(src + 512, 4096, MVT + ((size_t)((l * 4 + b) * 4 + h) * 128) * 256 + t * 64, 256, (LAS bf16_t*)lds, tid); } }
    for (int l = 0; l < NL; ++l) {
        for (int hf = 0; hf < 2; ++hf) {
            { PH_BEGIN pg8::Gemm g{XBF + (size_t)hf * MH * 1024, WIN + (size_t)l * PW * 1024, MH, PW, 1024, 1024}; pg8::EpiStore E{PROJ, PW, SSQ + (size_t)hf * MH * 16}; GEMM_PHASE(pg8::EpiStore, g, E); }
            GSYNC();
            { PH_BEGIN const int tid0_ = tid;
              for (int u = bx; u < 32; u += G) { int tid = tid0_; asm volatile("" : "+v"(tid)); const int lane = tid & 63;
                    const int bhp = u >> 2, sg = u & 3, bp = bhp >> 2, h = bhp & 3; const float fb = p.in[I_BFOX][l * 4 + h];
                    float loc[4]; float run = 0.f;
#pragma unroll
                    for (int i = 0; i < 4; ++i) { const float x = bf2f(PROJ[(size_t)(bp * SEQ + sg * 2048 + 4 * tid + i) * PW + C_FF + h]) + fb; run += log_sigmoid_(x); loc[i] = run; }
                    float sc = run;
#pragma unroll
                    for (int o = 1; o < 64; o <<= 1) { const float t = __shfl_up(sc, o); if (lane >= o) sc += t; }
                    LAS float* wt = (LAS float*)lds;
                    if (lane == 63) wt[wid] = sc;
                    __syncthreads();
                    float offs = sc - run;
                    for (int w = 0; w < wid; ++w) offs += wt[w];
                    *(f32x4*)(CUMF + (size_t)bhp * SEQ + sg * 2048 + 4 * tid) = (f32x4){loc[0] + offs, loc[1] + offs, loc[2] + offs, loc[3] + offs};
                    if (tid == 511) ((float*)(ws + WS_TSK))[16 + u] = loc[3] + offs;
                    __syncthreads();
              }
              for (int v0 = bx; v0 < 1024; v0 += 4 * G) { int tid = tid0_; asm volatile("" : "+v"(tid)); prep_batch(PROJ, p.in[I_GFK] + l * 128, KC, VTF, (LAS bf16_t*)lds, v0, G, tid); }
              for (int u = bx; u < 1024; u += 2 * G) { int tid = tid0_; asm volatile("" : "+v"(tid)); const int lane = tid & 63; gla_pair<false>(lds, p, l, u, (u + G < 1024 ? u + G : u), PROJ, CS, DEC, SIN, PROJ, tid, lane, wid); }
              for (int v = bx; v < 256; v += G) { int tid = tid0_; asm volatile("" : "+v"(tid)); const int lane = tid & 63;
                    const int rb = v >> 2, h = v & 3, r0 = rb * 256, bp = r0 / SEQ, b = hf * 2 + bp;
                    attn_unit<false>(lds, p.in[I_GMQ] + l * 128, PROJ + (size_t)r0 * PW + C_MQ + h * 128, PW, MKN + ((size_t)(l * 4 + b) * 256) * 512 + h * 128, 512,
                                     MVT + ((size_t)((l * 4 + b) * 4 + h) * 128) * 256, 256, 64, nullptr, 0.f, 0.f, 0.f, 0.f, 3.0e38f, 0, 0, 3, PROJ + (size_t)r0 * PW + C_MQ + h * 128, PW, tid, lane, wid);
              }
            }
            GSYNC();
            { PH_BEGIN
                for (int u = bx; u < 512; u += G) {
                    typedef float f32x2v __attribute__((ext_vector_type(2)));
                    const int e2 = u * 64 + lane, bhp = e2 >> 12, dvdk = (e2 & 4095) * 2, dk = dvdk & 63, seg = wid;
                    f32x2v c[16], d[16];
#pragma unroll
                    for (int i = 0; i < 16; ++i) { const size_t unit = (size_t)bhp * 128 + seg * 16 + i; c[i] = *(const f32x2v*)(CS + unit * 8192 + dvdk); d[i] = *(const f32x2v*)(DEC + unit * 64 + dk); }
                    f32x2v sl[16], pl[16]; f32x2v sacc = (f32x2v){0.f, 0.f}, pacc = (f32x2v){1.f, 1.f};
#pragma unroll
                    for (int i = 0; i < 16; ++i) { sl[i] = sacc; pl[i] = pacc; sacc = d[i] * sacc + c[i]; pacc = pacc * d[i]; }
                    LAS f32x4* AB = (LAS f32x4*)lds;
                    AB[seg * 64 + lane] = (f32x4){pacc.x, pacc.y, sacc.x, sacc.y};
                    __syncthreads();
                    f32x2v s0 = (f32x2v){0.f, 0.f};
                    for (int j = 0; j < seg; ++j) { const f32x4 ab = AB[j * 64 + lane]; s0 = (f32x2v){ab[0] * s0.x + ab[2], ab[1] * s0.y + ab[3]}; }
#pragma unroll
                    for (int i = 0; i < 16; ++i) { const size_t unit = (size_t)bhp * 128 + seg * 16 + i; const f32x2v v = sl[i] + pl[i] * s0;
                        *(unsigned*)(SIN + unit * 8192 + dvdk) = cvt_pk_bf16(v.x, v.y); }
                    __syncthreads();
                }
                const int nf = G, fidx = bx;
                const int tid0_ = tid; if (fidx >= 0) for (int u = fidx; u < 256; u += nf) { int tid = tid0_; asm volatile("" : "+v"(tid)); const int lane = tid & 63;
                    const int qb = 31 - (u >> 3), bhp = u & 7, bp = bhp >> 2, h = bhp & 3, q0 = qb * 256; const size_t r0 = (size_t)bp * SEQ + q0;
                    const float* cum = CUMF + (size_t)bhp * SEQ; const float* sgt = (const float*)(ws + WS_TSK) + 16 + bhp * 4;
                    const float o1 = sgt[0], o2 = o1 + sgt[1], o3 = o2 + sgt[2];
                    const int sq_ = q0 >> 11; const float cref = cum[q0] + (sq_ == 0 ? 0.f : sq_ == 1 ? o1 : sq_ == 2 ? o2 : o3);
                    int j0 = 0; float Tsk_ = 3.0e38f;
#if FOX_SKIP
                    {
                        const float T = ((const float*)(ws + WS_TSK))[l];
                        Tsk_ = T;
                        const int nt = q0 >> 6;
                        int cnt = 0;
                        if (tid < nt) { const int sk_ = tid >> 5; cnt = (cref - (cum[64 * tid + 63] + (sk_ == 0 ? 0.f : sk_ == 1 ? o1 : sk_ == 2 ? o2 : o3)) < -T) ? 1 : 0; }
                        const unsigned long long bal = __ballot(cnt);
                        LAS int* red = (LAS int*)(lds + 73728);
                        if (lane == 0 && wid < 2) red[wid] = __popcll(bal);
                        __syncthreads();
                        j0 = red[0] + red[1];
                    }
#endif
                    attn_unit<true>(lds, p.in[I_GFQ] + l * 128, PROJ + r0 * PW + C_FQ + h * 128, PW, KC + (size_t)bhp * SEQ * 128, 128, VTF + ((size_t)bhp * 128) * SEQ, 64, 8192,
                                    cum, cref, o1, o2, o3, Tsk_, q0, j0, (q0 >> 6) + 3, PROJ + r0 * PW + C_FQ + h * 128, PW, tid, lane, wid);
                }
            }
            GSYNC();
            { PH_BEGIN const int tid0_ = tid; for (int u = bx; u < 1024; u += 2 * G) { int tid = tid0_; asm volatile("" : "+v"(tid)); const int lane = tid & 63; gla_pair<true>(lds, p, l, u, (u + G < 1024 ? u + G : u), PROJ, CS, DEC, SIN, PROJ, tid, lane, wid); } }
            GSYNC();
            { PH_BEGIN
                pg8::Gemm g{PROJ, WBR + (size_t)l * 3 * 1024 * 512, MH, 3072, 512, PW};
                pg8::EpiGate E{PROJ + C_BG, PW, p.in[I_BGATE] + l * 3072, MRG + (size_t)hf * MH * 1024, 1024};
                pg8::BranchOrder S_; S_.init(MH, G, (int)blockIdx.x); static_assert(C_GV * 2 == 1024 && C_FQ * 2 == 3072 && C_MQ * 2 == 6144, "BranchOrder offsets"); pg8::gemm_phase<pg8::EpiGate, pg8::BranchOrder, true, true>(lds, g, S_, E);
            }
            GSYNC();
        }
        { PH_BEGIN pg8::Gemm g{MRG, WOUT + (size_t)l * 1024 * 1024, 2 * MH, 1024, 1024, 1024}; pg8::EpiResid E{nullptr, XBF, SSQ}; GEMM_PHASE(pg8::EpiResid, g, E); }
        GSYNC();
        { PH_BEGIN pg8::Gemm g{XBF, WGU + (size_t)l * 5632 * 1024, 2 * MH, 5632, 1024, 1024}; pg8::EpiSwiglu E{HB, DFF, SSQ}; GEMM_PHASE(pg8::EpiSwiglu, g, E); }
        GSYNC();
        { PH_BEGIN pg8::Gemm g{HB, WDN + (size_t)l * 1024 * DFF, 2 * MH, 1024, DFF, DFF}; pg8::EpiResid E{l == NL - 1 ? p.out : nullptr, XBF, SSQ}; GEMM_PHASE(pg8::EpiResid, g, E); }
        GSYNC();
    }
}

extern "C" void kernel_launch(void* const* d_in, const int* in_sizes, int n_in, void* d_out, int out_size, void* d_ws, size_t ws_size, hipStream_t stream) {
    static int grid = 0;
    if (grid == 0) {
        int dev = 0, cus = 0, per_cu = 0;
        hipGetDevice(&dev); hipDeviceGetAttribute(&cus, hipDeviceAttributeMultiprocessorCount, dev);
        hipFuncSetAttribute((const void*)mega_fwd, hipFuncAttributeMaxDynamicSharedMemorySize, LDS_BYTES);
        hipOccupancyMaxActiveBlocksPerMultiprocessor(&per_cu, (const void*)mega_fwd, 512, LDS_BYTES);
        if (per_cu < 1) { fprintf(stderr, "kernel_launch: occupancy query says %d blocks/CU\n", per_cu); per_cu = 1; }
        grid = cus * 1;
        if (ws_size < WS_END) { fprintf(stderr, "kernel_launch: workspace too small: %zu < %zu\n", ws_size, (size_t)WS_END); grid = -1; }
        (void)hipGetLastError();
    }
    if (grid < 0) return;
    Params p{};
    for (int i = 0; i < 21; ++i) p.in[i] = (const float*)d_in[i];
    p.out = (float*)d_out; p.ws = (unsigned char*)d_ws;
    hipMemsetAsync((unsigned char*)d_ws + WS_BAR, 0, 16384, stream);
    void* args[] = {&p};
    hipError_t e = hipLaunchCooperativeKernel((const void*)mega_fwd, dim3(grid), dim3(512), args, LDS_BYTES, stream);
    if (e != hipSuccess) fprintf(stderr, "cooperative launch failed: %s (grid %d)\n", hipGetErrorString(e), grid);
}
```
